# Optimizing an MI355X kernel written in HIP

```python
import math
import jax
import jax.numpy as jnp
from jax import lax
import numpy as np

D_MODEL = 1024
BATCH = 16
SEQ = 256
DEPTH = 4
DEC_BATCH = 2
DEC_SEQ = 1024
PAST_LEN = 256

F32 = jnp.float32
GRID_W = 64
N_ADA = 9
D_FF = 2816
GROUP_W = D_MODEL // 4
MIX_W = 4 * GROUP_W
CHUNK = 64
Q_BLOCK = 128
RMS_EPS = 1e-6

HG_HEADS = 4
HG_DK = GROUP_W // HG_HEADS
HG_DV = GROUP_W // HG_HEADS
HY_W = GROUP_W
HY_EMB = 33
HY_BANDS = (HY_EMB - 1) // 2
HY_FH = 64
HY_TARGET = 1e-2
HY_FAST = 0.3
HY_SLOW = 1.5
MLA_HEADS = 4
MLA_NOPE = 64
MLA_ROPE = 32
MLA_V = GROUP_W // MLA_HEADS
MLA_Q_LORA = 256
MLA_KV_LORA = 128
ROPE_BASE = 10000.0
GD_HEADS = 4
GD_DK = 64
GD_DV = GROUP_W // GD_HEADS

HG_COLS = 5 * GROUP_W
HY_COLS = 3 * HY_W
MLA_COLS = MLA_Q_LORA + MLA_KV_LORA + MLA_ROPE
GD_COLS = 4 * GROUP_W + 4 * GD_HEADS
IN_COLS = HG_COLS + HY_COLS + MLA_COLS + GD_COLS

kernel_name = 'hybrid_diffusion_hgrn2_hyena_mla_gdn_step'


def rms_norm(x, g):
    xf = x.astype(F32)
    y = xf * lax.rsqrt(jnp.mean(xf * xf, axis=-1, keepdims=True) + RMS_EPS)
    return (y * g.astype(F32)).astype(x.dtype)


def l2_norm(x):
    return x * lax.rsqrt(jnp.sum(x * x, axis=-1, keepdims=True) + 1e-6)


def heads(x, n):
    B, T, _ = x.shape
    return x.reshape(B, T, n, -1).transpose(0, 2, 1, 3)


def merge_heads(x):
    B, n, T, d = x.shape
    return x.transpose(0, 2, 1, 3).reshape(B, T, n * d)


def head_norm_gate(o, g_norm, gate):
    o = rms_norm(o.transpose(0, 2, 1, 3), g_norm)
    B, T, H, d = o.shape
    return o.reshape(B, T, H * d) * jax.nn.silu(gate)


def conv3_centred(x, w):
    xp = jnp.pad(x, ((0, 0), (1, 1), (0, 0)))
    return xp[:, :-2] * w[0] + xp[:, 1:-1] * w[1] + xp[:, 2:] * w[2]


def swiglu(h, w_gu, w_down):
    gate, up = jnp.split(h @ w_gu, 2, axis=-1)
    return (jax.nn.silu(gate) * up) @ w_down


def adaln(cond, w, b):
    return (jax.nn.silu(cond) @ w + b).reshape(cond.shape[0], N_ADA, D_MODEL)


def rope_tables(rows):
    T = rows * GRID_W
    row = jnp.repeat(jnp.arange(rows, dtype=F32), GRID_W)
    col = (jnp.arange(T) % GRID_W).astype(F32)
    pairs = MLA_ROPE // 4
    inv = ROPE_BASE ** (-jnp.arange(pairs, dtype=F32) / pairs)
    ang = jnp.concatenate([row[:, None] * inv, col[:, None] * inv], axis=-1)
    return jnp.cos(ang), jnp.sin(ang)


def apply_rope(x, cos, sin):
    xn, xr = x[..., :MLA_NOPE], x[..., MLA_NOPE:]
    x1, x2 = jnp.split(xr, 2, axis=-1)
    return jnp.concatenate([xn, x1 * cos - x2 * sin, x2 * cos + x1 * sin], axis=-1)


def attention(q, k, v, scale):
    B, H, T, dq = q.shape
    nb = T // Q_BLOCK
    qb = q.reshape(B, H, nb, Q_BLOCK, dq).transpose(2, 0, 1, 3, 4)

    def block(qi):
        s = jnp.einsum('bhqd,bhkd->bhqk', qi, k).astype(F32) * scale
        p = jax.nn.softmax(s, axis=-1)
        return jnp.einsum('bhqk,bhkd->bhqd', p.astype(v.dtype), v)

    o = lax.map(block, qb)
    return o.transpose(1, 2, 0, 3, 4).reshape(B, H, T, -1)


def hgrn2_chunk_scan(q, k, v, log_f, s0):
    B, H, T, dk = q.shape
    n = T // CHUNK
    q, k, v, log_f = (a.reshape(B, H, n, CHUNK, a.shape[-1]) for a in (q, k, v, log_f))
    b = jnp.cumsum(log_f, axis=3)
    causal = jnp.tril(jnp.ones((CHUNK, CHUNK), bool))
    rel = jnp.where(causal[:, :, None], b[:, :, :, :, None, :] - b[:, :, :, None, :, :], -jnp.inf)
    scores = jnp.einsum('bhnik,bhnjk,bhnijk->bhnij', q, k, jnp.exp(rel))
    o_intra = jnp.einsum('bhnij,bhnjv->bhniv', scores, v)
    q_in = q * jnp.exp(b)
    k_out = k * jnp.exp(b[:, :, :, -1:] - b)
    decay = jnp.exp(b[:, :, :, -1])

    def step(s, xs):
        qi, ki, vi, di = xs
        o = jnp.einsum('bhck,bhkv->bhcv', qi, s)
        s = s * di[..., None] + jnp.einsum('bhck,bhcv->bhkv', ki, vi)
        return s, o

    xs = tuple(jnp.moveaxis(a, 2, 0) for a in (q_in, k_out, v, decay))
    s_fin, o_inter = lax.scan(step, s0, xs)
    o = o_intra + jnp.moveaxis(o_inter, 0, 2)
    return o.reshape(B, H, T, -1), s_fin


def hgrn2_mixer(u, lb, g_norm, s0):
    q, i, g, z_f, z_b = jnp.split(u, 5, axis=-1)
    q = heads(q, HG_HEADS) * HG_DK ** -0.5
    v = heads(i, HG_HEADS)
    out = 0.0
    finals = []
    for d, z in enumerate((z_f, z_b)):
        log_f = heads(jnp.logaddexp(jnp.log(lb[d]), jnp.log1p(-lb[d]) + jax.nn.log_sigmoid(z)), HG_HEADS)
        k = -jnp.expm1(log_f)
        if d == 0:
            o, s = hgrn2_chunk_scan(q, k, v, log_f, s0[:, d])
        else:
            o, s = hgrn2_chunk_scan(jnp.flip(q, 2), jnp.flip(k, 2), jnp.flip(v, 2), jnp.flip(log_f, 2), s0[:, d])
            o = jnp.flip(o, 2)
        out = out + o
        finals.append(s)
    return head_norm_gate(out, g_norm.reshape(HG_HEADS, HG_DV), g), jnp.stack(finals, axis=1)


def hyena_filter(L, w1, b1, freq, w2, b2, w3):
    w1, b1, freq, w2, b2, w3 = (a.astype(F32) for a in (w1, b1, freq, w2, b2, w3))
    pos = jnp.arange(L, dtype=F32)
    t = pos / (L - 1)
    bands = jnp.linspace(1e-4, HY_BANDS - 1, HY_BANDS, dtype=F32)
    ang = (2.0 * math.pi / L) * pos[:, None] * bands[None, :]
    z = jnp.concatenate([t[:, None], jnp.cos(ang), -jnp.sin(ang)], axis=-1)
    h = jnp.sin(freq * (z @ w1 + b1))
    h = jnp.sin(freq * (h @ w2 + b2))
    h = h @ w3
    max_decay = math.log(HY_TARGET) / HY_FAST
    min_decay = math.log(HY_TARGET) / HY_SLOW
    deltas = jnp.linspace(min_decay, max_decay, HY_W, dtype=F32)
    window = jnp.exp(-t[:, None] * jnp.abs(deltas)[None, :])
    h_f, h_b = h[:, :HY_W] * window, h[:, HY_W:] * window
    return jnp.concatenate([h_f, jnp.zeros((1, HY_W), F32), jnp.flip(h_b[1:], axis=0)], axis=0)


def hyena_mixer(u, conv_w, conv_b, w1, b1, freq, w2, b2, w3, skip):
    B, T, _ = u.shape
    uc = conv3_centred(u, conv_w) + conv_b
    x0, x1, v = jnp.split(uc, 3, axis=-1)
    z = x1 * v
    filt = hyena_filter(T, w1, b1, freq, w2, b2, w3)
    y = jnp.fft.irfft(jnp.fft.rfft(z, n=2 * T, axis=1) * jnp.fft.rfft(filt, n=2 * T, axis=0)[None], n=2 * T, axis=1)[:, :T]
    return x0 * (y + z * skip)


def mla_keys_values(ckv, krope, w_kv_up):
    B, S, _ = ckv.shape
    kv = heads(ckv @ w_kv_up, MLA_HEADS)
    k_nope, v = kv[..., :MLA_NOPE], kv[..., MLA_NOPE:]
    k = jnp.concatenate([k_nope, jnp.broadcast_to(krope[:, None], (B, MLA_HEADS, S, MLA_ROPE))], axis=-1)
    return k, v


def mla_mixer(u, q_norm_a, w_q_up, kv_norm_a, w_kv_up, qk_norm, rope, ctx):
    cq, ckv, krope = jnp.split(u, [MLA_Q_LORA, MLA_Q_LORA + MLA_KV_LORA], axis=-1)
    q = heads(rms_norm(cq, q_norm_a) @ w_q_up, MLA_HEADS)
    ckv = rms_norm(ckv, kv_norm_a)
    k, v = mla_keys_values(ckv, krope, w_kv_up)
    q = rms_norm(q, qk_norm[0])
    k = rms_norm(k, qk_norm[1])
    if ctx is not None:
        q = apply_rope(q, rope[0], rope[1])
        k = apply_rope(k, rope[0], rope[1])
        kc, vc = mla_keys_values(ctx[0], ctx[1], w_kv_up)
        k = jnp.concatenate([k, rms_norm(kc, qk_norm[1])], axis=2)
        v = jnp.concatenate([v, vc], axis=2)
    o = attention(q, k, v, (MLA_NOPE + MLA_ROPE) ** -0.5)
    return merge_heads(o), ckv, krope


def gdn_chunk_scan(q, k, v, beta, log_a, s0):
    B, H, T, dk = q.shape
    n = T // CHUNK
    q, k, v = (a.reshape(B, H, n, CHUNK, a.shape[-1]) for a in (q, k, v))
    beta, log_a = (a.reshape(B, H, n, CHUNK) for a in (beta, log_a))
    G = jnp.cumsum(log_a, axis=-1)
    incl = jnp.tril(jnp.ones((CHUNK, CHUNK), bool))
    strict = jnp.tril(jnp.ones((CHUNK, CHUNK), F32), -1)
    decay = jnp.exp(jnp.where(incl, G[..., :, None] - G[..., None, :], -jnp.inf))
    kb = k * beta[..., None]
    lmat = jnp.einsum('bhnik,bhnjk->bhnij', kb, k) * decay * strict
    eye = jnp.eye(CHUNK, dtype=F32)
    tmat = lax.linalg.triangular_solve(eye + lmat, jnp.broadcast_to(eye, lmat.shape), left_side=True, lower=True, unit_diagonal=True)
    u_w = tmat @ (v * beta[..., None])
    w_w = tmat @ (kb * jnp.exp(G)[..., None])
    attn = jnp.einsum('bhnik,bhnjk->bhnij', q, k) * decay
    q_in = q * jnp.exp(G)[..., None]
    k_out = k * jnp.exp(G[..., -1:] - G)[..., None]
    a_last = jnp.exp(G[..., -1])

    def step(s, xs):
        qi, ki, wi, ui, ai, di = xs
        v_new = ui - wi @ s
        o = qi @ s + ai @ v_new
        s = s * di[..., None, None] + jnp.swapaxes(ki, -1, -2) @ v_new
        return s, o

    xs = tuple(jnp.moveaxis(a, 2, 0) for a in (q_in, k_out, w_w, u_w, attn, a_last))
    s_fin, o = lax.scan(step, s0, xs)
    return jnp.moveaxis(o, 0, 2).reshape(B, H, T, -1), s_fin


def gdn_mixer(u, conv_w, a_log, dt_bias, g_norm, s0):
    B, T, _ = u.shape
    qkv, g, ab = jnp.split(u, [3 * GROUP_W, 4 * GROUP_W], axis=-1)
    qkv = jax.nn.silu(conv3_centred(qkv, conv_w))
    q, k, v = jnp.split(qkv, 3, axis=-1)
    q = l2_norm(heads(q, GD_HEADS)) * GD_DK ** -0.5
    k = l2_norm(heads(k, GD_HEADS))
    v = heads(v, GD_HEADS)
    a = ab[..., :2 * GD_HEADS].reshape(B, T, 2, GD_HEADS)
    bb = ab[..., 2 * GD_HEADS:].reshape(B, T, 2, GD_HEADS)
    a_log, dt_bias = a_log.astype(F32), dt_bias.astype(F32)
    out = 0.0
    finals = []
    for d in range(2):
        log_a = (-jnp.exp(a_log[d]) * jax.nn.softplus(a[:, :, d] + dt_bias[d])).transpose(0, 2, 1)
        beta = jax.nn.sigmoid(bb[:, :, d]).transpose(0, 2, 1)
        if d == 0:
            o, s = gdn_chunk_scan(q, k, v, beta, log_a, s0[:, d])
        else:
            o, s = gdn_chunk_scan(jnp.flip(q, 2), jnp.flip(k, 2), jnp.flip(v, 2), jnp.flip(beta, 2), jnp.flip(log_a, 2), s0[:, d])
            o = jnp.flip(o, 2)
        out = out + o
        finals.append(s)
    return head_norm_gate(out, g_norm, g), jnp.stack(finals, axis=1)


def trunk_layer(x, ada, lb, rope, ctx, l, P):
    m = [ada[:, i, None, :] for i in range(N_ADA)]
    h = rms_norm(x, P['norm_ffn'][l, 0]) * (1.0 + m[1]) + m[0]
    x = x + 0.5 * m[2] * swiglu(h, P['w_ffn_gu'][l, 0], P['w_ffn_down'][l, 0])
    h = rms_norm(x, P['norm_mix'][l]) * (1.0 + m[4]) + m[3]
    u = (h @ P['w_in'][l]).astype(F32)
    u_hg, u_hy, u_mla, u_gd = jnp.split(u, [HG_COLS, HG_COLS + HY_COLS, HG_COLS + HY_COLS + MLA_COLS], axis=-1)
    B = x.shape[0]
    if ctx is None:
        mla_ctx = None
        s_hg0 = jnp.zeros((B, 2, HG_HEADS, HG_DK, HG_DV), F32)
        s_gd0 = jnp.zeros((B, 2, GD_HEADS, GD_DK, GD_DV), F32)
    else:
        mla_ctx = (ctx[0].astype(F32), ctx[1].astype(F32))
        s_hg0, s_gd0 = ctx[2].astype(F32), ctx[3].astype(F32)
    o_hg, s_hg = hgrn2_mixer(u_hg, lb, P['hgrn_norm'][l], s_hg0)
    o_hy = hyena_mixer(u_hy, P['hy_conv_w'][l], P['hy_conv_b'][l], P['hy_w1'][l], P['hy_b1'][l], P['hy_freq'][l],
                       P['hy_w2'][l], P['hy_b2'][l], P['hy_w3'][l], P['hy_skip'][l])
    o_mla, ckv, krope = mla_mixer(u_mla, P['mla_q_norm_a'][l], P['mla_w_q_up'][l], P['mla_kv_norm_a'][l],
                                  P['mla_w_kv_up'][l], P['mla_qk_norm'][l], rope, mla_ctx)
    o_gd, s_gd = gdn_mixer(u_gd, P['gdn_conv_w'][l], P['gdn_a_log'][l], P['gdn_dt_bias'][l], P['gdn_norm'][l], s_gd0)
    o = jnp.concatenate([o_hg, o_hy, o_mla, o_gd], axis=-1).astype(x.dtype) @ P['w_out'][l]
    x = x + m[5] * o
    h = rms_norm(x, P['norm_ffn'][l, 1]) * (1.0 + m[7]) + m[6]
    x = x + 0.5 * m[8] * swiglu(h, P['w_ffn_gu'][l, 1], P['w_ffn_down'][l, 1])
    return x, (ckv, krope, s_hg, s_gd)


def setup_inputs(seed: int = 0) -> dict:
    key = jax.random.key(seed)
    ks = iter(jax.random.split(key, 48))

    def nrm(shape, s):
        return s * jax.random.normal(next(ks), shape, F32)

    def gain(shape):
        return 1.0 + nrm(shape, 0.02)

    dt = jnp.exp(jax.random.uniform(next(ks), (DEPTH, 2, GD_HEADS), F32, math.log(1e-3), math.log(1e-1)))
    a_init = jax.random.uniform(next(ks), (DEPTH, 2, GD_HEADS), F32, 1.0, 16.0)
    return {
        'x_prompt': nrm((BATCH, SEQ, D_MODEL), 1.0),
        'x_sample': nrm((DEC_BATCH, DEC_SEQ, D_MODEL), 1.0),
        'cache_mla_ckv': nrm((DEC_BATCH, DEPTH, PAST_LEN, MLA_KV_LORA), 1.0),
        'cache_mla_krope': nrm((DEC_BATCH, DEPTH, PAST_LEN, MLA_ROPE), 1.0),
        'state_hgrn': nrm((DEC_BATCH, DEPTH, 2, HG_HEADS, HG_DK, HG_DV), 0.3),
        'state_gdn': nrm((DEC_BATCH, DEPTH, 2, GD_HEADS, GD_DK, GD_DV), 0.1),
        'c': nrm((DEC_BATCH, D_MODEL), 1.0),
        'c_ctx': nrm((D_MODEL,), 1.0),
        'w_ada': nrm((DEPTH, D_MODEL, N_ADA * D_MODEL), 0.5 * D_MODEL ** -0.5),
        'b_ada': nrm((DEPTH, N_ADA * D_MODEL), 0.02),
        'norm_ffn': gain((DEPTH, 2, D_MODEL)),
        'w_ffn_gu': nrm((DEPTH, 2, D_MODEL, 2 * D_FF), D_MODEL ** -0.5),
        'w_ffn_down': nrm((DEPTH, 2, D_FF, D_MODEL), D_FF ** -0.5),
        'norm_mix': gain((DEPTH, D_MODEL)),
        'w_in': nrm((DEPTH, D_MODEL, IN_COLS), D_MODEL ** -0.5),
        'w_out': nrm((DEPTH, MIX_W, D_MODEL), MIX_W ** -0.5),
        'hgrn_lb': nrm((DEPTH, 2, GROUP_W), 0.1),
        'hgrn_norm': gain((DEPTH, GROUP_W)),
        'hy_conv_w': nrm((DEPTH, 3, HY_COLS), 0.5),
        'hy_conv_b': nrm((DEPTH, HY_COLS), 0.02),
        'hy_w1': nrm((DEPTH, HY_EMB, HY_FH), HY_EMB ** -0.5),
        'hy_b1': nrm((DEPTH, HY_FH), 0.1),
        'hy_freq': gain((DEPTH, HY_FH)),
        'hy_w2': nrm((DEPTH, HY_FH, HY_FH), HY_FH ** -0.5),
        'hy_b2': nrm((DEPTH, HY_FH), 0.1),
        'hy_w3': nrm((DEPTH, HY_FH, 2 * HY_W), 0.01),
        'hy_skip': nrm((DEPTH, HY_W), 0.5),
        'mla_q_norm_a': gain((DEPTH, MLA_Q_LORA)),
        'mla_w_q_up': nrm((DEPTH, MLA_Q_LORA, MLA_HEADS * (MLA_NOPE + MLA_ROPE)), MLA_Q_LORA ** -0.5),
        'mla_kv_norm_a': gain((DEPTH, MLA_KV_LORA)),
        'mla_w_kv_up': nrm((DEPTH, MLA_KV_LORA, MLA_HEADS * (MLA_NOPE + MLA_V)), MLA_KV_LORA ** -0.5),
        'mla_qk_norm': gain((DEPTH, 2, MLA_NOPE + MLA_ROPE)),
        'gdn_conv_w': nrm((DEPTH, 3, 3 * GROUP_W), 0.5),
        'gdn_a_log': jnp.log(a_init),
        'gdn_dt_bias': dt + jnp.log(-jnp.expm1(-dt)),
        'gdn_norm': gain((DEPTH, GD_DV)),
    }


def reference(x_prompt, x_sample, cache_mla_ckv, cache_mla_krope, state_hgrn, state_gdn, c, c_ctx,
              w_ada, b_ada, norm_ffn, w_ffn_gu, w_ffn_down, norm_mix, w_in, w_out, hgrn_lb, hgrn_norm,
              hy_conv_w, hy_conv_b, hy_w1, hy_b1, hy_freq, hy_w2, hy_b2, hy_w3, hy_skip,
              mla_q_norm_a, mla_w_q_up, mla_kv_norm_a, mla_w_kv_up, mla_qk_norm,
              gdn_conv_w, gdn_a_log, gdn_dt_bias, gdn_norm):
    P = dict(norm_ffn=norm_ffn, w_ffn_gu=w_ffn_gu, w_ffn_down=w_ffn_down, norm_mix=norm_mix, w_in=w_in,
             w_out=w_out, hgrn_norm=hgrn_norm, hy_conv_w=hy_conv_w, hy_conv_b=hy_conv_b, hy_w1=hy_w1,
             hy_b1=hy_b1, hy_freq=hy_freq, hy_w2=hy_w2, hy_b2=hy_b2, hy_w3=hy_w3, hy_skip=hy_skip,
             mla_q_norm_a=mla_q_norm_a, mla_w_q_up=mla_w_q_up, mla_kv_norm_a=mla_kv_norm_a,
             mla_w_kv_up=mla_w_kv_up, mla_qk_norm=mla_qk_norm, gdn_conv_w=gdn_conv_w, gdn_a_log=gdn_a_log,
             gdn_dt_bias=gdn_dt_bias, gdn_norm=gdn_norm)
    lb_all = jnp.cumsum(jax.nn.softmax(hgrn_lb.astype(F32), axis=0), axis=0)
    lb_all = lb_all - lb_all[0]
    rows = x_sample.shape[1] // GRID_W
    rope = rope_tables(rows)
    ctx_cond = c_ctx[None]
    y_prompt, y_sample = x_prompt, x_sample
    ctx_states = []
    for l in range(DEPTH):
        y_prompt, st = trunk_layer(y_prompt, adaln(ctx_cond, w_ada[l], b_ada[l]), lb_all[l], None, None, l, P)
        ctx_states.append(st)
        cached = (cache_mla_ckv[:, l], cache_mla_krope[:, l], state_hgrn[:, l], state_gdn[:, l])
        y_sample, _ = trunk_layer(y_sample, adaln(c, w_ada[l], b_ada[l]), lb_all[l], rope, cached, l, P)
    new_ckv = jnp.stack([s[0] for s in ctx_states], axis=1)
    new_krope = jnp.stack([s[1] for s in ctx_states], axis=1)
    new_hg = jnp.stack([s[2] for s in ctx_states], axis=1)
    new_gd = jnp.stack([s[3] for s in ctx_states], axis=1)
    return (y_prompt, y_sample, new_ckv, new_krope, new_hg, new_gd)
```

```cpp
#include <hip/hip_runtime.h>
#include <stdint.h>
#include <math.h>

namespace {

constexpr int D = 1024, NB_P = 16, T_P = 256, NB_S = 2, T_S = 1024, DEPTH = 4, PAST = 256;
constexpr int M_P = NB_P * T_P, M_S = NB_S * T_S, M = M_P + M_S;
constexpr int DFF = 2816, NADA = 9, INC = 3504;
constexpr int HG_OFF = 0, HY_OFF = 1280, MLA_OFF = 2048, GD_OFF = 2464;
constexpr int NKS = T_S + PAST;
constexpr float RMS_EPS = 1e-6f;

struct P {
    const float *x_prompt, *x_sample, *cache_ckv, *cache_krope, *state_hgrn, *state_gdn, *c, *c_ctx;
    const float *w_ada, *b_ada, *norm_ffn, *w_gu, *w_down, *norm_mix, *w_in, *w_out, *hgrn_lb, *hgrn_norm;
    const float *hy_conv_w, *hy_conv_b, *hy_w1, *hy_b1, *hy_freq, *hy_w2, *hy_b2, *hy_w3, *hy_skip;
    const float *q_norm_a, *w_q_up, *kv_norm_a, *w_kv_up, *qk_norm, *gdn_conv_w, *gdn_a_log, *gdn_dt_bias, *gdn_norm;
    float *X;
    float *o_ckv, *o_krope, *o_shg, *o_sgd;
    float *ADA;
    float *LB;
    float *FILT;
    float *ROPE;
    float *H;
    float *GU;
    float *ACT;
    float *TMP;
    float *U;
    float *Q;
    float *KP, *VP;
    float *KS, *VS;
    float *GQ, *GK, *GV;
    float *GLA, *GBT;
    float *Z, *X0;
    float *OH, *OG;
    float *OCAT;
};

constexpr size_t FILT_L = 2 * (256 + 1024) * 256;

__device__ __forceinline__ float sigmoidf_(float x) { return 1.f / (1.f + expf(-x)); }
__device__ __forceinline__ float siluf_(float x) { return x / (1.f + expf(-x)); }

__device__ __forceinline__ void row_info(int r, int& ci, int& T, int& row0, int& t, int& b) {
    if (r < M_P) { b = r >> 8; t = r & 255; T = T_P; row0 = b << 8; ci = 0; }
    else { const int rr = r - M_P; b = rr >> 10; t = rr & 1023; T = T_S; row0 = M_P + (b << 10); ci = 1 + b; }
}

__device__ __forceinline__ float wave_sum(float v) {
#pragma unroll
    for (int o = 1; o < 64; o <<= 1) v += __shfl_xor(v, o);
    return v;
}

__global__ void k_init(P p) {
    const int n4 = M * D / 4, np4 = M_P * D / 4;
    for (int i = blockIdx.x * blockDim.x + threadIdx.x; i < n4; i += gridDim.x * blockDim.x) {
        float4 v = (i < np4) ? ((const float4*)p.x_prompt)[i] : ((const float4*)p.x_sample)[i - np4];
        ((float4*)p.X)[i] = v;
    }
}

__global__ void k_ada(P p) {
    __shared__ float sc[3][1024];
    for (int i = threadIdx.x; i < 3 * 1024; i += blockDim.x) {
        const int ci = i >> 10, k = i & 1023;
        const float v = (ci == 0) ? p.c_ctx[k] : p.c[(ci - 1) * 1024 + k];
        sc[ci][k] = siluf_(v);
    }
    __syncthreads();
    const int NJ = NADA * D;
    for (int idx = blockIdx.x * blockDim.x + threadIdx.x; idx < DEPTH * NJ; idx += gridDim.x * blockDim.x) {
        const int l = idx / NJ, j = idx % NJ;
        const float* w = p.w_ada + (size_t)l * D * NJ + j;
        float a0 = 0.f, a1 = 0.f, a2 = 0.f;
#pragma unroll 8
        for (int k = 0; k < D; ++k) { const float wv = w[(size_t)k * NJ]; a0 += sc[0][k] * wv; a1 += sc[1][k] * wv; a2 += sc[2][k] * wv; }
        const float bb = p.b_ada[l * NJ + j];
        p.ADA[(size_t)(l * 3 + 0) * NJ + j] = a0 + bb;
        p.ADA[(size_t)(l * 3 + 1) * NJ + j] = a1 + bb;
        p.ADA[(size_t)(l * 3 + 2) * NJ + j] = a2 + bb;
    }
}

__global__ void k_small(P p) {
    const int gt = blockIdx.x * blockDim.x + threadIdx.x, gn = gridDim.x * blockDim.x;
    for (int i = gt; i < 512; i += gn) {
        float v[4], mx = -1e30f;
        for (int l = 0; l < 4; ++l) { v[l] = p.hgrn_lb[l * 512 + i]; mx = fmaxf(mx, v[l]); }
        float s = 0.f;
        for (int l = 0; l < 4; ++l) { v[l] = expf(v[l] - mx); s += v[l]; }
        float cum = 0.f;
        for (int l = 0; l < 4; ++l) { if (l > 0) cum += v[l] / s; p.LB[l * 512 + i] = cum; }
    }
    for (int i = gt; i < 1024 * 16; i += gn) {
        const int t = i >> 4, j = i & 15;
        const int row = t >> 6, col = t & 63;
        const double inv = pow(10000.0, -(double)(j & 7) / 8.0);
        const double ang = (double)((j < 8) ? row : col) * inv;
        p.ROPE[i] = (float)cos(ang);
        p.ROPE[1024 * 16 + i] = (float)sin(ang);
    }
}

__global__ void k_filt(P p) {
    __shared__ double ze[33];
    __shared__ double h1[64];
    __shared__ double h2[64];
    const int tid = threadIdx.x;
    for (int item = blockIdx.x; item < DEPTH * 1280; item += gridDim.x) {
        const int l = item / 1280, q = item % 1280;
        const int set = (q < 256) ? 0 : 1, pos = set ? q - 256 : q, L = set ? 1024 : 256;
        const double t = (double)pos / (double)(L - 1);
        if (tid == 0) ze[0] = t;
        if (tid < 16) {
            const double band = 1e-4 + (double)tid * ((15.0 - 1e-4) / 15.0);
            const double ang = (2.0 * 3.14159265358979323846 / (double)L) * (double)pos * band;
            ze[1 + tid] = cos(ang);
            ze[17 + tid] = -sin(ang);
        }
        __syncthreads();
        const double fr = (double)p.hy_freq[l * 64 + tid];
        {
            double a = (double)p.hy_b1[l * 64 + tid];
            for (int i = 0; i < 33; ++i) a += ze[i] * (double)p.hy_w1[(l * 33 + i) * 64 + tid];
            h1[tid] = sin(fr * a);
        }
        __syncthreads();
        {
            double a = (double)p.hy_b2[l * 64 + tid];
            for (int i = 0; i < 64; ++i) a += h1[i] * (double)p.hy_w2[(l * 64 + i) * 64 + tid];
            h2[tid] = sin(fr * a);
        }
        __syncthreads();
        float* base = p.FILT + (size_t)l * FILT_L + (set ? (size_t)2 * 256 * 256 : 0);
        const size_t hb_off = (size_t)L * 256;
        const double max_decay = log(1e-2) / 0.3, min_decay = log(1e-2) / 1.5;
        for (int n = tid; n < 512; n += 64) {
            double a = 0.0;
            for (int i = 0; i < 64; ++i) a += h2[i] * (double)p.hy_w3[(size_t)(l * 64 + i) * 512 + n];
            const int c = n & 255;
            const double delta = min_decay + (double)c * ((max_decay - min_decay) / 255.0);
            const double win = exp(-t * fabs(delta));
            base[(n < 256 ? 0 : hb_off) + (size_t)pos * 256 + c] = (float)(a * win);
        }
        __syncthreads();
    }
}

__global__ void k_norm(P p, int l, int s) {
    const int lane = threadIdx.x & 63, wpb = blockDim.x >> 6;
    const float* g = (s == 1) ? p.norm_mix + l * D : p.norm_ffn + (size_t)(l * 2 + (s == 2 ? 1 : 0)) * D;
    for (int r = blockIdx.x * wpb + (threadIdx.x >> 6); r < M; r += gridDim.x * wpb) {
        int ci, T, row0, t, b; row_info(r, ci, T, row0, t, b);
        const float* ada = p.ADA + (size_t)(l * 3 + ci) * NADA * D;
        const float* shift = ada + (3 * s + 0) * D;
        const float* scale = ada + (3 * s + 1) * D;
        const float4* xr = (const float4*)(p.X + (size_t)r * D);
        float4 v[4]; float ss = 0.f;
#pragma unroll
        for (int j = 0; j < 4; ++j) { v[j] = xr[lane + 64 * j]; ss += v[j].x * v[j].x + v[j].y * v[j].y + v[j].z * v[j].z + v[j].w * v[j].w; }
        ss = wave_sum(ss);
        const float rstd = 1.0f / sqrtf(ss * (1.0f / D) + RMS_EPS);
        float4* hr = (float4*)(p.H + (size_t)r * D);
#pragma unroll
        for (int j = 0; j < 4; ++j) {
            const int c4 = lane + 64 * j;
            const float4 gg = ((const float4*)g)[c4], sh = ((const float4*)shift)[c4], scl = ((const float4*)scale)[c4];
            float4 o;
            o.x = v[j].x * rstd * gg.x * (1.f + scl.x) + sh.x;
            o.y = v[j].y * rstd * gg.y * (1.f + scl.y) + sh.y;
            o.z = v[j].z * rstd * gg.z * (1.f + scl.z) + sh.z;
            o.w = v[j].w * rstd * gg.w * (1.f + scl.w) + sh.w;
            hr[c4] = o;
        }
    }
}

__global__ void __launch_bounds__(256) k_gemm(const float* __restrict__ A, const float* __restrict__ W, float* __restrict__ C, int Mr, int N, int K) {
    __shared__ float As[16][68];
    __shared__ float Ws[16][68];
    const int tid = threadIdx.x, tx = tid & 15, ty = tid >> 4;
    const int tilesN = (N + 63) / 64, tilesM = Mr / 64;
    for (int tile = blockIdx.x; tile < tilesM * tilesN; tile += gridDim.x) {
        const int tm = tile / tilesN, tn = tile % tilesN;
        float acc[4][4];
#pragma unroll
        for (int i = 0; i < 4; ++i)
#pragma unroll
            for (int j = 0; j < 4; ++j) acc[i][j] = 0.f;
        const int am = tid >> 2, ak = (tid & 3) * 4;
        const int wk = tid >> 4, wn = (tid & 15) * 4;
        const float* Ap = A + (size_t)(tm * 64 + am) * K + ak;
        const int wcol = tn * 64 + wn;
        for (int k0 = 0; k0 < K; k0 += 16) {
            const float4 av = *(const float4*)(Ap + k0);
            float4 wv = make_float4(0.f, 0.f, 0.f, 0.f);
            if (wcol < N) wv = *(const float4*)(W + (size_t)(k0 + wk) * N + wcol);
            As[ak + 0][am] = av.x; As[ak + 1][am] = av.y; As[ak + 2][am] = av.z; As[ak + 3][am] = av.w;
            *(float4*)&Ws[wk][wn] = wv;
            __syncthreads();
#pragma unroll
            for (int k = 0; k < 16; ++k) {
                const float4 a = *(const float4*)&As[k][ty * 4];
                const float4 b = *(const float4*)&Ws[k][tx * 4];
                const float aa[4] = {a.x, a.y, a.z, a.w}, bb[4] = {b.x, b.y, b.z, b.w};
#pragma unroll
                for (int i = 0; i < 4; ++i)
#pragma unroll
                    for (int j = 0; j < 4; ++j) acc[i][j] += aa[i] * bb[j];
            }
            __syncthreads();
        }
        const int col = tn * 64 + tx * 4;
        if (col < N) {
#pragma unroll
            for (int i = 0; i < 4; ++i)
                *(float4*)(C + (size_t)(tm * 64 + ty * 4 + i) * N + col) = make_float4(acc[i][0], acc[i][1], acc[i][2], acc[i][3]);
        }
    }
}

__global__ void k_swiglu(P p) {
    const size_t n = (size_t)M * DFF;
    for (size_t i = (size_t)blockIdx.x * blockDim.x + threadIdx.x; i < n; i += (size_t)gridDim.x * blockDim.x) {
        const size_t r = i / DFF; const int j = (int)(i % DFF);
        const float g = p.GU[r * (2 * DFF) + j], u = p.GU[r * (2 * DFF) + DFF + j];
        p.ACT[i] = siluf_(g) * u;
    }
}

__global__ void k_resid(P p, int l, int gidx, float coef) {
    const size_t n = (size_t)M * D;
    for (size_t i = (size_t)blockIdx.x * blockDim.x + threadIdx.x; i < n; i += (size_t)gridDim.x * blockDim.x) {
        const int r = (int)(i >> 10), c = (int)(i & 1023);
        int ci, T, row0, t, b; row_info(r, ci, T, row0, t, b);
        const float gate = p.ADA[((size_t)(l * 3 + ci) * NADA + gidx) * D + c];
        p.X[i] += coef * gate * p.TMP[i];
    }
}

__global__ void __launch_bounds__(256) k_mla_prep(P p, int l) {
    __shared__ float cqn[256];
    __shared__ float ckvn[128];
    __shared__ float kr[32];
    __shared__ float qraw[384];
    __shared__ float kvraw[512];
    __shared__ float red[8];
    __shared__ float rs[8];
    const int tid = threadIdx.x, lane = tid & 63, wv = tid >> 6;
    for (int r = blockIdx.x; r < M + NB_S * PAST; r += gridDim.x) {
        const bool isctx = r >= M;
        int ci = 0, T = 0, row0 = 0, t = 0, b = 0;
        bool sample = false;
        if (!isctx) {
            row_info(r, ci, T, row0, t, b); sample = r >= M_P;
            const float* u = p.U + (size_t)r * INC + MLA_OFF;
            const float x = u[tid];
            float ss = wave_sum(x * x);
            if (lane == 0) red[wv] = ss;
            float y = 0.f;
            if (tid < 128) y = u[256 + tid];
            float s2 = wave_sum(y * y);
            if (lane == 0) red[4 + wv] = s2;
            if (tid < 32) kr[tid] = u[384 + tid];
            __syncthreads();
            const float rstd_q = 1.0f / sqrtf((red[0] + red[1] + red[2] + red[3]) * (1.0f / 256.f) + RMS_EPS);
            const float rstd_kv = 1.0f / sqrtf((red[4] + red[5]) * (1.0f / 128.f) + RMS_EPS);
            cqn[tid] = x * rstd_q * p.q_norm_a[l * 256 + tid];
            if (tid < 128) {
                const float cv = y * rstd_kv * p.kv_norm_a[l * 128 + tid];
                ckvn[tid] = cv;
                if (!sample) p.o_ckv[((size_t)(b * DEPTH + l) * T_P + t) * 128 + tid] = cv;
            }
            if (tid < 32 && !sample) p.o_krope[((size_t)(b * DEPTH + l) * T_P + t) * 32 + tid] = kr[tid];
        } else {
            const int idx = r - M; b = idx >> 8; t = idx & 255;
            if (tid < 128) ckvn[tid] = p.cache_ckv[((size_t)(b * DEPTH + l) * PAST + t) * 128 + tid];
            if (tid < 32) kr[tid] = p.cache_krope[((size_t)(b * DEPTH + l) * PAST + t) * 32 + tid];
        }
        __syncthreads();
        if (!isctx) {
            const float* wq = p.w_q_up + (size_t)l * 256 * 384;
            for (int n = tid; n < 384; n += 256) {
                float a = 0.f;
#pragma unroll 8
                for (int k = 0; k < 256; ++k) a += cqn[k] * wq[k * 384 + n];
                qraw[n] = a;
            }
        }
        {
            const float* wkv = p.w_kv_up + (size_t)l * 128 * 512;
            for (int n = tid; n < 512; n += 256) {
                float a = 0.f;
#pragma unroll 8
                for (int k = 0; k < 128; ++k) a += ckvn[k] * wkv[k * 512 + n];
                kvraw[n] = a;
            }
        }
        __syncthreads();
        if (tid < 8) {
            const int h = tid & 3; float ss = 0.f;
            if (tid < 4) { if (!isctx) for (int d = 0; d < 96; ++d) { const float v = qraw[h * 96 + d]; ss += v * v; } }
            else { for (int d = 0; d < 64; ++d) { const float v = kvraw[h * 128 + d]; ss += v * v; } for (int d = 0; d < 32; ++d) ss += kr[d] * kr[d]; }
            rs[tid] = 1.0f / sqrtf(ss * (1.0f / 96.f) + RMS_EPS);
        }
        __syncthreads();
        const bool rope = sample && !isctx;
        const int tr = rope ? t : 0;
        const float* cs = p.ROPE + tr * 16; const float* sn = p.ROPE + 1024 * 16 + tr * 16;
        const float* qn0 = p.qk_norm + (size_t)(l * 2 + 0) * 96; const float* qn1 = p.qk_norm + (size_t)(l * 2 + 1) * 96;
        if (!isctx) {
            for (int e = tid; e < 384; e += 256) {
                const int h = e / 96, d = e % 96;
                float v = qraw[e] * rs[h] * qn0[d];
                if (rope && d >= 64) {
                    if (d < 80) { const int i = d - 64; const float x2 = qraw[e + 16] * rs[h] * qn0[d + 16]; v = v * cs[i] - x2 * sn[i]; }
                    else { const int i = d - 80; const float x1 = qraw[e - 16] * rs[h] * qn0[d - 16]; v = v * cs[i] + x1 * sn[i]; }
                }
                p.Q[(size_t)r * 384 + e] = v;
            }
        }
        float *Kd, *Vd;
        if (isctx) { Kd = p.KS + ((size_t)(b * 4) * NKS + T_S + t) * 96; Vd = p.VS + ((size_t)(b * 4) * NKS + T_S + t) * 64; }
        else if (sample) { Kd = p.KS + ((size_t)(b * 4) * NKS + t) * 96; Vd = p.VS + ((size_t)(b * 4) * NKS + t) * 64; }
        else { Kd = p.KP + ((size_t)(b * 4) * T_P + t) * 96; Vd = p.VP + ((size_t)(b * 4) * T_P + t) * 64; }
        const size_t hstrK = (size_t)((isctx || sample) ? NKS : T_P) * 96, hstrV = (size_t)((isctx || sample) ? NKS : T_P) * 64;
        for (int e = tid; e < 384; e += 256) {
            const int h = e / 96, d = e % 96;
            const float raw = (d < 64) ? kvraw[h * 128 + d] : kr[d - 64];
            float v = raw * rs[4 + h] * qn1[d];
            if (rope && d >= 64) {
                if (d < 80) { const int i = d - 64; const float x2 = kr[d + 16 - 64] * rs[4 + h] * qn1[d + 16]; v = v * cs[i] - x2 * sn[i]; }
                else { const int i = d - 80; const float x1 = kr[d - 16 - 64] * rs[4 + h] * qn1[d - 16]; v = v * cs[i] + x1 * sn[i]; }
            }
            Kd[h * hstrK + d] = v;
        }
        {
            const int h = tid >> 6, d = tid & 63;
            Vd[h * hstrV + d] = kvraw[h * 128 + 64 + d];
        }
        __syncthreads();
    }
}

__global__ void __launch_bounds__(256) k_attn(P p) {
    const int NI = NB_P * 4 * T_P + NB_S * 4 * T_S;
    const float scale = 0.10206207261596577f;
    for (int idx = blockIdx.x * blockDim.x + threadIdx.x; idx < NI; idx += gridDim.x * blockDim.x) {
        int r, h, nk; const float *Kb, *Vb;
        if (idx < NB_P * 4 * T_P) { const int b = idx >> 10; h = (idx >> 8) & 3; const int t = idx & 255; r = b * T_P + t; nk = T_P;
            Kb = p.KP + (size_t)(b * 4 + h) * T_P * 96; Vb = p.VP + (size_t)(b * 4 + h) * T_P * 64; }
        else { const int j = idx - NB_P * 4 * T_P; const int b = j >> 12; h = (j >> 10) & 3; const int t = j & 1023; r = M_P + b * T_S + t; nk = NKS;
            Kb = p.KS + (size_t)(b * 4 + h) * NKS * 96; Vb = p.VS + (size_t)(b * 4 + h) * NKS * 64; }
        float q[96];
        const float4* qp = (const float4*)(p.Q + (size_t)r * 384 + h * 96);
#pragma unroll
        for (int i = 0; i < 24; ++i) { const float4 v = qp[i]; q[4 * i] = v.x * scale; q[4 * i + 1] = v.y * scale; q[4 * i + 2] = v.z * scale; q[4 * i + 3] = v.w * scale; }
        float acc[64];
#pragma unroll
        for (int i = 0; i < 64; ++i) acc[i] = 0.f;
        float mx = -1e30f, den = 0.f;
        for (int s = 0; s < nk; ++s) {
            const float4* kp = (const float4*)(Kb + (size_t)s * 96);
            float dot = 0.f;
#pragma unroll
            for (int i = 0; i < 24; ++i) { const float4 kv = kp[i]; dot += q[4 * i] * kv.x + q[4 * i + 1] * kv.y + q[4 * i + 2] * kv.z + q[4 * i + 3] * kv.w; }
            const float mn = fmaxf(mx, dot);
            const float corr = expf(mx - mn), pr = expf(dot - mn);
            den = den * corr + pr;
            const float4* vp = (const float4*)(Vb + (size_t)s * 64);
#pragma unroll
            for (int i = 0; i < 16; ++i) { const float4 vv = vp[i];
                acc[4 * i] = acc[4 * i] * corr + pr * vv.x; acc[4 * i + 1] = acc[4 * i + 1] * corr + pr * vv.y;
                acc[4 * i + 2] = acc[4 * i + 2] * corr + pr * vv.z; acc[4 * i + 3] = acc[4 * i + 3] * corr + pr * vv.w; }
            mx = mn;
        }
        const float inv = 1.0f / den;
        float4* op = (float4*)(p.OCAT + (size_t)r * D + 512 + h * 64);
#pragma unroll
        for (int i = 0; i < 16; ++i) op[i] = make_float4(acc[4 * i] * inv, acc[4 * i + 1] * inv, acc[4 * i + 2] * inv, acc[4 * i + 3] * inv);
    }
}

__global__ void __launch_bounds__(256) k_hgrn_scan(P p, int l) {
    const int lane = threadIdx.x & 63, wpb = blockDim.x >> 6;
    for (int item = blockIdx.x * wpb + (threadIdx.x >> 6); item < 18 * 8; item += gridDim.x * wpb) {
        const int seq = item >> 3, dir = (item >> 2) & 1, h = item & 3;
        const bool prompt = seq < NB_P;
        const int T = prompt ? T_P : T_S, row0 = prompt ? seq * T_P : M_P + (seq - NB_P) * T_S;
        float S[64];
        if (prompt) {
#pragma unroll
            for (int k = 0; k < 64; ++k) S[k] = 0.f;
        } else {
            const float* s0 = p.state_hgrn + ((size_t)(((seq - NB_P) * DEPTH + l) * 2 + dir) * 4 + h) * 4096;
#pragma unroll
            for (int k = 0; k < 64; ++k) S[k] = s0[k * 64 + lane];
        }
        const float lbv = p.LB[(l * 2 + dir) * 256 + h * 64 + lane];
        for (int step = 0; step < T; ++step) {
            const int t = dir ? T - 1 - step : step;
            const float* u = p.U + (size_t)(row0 + t) * INC + HG_OFF;
            const float qv = u[h * 64 + lane] * 0.125f;
            const float vi = u[256 + h * 64 + lane];
            const float z = u[768 + dir * 256 + h * 64 + lane];
            const float fv = lbv + (1.f - lbv) * sigmoidf_(z);
            float o = 0.f;
#pragma unroll
            for (int k = 0; k < 64; ++k) {
                const float fk = __shfl(fv, k), qk = __shfl(qv, k);
                S[k] = fk * S[k] + (1.f - fk) * vi;
                o += qk * S[k];
            }
            p.OH[((size_t)dir * M + row0 + t) * 256 + h * 64 + lane] = o;
        }
        if (prompt) {
            float* so = p.o_shg + ((size_t)((seq * DEPTH + l) * 2 + dir) * 4 + h) * 4096;
#pragma unroll
            for (int k = 0; k < 64; ++k) so[k * 64 + lane] = S[k];
        }
    }
}

__global__ void __launch_bounds__(256) k_gdn_prep(P p, int l) {
    const int tid = threadIdx.x;
    for (int r = blockIdx.x; r < M; r += gridDim.x) {
        int ci, T, row0, t, b; row_info(r, ci, T, row0, t, b);
        const float* u = p.U + (size_t)r * INC + GD_OFF;
        const float* cw = p.gdn_conv_w + (size_t)l * 3 * 768;
        float val[3];
#pragma unroll
        for (int part = 0; part < 3; ++part) {
            const int ch = part * 256 + tid;
            float a = cw[768 + ch] * u[ch];
            if (t > 0) a += cw[ch] * u[ch - INC];
            if (t < T - 1) a += cw[2 * 768 + ch] * u[ch + INC];
            val[part] = siluf_(a);
        }
        const float sq = wave_sum(val[0] * val[0]), sk = wave_sum(val[1] * val[1]);
        p.GQ[(size_t)r * 256 + tid] = val[0] * (1.0f / sqrtf(sq + 1e-6f)) * 0.125f;
        p.GK[(size_t)r * 256 + tid] = val[1] * (1.0f / sqrtf(sk + 1e-6f));
        p.GV[(size_t)r * 256 + tid] = val[2];
        if (tid < 8) {
            const float a = u[1024 + tid], bb = u[1032 + tid];
            const float x = a + p.gdn_dt_bias[l * 8 + tid];
            const float sp = (x > 20.f) ? x : log1pf(expf(x));
            p.GLA[(size_t)r * 8 + tid] = -expf(p.gdn_a_log[l * 8 + tid]) * sp;
            p.GBT[(size_t)r * 8 + tid] = sigmoidf_(bb);
        }
    }
}

__global__ void __launch_bounds__(256) k_gdn_scan(P p, int l) {
    const int lane = threadIdx.x & 63, wpb = blockDim.x >> 6;
    for (int item = blockIdx.x * wpb + (threadIdx.x >> 6); item < 18 * 8; item += gridDim.x * wpb) {
        const int seq = item >> 3, dir = (item >> 2) & 1, h = item & 3;
        const bool prompt = seq < NB_P;
        const int T = prompt ? T_P : T_S, row0 = prompt ? seq * T_P : M_P + (seq - NB_P) * T_S;
        float S[64];
        if (prompt) {
#pragma unroll
            for (int k = 0; k < 64; ++k) S[k] = 0.f;
        } else {
            const float* s0 = p.state_gdn + ((size_t)(((seq - NB_P) * DEPTH + l) * 2 + dir) * 4 + h) * 4096;
#pragma unroll
            for (int k = 0; k < 64; ++k) S[k] = s0[k * 64 + lane];
        }
        for (int step = 0; step < T; ++step) {
            const int t = dir ? T - 1 - step : step;
            const size_t r = (size_t)(row0 + t);
            const float qv = p.GQ[r * 256 + h * 64 + lane], kv = p.GK[r * 256 + h * 64 + lane], vi = p.GV[r * 256 + h * 64 + lane];
            const float a = expf(p.GLA[r * 8 + dir * 4 + h]), beta = p.GBT[r * 8 + dir * 4 + h];
            float kS = 0.f;
#pragma unroll
            for (int k = 0; k < 64; ++k) kS += __shfl(kv, k) * S[k];
            const float cc = beta * (vi - a * kS);
            float o = 0.f;
#pragma unroll
            for (int k = 0; k < 64; ++k) { S[k] = a * S[k] + __shfl(kv, k) * cc; o += __shfl(qv, k) * S[k]; }
            p.OG[((size_t)dir * M + r) * 256 + h * 64 + lane] = o;
        }
        if (prompt) {
            float* so = p.o_sgd + ((size_t)((seq * DEPTH + l) * 2 + dir) * 4 + h) * 4096;
#pragma unroll
            for (int k = 0; k < 64; ++k) so[k * 64 + lane] = S[k];
        }
    }
}

__global__ void __launch_bounds__(256) k_headnorm(P p, int l) {
    const int lane = threadIdx.x & 63, wpb = blockDim.x >> 6;
    for (int item = blockIdx.x * wpb + (threadIdx.x >> 6); item < M * 8; item += gridDim.x * wpb) {
        const int r = item >> 3, which = (item >> 2) & 1, h = item & 3;
        const int c = h * 64 + lane;
        const float* O = which ? p.OG : p.OH;
        const float o = O[(size_t)r * 256 + c] + O[((size_t)M + r) * 256 + c];
        const float ss = wave_sum(o * o);
        const float rstd = 1.0f / sqrtf(ss * (1.0f / 64.f) + RMS_EPS);
        const float gn = which ? p.gdn_norm[l * 64 + lane] : p.hgrn_norm[l * 256 + c];
        const float g = which ? p.U[(size_t)r * INC + GD_OFF + 768 + c] : p.U[(size_t)r * INC + HG_OFF + 512 + c];
        p.OCAT[(size_t)r * D + (which ? 768 : 0) + c] = o * rstd * gn * siluf_(g);
    }
}

__global__ void __launch_bounds__(256) k_hy_prep(P p, int l) {
    const int tid = threadIdx.x;
    for (int r = blockIdx.x; r < M; r += gridDim.x) {
        int ci, T, row0, t, b; row_info(r, ci, T, row0, t, b);
        const float* u = p.U + (size_t)r * INC + HY_OFF;
        const float* cw = p.hy_conv_w + (size_t)l * 3 * 768;
        const float* cb = p.hy_conv_b + (size_t)l * 768;
        float val[3];
#pragma unroll
        for (int part = 0; part < 3; ++part) {
            const int ch = part * 256 + tid;
            float a = cw[768 + ch] * u[ch] + cb[ch];
            if (t > 0) a += cw[ch] * u[ch - INC];
            if (t < T - 1) a += cw[2 * 768 + ch] * u[ch + INC];
            val[part] = a;
        }
        p.X0[(size_t)r * 256 + tid] = val[0];
        p.Z[(size_t)r * 256 + tid] = val[1] * val[2];
    }
}

__global__ void __launch_bounds__(256) k_hyena(P p, int l) {
    const int tid = threadIdx.x;
    for (int r = blockIdx.x; r < M; r += gridDim.x) {
        int ci, T, row0, t, b; row_info(r, ci, T, row0, t, b);
        const float* base = p.FILT + (size_t)l * FILT_L + (r >= M_P ? (size_t)2 * 256 * 256 : 0);
        const float* hf = base; const float* hb = base + (size_t)T * 256;
        const float* z = p.Z + (size_t)row0 * 256 + tid;
        float y = 0.f;
        for (int s = 0; s <= t; ++s) y += hf[(size_t)(t - s) * 256 + tid] * z[(size_t)s * 256];
        for (int s = t + 1; s < T; ++s) y += hb[(size_t)(s - t) * 256 + tid] * z[(size_t)s * 256];
        const float zz = z[(size_t)t * 256];
        p.OCAT[(size_t)r * D + 256 + tid] = p.X0[(size_t)r * 256 + tid] * (y + zz * p.hy_skip[l * 256 + tid]);
    }
}

}

extern "C" void kernel_launch(void* const* d_in, const int* in_sizes, int n_in, void* d_out, int out_size, void* d_ws, size_t ws_size, hipStream_t stream) {
    P p{};
    const float* const* in = (const float* const*)d_in;
    p.x_prompt = in[0]; p.x_sample = in[1]; p.cache_ckv = in[2]; p.cache_krope = in[3]; p.state_hgrn = in[4]; p.state_gdn = in[5]; p.c = in[6]; p.c_ctx = in[7];
    p.w_ada = in[8]; p.b_ada = in[9]; p.norm_ffn = in[10]; p.w_gu = in[11]; p.w_down = in[12]; p.norm_mix = in[13]; p.w_in = in[14]; p.w_out = in[15];
    p.hgrn_lb = in[16]; p.hgrn_norm = in[17]; p.hy_conv_w = in[18]; p.hy_conv_b = in[19]; p.hy_w1 = in[20]; p.hy_b1 = in[21]; p.hy_freq = in[22];
    p.hy_w2 = in[23]; p.hy_b2 = in[24]; p.hy_w3 = in[25]; p.hy_skip = in[26]; p.q_norm_a = in[27]; p.w_q_up = in[28]; p.kv_norm_a = in[29];
    p.w_kv_up = in[30]; p.qk_norm = in[31]; p.gdn_conv_w = in[32]; p.gdn_a_log = in[33]; p.gdn_dt_bias = in[34]; p.gdn_norm = in[35];
    float* out = (float*)d_out;
    p.X = out;
    p.o_ckv = out + (size_t)M * D;
    p.o_krope = p.o_ckv + (size_t)NB_P * DEPTH * T_P * 128;
    p.o_shg = p.o_krope + (size_t)NB_P * DEPTH * T_P * 32;
    p.o_sgd = p.o_shg + (size_t)NB_P * DEPTH * 2 * 4 * 64 * 64;
    float* w = (float*)d_ws;
    auto take = [&](size_t n) { float* r = w; w += (n + 63) & ~(size_t)63; return r; };
    p.ADA = take((size_t)DEPTH * 3 * NADA * D);
    p.LB = take(DEPTH * 512);
    p.FILT = take(DEPTH * FILT_L);
    p.ROPE = take(2 * 1024 * 16);
    p.H = take((size_t)M * D);
    p.GU = take((size_t)M * 2 * DFF);
    p.ACT = take((size_t)M * DFF);
    p.TMP = take((size_t)M * D);
    p.U = take((size_t)M * INC);
    p.Q = take((size_t)M * 384);
    p.KP = take((size_t)NB_P * 4 * T_P * 96); p.VP = take((size_t)NB_P * 4 * T_P * 64);
    p.KS = take((size_t)NB_S * 4 * NKS * 96); p.VS = take((size_t)NB_S * 4 * NKS * 64);
    p.GQ = take((size_t)M * 256); p.GK = take((size_t)M * 256); p.GV = take((size_t)M * 256);
    p.GLA = take((size_t)M * 8); p.GBT = take((size_t)M * 8);
    p.Z = take((size_t)M * 256); p.X0 = take((size_t)M * 256);
    p.OH = take((size_t)2 * M * 256); p.OG = take((size_t)2 * M * 256);
    p.OCAT = take((size_t)M * D);

    const dim3 B(256), G(1024);
    k_init<<<G, B, 0, stream>>>(p);
    k_ada<<<144, B, 0, stream>>>(p);
    k_small<<<64, B, 0, stream>>>(p);
    k_filt<<<DEPTH * 1280, 64, 0, stream>>>(p);
    for (int l = 0; l < DEPTH; ++l) {
        for (int f = 0; f < 2; ++f) {
            if (f == 1) {
                k_norm<<<G, B, 0, stream>>>(p, l, 1);
                k_gemm<<<2048, B, 0, stream>>>(p.H, p.w_in + (size_t)l * D * INC, p.U, M, INC, D);
                k_mla_prep<<<2048, B, 0, stream>>>(p, l);
                k_gdn_prep<<<2048, B, 0, stream>>>(p, l);
                k_hy_prep<<<2048, B, 0, stream>>>(p, l);
                k_attn<<<96, B, 0, stream>>>(p);
                k_hgrn_scan<<<36, B, 0, stream>>>(p, l);
                k_gdn_scan<<<36, B, 0, stream>>>(p, l);
                k_hyena<<<2048, B, 0, stream>>>(p, l);
                k_headnorm<<<2048, B, 0, stream>>>(p, l);
                k_gemm<<<2048, B, 0, stream>>>(p.OCAT, p.w_out + (size_t)l * D * D, p.TMP, M, D, D);
                k_resid<<<G, B, 0, stream>>>(p, l, 5, 1.0f);
            }
            const int s = f == 0 ? 0 : 2;
            k_norm<<<G, B, 0, stream>>>(p, l, s);
            k_gemm<<<2048, B, 0, stream>>>(p.H, p.w_gu + (size_t)(l * 2 + f) * D * 2 * DFF, p.GU, M, 2 * DFF, D);
            k_swiglu<<<G, B, 0, stream>>>(p);
            k_gemm<<<2048, B, 0, stream>>>(p.ACT, p.w_down + (size_t)(l * 2 + f) * DFF * D, p.TMP, M, D, DFF);
            k_resid<<<G, B, 0, stream>>>(p, l, 3 * s + 2, 0.5f);
        }
    }
}
```

```cpp
#include <hip/hip_runtime.h>
#include <hip/hip_cooperative_groups.h>
#include <stdint.h>
#include <math.h>
#include <cstdio>
namespace cg = cooperative_groups;

namespace pg8 {
#define PG8_LAS __attribute__((address_space(3)))
typedef unsigned short bf16_t;
typedef short bf16x8 __attribute__((ext_vector_type(8)));
typedef float f32x4 __attribute__((ext_vector_type(4)));
typedef unsigned u32x4 __attribute__((ext_vector_type(4)));
constexpr int BM = 256, BK = 64, HALF = 128, HTB = HALF * BK * 2  , STAGE_BYTES = 8 * HTB, NXCD = 8, WGM = 8;

__host__ __device__ __forceinline__ int lds_byte(int r, int c) { const int st = (r >> 4) * 2 + (c >> 5), rr = r & 15, cc = c & 31, ob = rr * 64 + cc * 2; return st * 1024 + (ob ^ (((ob >> 9) & 1) << 5)); }
__host__ __device__ __forceinline__ void stage_rc(int b, int& R, int& C) { const int st = b / 1024, sb = b % 1024, swz = sb ^ (((sb >> 9) & 1) << 5); R = (st >> 1) * 16 + swz / 64; C = (st & 1) * 32 + (swz % 64) / 2; }
__host__ __device__ __forceinline__ int perm32(int rho) { const int n = rho >> 4, i = rho & 15; return 8 * (i >> 2) + 4 * n + (i & 3); }

struct Unit { int pm, pn; };
struct Gemm { const bf16_t* A; const bf16_t* Bt; int M, N, K; };

struct StaticOrder {
    int nM, nN, nwg, G, c;
    __host__ __device__ void init(int M, int N, int G_, int c_) { nM = M / BM; nN = N / BM; nwg = nM * nN; G = G_; c = c_; }
    __host__ __device__ bool next(int i, Unit& u) const {
        const long L = (long)i * G + c; if (L >= nwg) return false;
        int wgid = (int)L; { const int q = nwg / NXCD, r = nwg % NXCD, xcd = wgid % NXCD, off = wgid / NXCD; wgid = (xcd < r ? xcd * (q + 1) : r * (q + 1) + (xcd - r) * q) + off; }
        const int nig = WGM * nN, gid = wgid / nig, fm = gid * WGM, gsz = (nM - fm) < WGM ? (nM - fm) : WGM;
        u.pm = fm + ((wgid % nig) % gsz); u.pn = (wgid % nig) / gsz; return true;
    }
    __device__ __forceinline__ void a_ready(const Unit&) const {}
    __device__ __forceinline__ void done(const Unit&) const {}
};

__device__ __forceinline__ unsigned cvt_pk_bf16(float lo, float hi) { unsigned r; asm volatile("v_cvt_pk_bf16_f32 %0, %1, %2" : "=v"(r) : "v"(lo), "v"(hi)); return r; }

template <class Epi, class Sched, bool ALIGN_EPI = false, bool SP2 = false>
__device__ __forceinline__ void gemm_phase(PG8_LAS unsigned char* lds, const Gemm g, const Sched& S, const Epi& E) {
    int tid_ = threadIdx.x; asm volatile("" : "+v"(tid_));
    const int tid = tid_, wid = __builtin_amdgcn_readfirstlane(tid >> 6), lane = tid & 63, wr = wid >> 2, wc = wid & 3, fr = lane & 15, fq = lane >> 4;
    const int K = g.K, nt = K / BK;
    unsigned voffA[2], voffB[2];
#pragma unroll
    for (int i = 0; i < 2; ++i) { int R, C; stage_rc(tid * 16 + i * 8192, R, C); const int Rb = Epi::PERM ? ((R & ~31) + perm32(R & 31)) : R;
        voffA[i] = (unsigned)(R * K + C) * 2u; voffB[i] = (unsigned)(Rb * K + C) * 2u; }
    const size_t kstep = (size_t)(BK * 2);
    const size_t hstep = (size_t)HALF * K * 2;
    const size_t tstep = 2 * hstep;
    const unsigned ldsw = (unsigned)wid * 1024u;
    const int aoff = lds_byte(wr * 64 + fr, fq * 8), boff = lds_byte(wc * 32 + fr, fq * 8);
#define PG8_SA(b, h) (((b) * 2 + (h)) * HTB)
#define PG8_SB(b, h) ((4 + (b) * 2 + (h)) * HTB)
#define PG8_STAGE(bufoff, gbase, voff) do { _Pragma("unroll") for (int _i = 0; _i < 2; ++_i) \
        __builtin_amdgcn_global_load_lds((const unsigned*)((const char*)(gbase) + (voff)[_i]), (PG8_LAS unsigned*)(lds + (bufoff) + ldsw + _i * 8192), 16, 0, 0); } while (0)
#define PG8_LDA(dst, b, h) do { _Pragma("unroll") for (int m = 0; m < 4; ++m) _Pragma("unroll") for (int k = 0; k < 2; ++k) dst[m][k] = *(const PG8_LAS bf16x8*)(lds + PG8_SA(b, h) + aoff + m * 2048 + k * 1024); } while (0)
#define PG8_LDB(dst, b, h) do { _Pragma("unroll") for (int n = 0; n < 2; ++n) _Pragma("unroll") for (int k = 0; k < 2; ++k) dst[n][k] = *(const PG8_LAS bf16x8*)(lds + PG8_SB(b, h) + boff + n * 2048 + k * 1024); } while (0)
#define PG8_MMA(ai, bj, At, Bt) do { __builtin_amdgcn_s_setprio(1); _Pragma("unroll") for (int m = 0; m < 4; ++m) _Pragma("unroll") for (int n = 0; n < 2; ++n) _Pragma("unroll") for (int k = 0; k < 2; ++k) \
        acc[ai][bj][m][n] = __builtin_amdgcn_mfma_f32_16x16x32_bf16(Bt[n][k], At[m][k], acc[ai][bj][m][n], 0, 0, 0); __builtin_amdgcn_s_setprio(0); } while (0)
#define PG8_WAIT_V(n) asm volatile("s_waitcnt vmcnt(" #n ")" ::: "memory")
#define PG8_WAIT_L(n) asm volatile("s_waitcnt lgkmcnt(" #n ")" ::: "memory")
#define PG8_BAR __builtin_amdgcn_s_barrier()
#define PG8_SCHED __builtin_amdgcn_sched_barrier(0)
    Unit cur, nxt; int ui = 0;
    if (!S.next(0, cur)) return;
    f32x4 acc[2][2][4][2];
#pragma unroll
    for (int a = 0; a < 2; ++a)
#pragma unroll
        for (int b = 0; b < 2; ++b)
#pragma unroll
            for (int m = 0; m < 4; ++m)
#pragma unroll
                for (int n = 0; n < 2; ++n) acc[a][b][m][n] = (f32x4){0.f, 0.f, 0.f, 0.f};
    bf16x8 At[4][2], B0[2][2], B1[2][2];
    const char* cA = (const char*)g.A + (size_t)cur.pm * tstep; const char* cB = (const char*)g.Bt + (size_t)cur.pn * tstep;
    S.a_ready(cur);
    if constexpr (SP2) {
        PG8_STAGE(PG8_SB(0, 0), cB, voffB); PG8_STAGE(PG8_SB(0, 1), cB + hstep, voffB); PG8_STAGE(PG8_SA(0, 0), cA, voffA); PG8_STAGE(PG8_SA(0, 1), cA + hstep, voffA);
        if (wr == 1) PG8_BAR;
        PG8_WAIT_V(2); PG8_BAR;
        PG8_STAGE(PG8_SB(1, 0), cB + kstep, voffB); PG8_STAGE(PG8_SA(1, 0), cA + kstep, voffA); PG8_STAGE(PG8_SB(1, 1), cB + hstep + kstep, voffB);
        PG8_WAIT_V(6); PG8_BAR;
    } else {
        PG8_STAGE(PG8_SB(0, 0), cB, voffB); PG8_STAGE(PG8_SA(0, 0), cA, voffA); PG8_STAGE(PG8_SB(0, 1), cB + hstep, voffB); PG8_STAGE(PG8_SA(0, 1), cA + hstep, voffA);
        if (wr == 1) PG8_BAR;
        PG8_WAIT_V(4); PG8_BAR;
        PG8_STAGE(PG8_SB(1, 0), cB + kstep, voffB); PG8_STAGE(PG8_SA(1, 0), cA + kstep, voffA); PG8_STAGE(PG8_SB(1, 1), cB + hstep + kstep, voffB);
        PG8_WAIT_V(6); PG8_BAR;
    }
    for (;;) {
        const bool has_next = S.next(ui + 1, nxt);
        const char* nA = has_next ? (const char*)g.A + (size_t)nxt.pm * tstep : cA; const char* nB = has_next ? (const char*)g.Bt + (size_t)nxt.pn * tstep : cB;
        for (int t = 0; t < nt; t += 2) {
            const bool last = (t == nt - 2);
            const char* a1 = cA + (size_t)(t + 1) * kstep;
            const char* a2 = last ? nA : cA + (size_t)(t + 2) * kstep; const char* b2 = last ? nB : cB + (size_t)(t + 2) * kstep;
            const char* a3 = a2 + kstep; const char* b3 = b2 + kstep;
            if (last && has_next) S.a_ready(nxt);
            if constexpr (SP2) {
            PG8_LDB(B0, 0, 0); PG8_LDB(B1, 0, 1); PG8_SCHED; PG8_LDA(At, 0, 0); PG8_STAGE(PG8_SA(1, 1), a1 + hstep, voffA);
            PG8_WAIT_V(8); PG8_WAIT_L(0); PG8_BAR; PG8_MMA(0, 0, At, B0); PG8_MMA(0, 1, At, B1); PG8_BAR; PG8_SCHED;
            PG8_LDA(At, 0, 1); PG8_STAGE(PG8_SB(0, 0), b2, voffB); PG8_STAGE(PG8_SB(0, 1), b2 + hstep, voffB); PG8_STAGE(PG8_SA(0, 0), a2, voffA);
            PG8_WAIT_V(8); PG8_WAIT_L(0); PG8_BAR; PG8_MMA(1, 0, At, B0); PG8_MMA(1, 1, At, B1); PG8_BAR; PG8_SCHED;
            PG8_LDB(B0, 1, 0); PG8_LDB(B1, 1, 1); PG8_SCHED; PG8_LDA(At, 1, 0); PG8_STAGE(PG8_SA(0, 1), a2 + hstep, voffA);
            PG8_WAIT_V(8); PG8_WAIT_L(0); PG8_BAR; PG8_MMA(0, 0, At, B0); PG8_MMA(0, 1, At, B1); PG8_BAR; PG8_SCHED;
            PG8_LDA(At, 1, 1); PG8_STAGE(PG8_SB(1, 0), b3, voffB); PG8_STAGE(PG8_SB(1, 1), b3 + hstep, voffB); PG8_STAGE(PG8_SA(1, 0), a3, voffA);
            PG8_WAIT_V(8); PG8_WAIT_L(0); PG8_BAR; PG8_MMA(1, 0, At, B0); PG8_MMA(1, 1, At, B1); PG8_BAR; PG8_SCHED;
            } else {
            PG8_LDB(B0, 0, 0); PG8_SCHED; PG8_LDA(At, 0, 0); PG8_STAGE(PG8_SA(1, 1), a1 + hstep, voffA);
            PG8_WAIT_L(8); PG8_BAR; PG8_WAIT_L(0); PG8_MMA(0, 0, At, B0); PG8_BAR; PG8_SCHED;
            PG8_LDB(B1, 0, 1); PG8_STAGE(PG8_SB(0, 0), b2, voffB);
            PG8_BAR; PG8_WAIT_L(0); PG8_MMA(0, 1, At, B1); PG8_BAR;
            PG8_LDA(At, 0, 1); PG8_STAGE(PG8_SA(0, 0), a2, voffA);
            PG8_BAR; PG8_WAIT_L(0); PG8_MMA(1, 0, At, B0); PG8_BAR; PG8_SCHED;
            PG8_STAGE(PG8_SB(0, 1), b2 + hstep, voffB);
            PG8_WAIT_V(6); PG8_BAR; PG8_MMA(1, 1, At, B1); PG8_BAR;
            PG8_LDB(B0, 1, 0); PG8_SCHED; PG8_LDA(At, 1, 0); PG8_STAGE(PG8_SA(0, 1), a2 + hstep, voffA);
            PG8_WAIT_L(8); PG8_BAR; PG8_WAIT_L(0); PG8_MMA(0, 0, At, B0); PG8_BAR; PG8_SCHED;
            PG8_LDB(B1, 1, 1); PG8_STAGE(PG8_SB(1, 0), b3, voffB);
            PG8_BAR; PG8_WAIT_L(0); PG8_MMA(0, 1, At, B1); PG8_BAR;
            PG8_LDA(At, 1, 1); PG8_STAGE(PG8_SA(1, 0), a3, voffA);
            PG8_BAR; PG8_WAIT_L(0); PG8_MMA(1, 0, At, B0); PG8_BAR; PG8_SCHED;
            PG8_STAGE(PG8_SB(1, 1), b3 + hstep, voffB);
            PG8_WAIT_V(6); PG8_BAR; PG8_MMA(1, 1, At, B1); PG8_BAR;
            }
        }
        if constexpr (ALIGN_EPI) { if (wr == 0) PG8_BAR; }
        if constexpr (!Epi::AFTER_DRAIN) { E(acc, cur, wr, wc, fr, fq); S.done(cur); }
        if (!has_next) break;
#pragma unroll
        for (int a = 0; a < 2; ++a)
#pragma unroll
            for (int b = 0; b < 2; ++b)
#pragma unroll
                for (int m = 0; m < 4; ++m)
#pragma unroll
                    for (int n = 0; n < 2; ++n) acc[a][b][m][n] = (f32x4){0.f, 0.f, 0.f, 0.f};
        cur = nxt; cA = nA; cB = nB; ++ui;
        if constexpr (ALIGN_EPI) { if (wr == 1) PG8_BAR; }
    }
    PG8_WAIT_V(0);
    if constexpr (!ALIGN_EPI) { if (wr == 0) PG8_BAR; }
    PG8_BAR;
    if constexpr (Epi::AFTER_DRAIN) { E.fused(acc, cur, wr, wc, fr, fq, lds, wid, lane); S.done(cur); }
#undef PG8_SA
#undef PG8_SB
#undef PG8_STAGE
#undef PG8_LDA
#undef PG8_LDB
#undef PG8_MMA
#undef PG8_WAIT_V
#undef PG8_WAIT_L
#undef PG8_BAR
#undef PG8_SCHED
}
}

namespace {
#define LAS __attribute__((address_space(3)))
typedef unsigned short bf16;
typedef float f32x4 __attribute__((ext_vector_type(4)));
typedef unsigned u32x4 __attribute__((ext_vector_type(4)));
typedef unsigned u32x2 __attribute__((ext_vector_type(2)));

constexpr int NTHREADS = 512;
constexpr int D = 1024, NB_P = 16, T_P = 256, NB_S = 2, T_S = 1024, DEPTH = 4, PAST = 256;
constexpr int M_P = NB_P * T_P, M_S = NB_S * T_S, M = M_P + M_S;
constexpr int DFF = 2816, NADA = 9, INC = 3504, INCP = 3584;
constexpr int HG_OFF = 0, HY_OFF = 1280, MLA_OFF = 2048, GD_OFF = 2464;
constexpr int NKS = T_S + PAST;
constexpr float RMS_EPS = 1e-6f;
constexpr int LDS_BYTES = 147456;
constexpr size_t FILT_L = 2 * (256 + 1024) * 256;

struct P {
    const float *x_prompt, *x_sample, *cache_ckv, *cache_krope, *state_hgrn, *state_gdn, *c, *c_ctx;
    const float *w_ada, *b_ada, *norm_ffn, *w_gu, *w_down, *norm_mix, *w_in, *w_out, *hgrn_lb, *hgrn_norm;
    const float *hy_conv_w, *hy_conv_b, *hy_w1, *hy_b1, *hy_freq, *hy_w2, *hy_b2, *hy_w3, *hy_skip;
    const float *q_norm_a, *w_q_up, *kv_norm_a, *w_kv_up, *qk_norm, *gdn_conv_w, *gdn_a_log, *gdn_dt_bias, *gdn_norm;
    float *X;
    float *o_ckv, *o_krope, *o_shg, *o_sgd;
    float *ADA;
    float *LB;
    float *FILT;
    float *ROPE;
    bf16 *WGU;
    bf16 *WDN;
    bf16 *WIN;
    bf16 *WOUT;
    bf16 *H;
    bf16 *ACT;
    bf16 *OCAT;
    float *U;
    float *Q;
    float *KP, *VP;
    float *KS, *VS;
    float *GQ, *GK, *GV;
    float *GLA, *GBT;
    float *Z, *X0;
    float *OH, *OG;
};

typedef const __attribute__((address_space(4))) P* KP;
#define FRESH_P() ({ KP k_ = (KP)__builtin_amdgcn_kernarg_segment_ptr(); asm volatile("" : "+s"(k_)); k_; })
__device__ __forceinline__ int otid() { int t = threadIdx.x; asm volatile("" : "+v"(t)); return t; }
__device__ __forceinline__ float sigmoidf_(float x) { return 1.f / (1.f + expf(-x)); }
__device__ __forceinline__ float siluf_(float x) { return x / (1.f + expf(-x)); }
__device__ __forceinline__ unsigned f2bf(float f) { unsigned u = __builtin_bit_cast(unsigned, f); return (u + 0x7fffu + ((u >> 16) & 1u)) >> 16; }
__device__ __forceinline__ unsigned pk2(float lo, float hi) { return f2bf(lo) | (f2bf(hi) << 16); }

__device__ __forceinline__ void row_info(int r, int& ci, int& T, int& row0, int& t, int& b) {
    if (r < M_P) { b = r >> 8; t = r & 255; T = T_P; row0 = b << 8; ci = 0; }
    else { const int rr = r - M_P; b = rr >> 10; t = rr & 1023; T = T_S; row0 = M_P + (b << 10); ci = 1 + b; }
}
__device__ __forceinline__ int panel_ci(int pm) { return pm < 16 ? 0 : 1 + ((pm - 16) >> 2); }

__device__ __forceinline__ float wave_sum(float v, int lane) {
#pragma unroll
    for (int o = 1; o < 64; o <<= 1) v += __builtin_bit_cast(float, __builtin_amdgcn_ds_bpermute((lane ^ o) << 2, __builtin_bit_cast(int, v)));
    return v;
}
__device__ __forceinline__ float bcast(float v, int k) { return __builtin_bit_cast(float, __builtin_amdgcn_readlane(__builtin_bit_cast(int, v), k)); }

struct EpiSwiGLU {
    static constexpr bool PERM = true, AFTER_DRAIN = false;
    bf16* O;
    __device__ __forceinline__ void operator()(const f32x4 (&acc)[2][2][4][2], const pg8::Unit& u, int wr, int wc, int fr, int fq) const {
        const int row0 = u.pm * 256 + wr * 64 + fr, col0 = u.pn * 128 + wc * 32 + 8 * fq;
#pragma unroll
        for (int ai = 0; ai < 2; ++ai)
#pragma unroll
            for (int m = 0; m < 4; ++m) {
                bf16* rowp = O + (size_t)(row0 + ai * 128 + m * 16) * DFF + col0;
                float v[8];
#pragma unroll
                for (int n = 0; n < 2; ++n)
#pragma unroll
                    for (int i = 0; i < 4; ++i) { const float g = acc[ai][0][m][n][i], up = acc[ai][1][m][n][i];
                        v[4 * n + i] = g * __builtin_amdgcn_rcpf(1.f + __expf(-g)) * up; }
                u32x4 w; w.x = pg8::cvt_pk_bf16(v[0], v[1]); w.y = pg8::cvt_pk_bf16(v[2], v[3]); w.z = pg8::cvt_pk_bf16(v[4], v[5]); w.w = pg8::cvt_pk_bf16(v[6], v[7]);
                *(u32x4*)rowp = w;
            }
    }
};
struct EpiF32 {
    static constexpr bool PERM = false, AFTER_DRAIN = false;
    float* C; int ldc;
    __device__ __forceinline__ void operator()(const f32x4 (&acc)[2][2][4][2], const pg8::Unit& u, int wr, int wc, int fr, int fq) const {
        const int row0 = u.pm * 256 + wr * 64 + fr, col0 = u.pn * 256 + wc * 32 + 4 * fq;
#pragma unroll
        for (int ai = 0; ai < 2; ++ai)
#pragma unroll
            for (int m = 0; m < 4; ++m) { float* rowp = C + (size_t)(row0 + ai * 128 + m * 16) * ldc + col0;
#pragma unroll
                for (int bj = 0; bj < 2; ++bj)
#pragma unroll
                    for (int n = 0; n < 2; ++n) *(f32x4*)(rowp + bj * 128 + n * 16) = acc[ai][bj][m][n]; }
    }
};
struct EpiResid {
    static constexpr bool PERM = false, AFTER_DRAIN = false;
    float* X; const float* gate; float coef;
    __device__ __forceinline__ void operator()(const f32x4 (&acc)[2][2][4][2], const pg8::Unit& u, int wr, int wc, int fr, int fq) const {
        const int row0 = u.pm * 256 + wr * 64 + fr, col0 = u.pn * 256 + wc * 32 + 4 * fq;
        const float* g = gate + (size_t)panel_ci(u.pm) * NADA * D + col0;
        f32x4 gv[2][2];
#pragma unroll
        for (int bj = 0; bj < 2; ++bj)
#pragma unroll
            for (int n = 0; n < 2; ++n) gv[bj][n] = *(const f32x4*)(g + bj * 128 + n * 16) * coef;
#pragma unroll
        for (int ai = 0; ai < 2; ++ai)
#pragma unroll
            for (int m = 0; m < 4; ++m) { float* rowp = X + (size_t)(row0 + ai * 128 + m * 16) * D + col0;
#pragma unroll
                for (int bj = 0; bj < 2; ++bj)
#pragma unroll
                    for (int n = 0; n < 2; ++n) { f32x4* q = (f32x4*)(rowp + bj * 128 + n * 16); *q = *q + gv[bj][n] * acc[ai][bj][m][n]; } }
    }
};

__device__ __forceinline__ void ph_init(KP p) {
    const int tix = otid();
    const int n4 = M * D / 4, np4 = M_P * D / 4;
    for (int i = blockIdx.x * NTHREADS + tix; i < n4; i += gridDim.x * NTHREADS) {
        const float4 v = (i < np4) ? ((const float4*)p->x_prompt)[i] : ((const float4*)p->x_sample)[i - np4];
        ((float4*)p->X)[i] = v;
    }
}

__device__ __forceinline__ void ph_ada(KP p, LAS float* sc  ) {
    const int tix = otid();
    for (int i = tix; i < 3 * 1024; i += NTHREADS) {
        const int ci = i >> 10, k = i & 1023;
        const float v = (ci == 0) ? p->c_ctx[k] : p->c[(ci - 1) * 1024 + k];
        sc[i] = siluf_(v);
    }
    __syncthreads();
    const int NJ = NADA * D;
    for (int idx = blockIdx.x * NTHREADS + tix; idx < DEPTH * NJ; idx += gridDim.x * NTHREADS) {
        const int l = idx / NJ, j = idx % NJ;
        const float* w = p->w_ada + (size_t)l * D * NJ + j;
        float a0 = 0.f, a1 = 0.f, a2 = 0.f;
#pragma unroll 8
        for (int k = 0; k < D; ++k) { const float wv = w[(size_t)k * NJ]; a0 += sc[k] * wv; a1 += sc[1024 + k] * wv; a2 += sc[2048 + k] * wv; }
        const float bb = p->b_ada[l * NJ + j];
        p->ADA[(size_t)(l * 3 + 0) * NJ + j] = a0 + bb;
        p->ADA[(size_t)(l * 3 + 1) * NJ + j] = a1 + bb;
        p->ADA[(size_t)(l * 3 + 2) * NJ + j] = a2 + bb;
    }
    __syncthreads();
}

__device__ __forceinline__ void ph_small(KP p) {
    const int tix = otid();
    const int gt = blockIdx.x * NTHREADS + tix, gn = gridDim.x * NTHREADS;
    for (int i = gt; i < 512; i += gn) {
        float v[4], mx = -1e30f;
        for (int l = 0; l < 4; ++l) { v[l] = p->hgrn_lb[l * 512 + i]; mx = fmaxf(mx, v[l]); }
        float s = 0.f;
        for (int l = 0; l < 4; ++l) { v[l] = expf(v[l] - mx); s += v[l]; }
        float cum = 0.f;
        for (int l = 0; l < 4; ++l) { if (l > 0) cum += v[l] / s; p->LB[l * 512 + i] = cum; }
    }
    for (int i = gt; i < 1024 * 16; i += gn) {
        const int t = i >> 4, j = i & 15;
        const int row = t >> 6, col = t & 63;
        const double inv = pow(10000.0, -(double)(j & 7) / 8.0);
        const double ang = (double)((j < 8) ? row : col) * inv;
        p->ROPE[i] = (float)cos(ang);
        p->ROPE[1024 * 16 + i] = (float)sin(ang);
    }
}

__device__ __forceinline__ void ph_filt(KP p, LAS double* scr  ) {
    const int tix = otid();
    const int lane = tix & 63, wv = tix >> 6;
    LAS double* ze = scr + wv * 168; LAS double* h1 = ze + 40; LAS double* h2 = h1 + 64;
    const int NIT = DEPTH * 1280, gw = blockIdx.x * 8 + wv, NGW = gridDim.x * 8;
    const int trips = (NIT + NGW - 1) / NGW;
    for (int it = 0; it < trips; ++it) {
        const int item = it * NGW + gw; const bool act = item < NIT;
        const int l = act ? item / 1280 : 0, q = act ? item % 1280 : 0;
        const int set = (q < 256) ? 0 : 1, pos = set ? q - 256 : q, L = set ? 1024 : 256;
        const double t = (double)pos / (double)(L - 1);
        if (lane == 0) ze[0] = t;
        if (lane < 16) {
            const double band = 1e-4 + (double)lane * ((15.0 - 1e-4) / 15.0);
            const double ang = (2.0 * 3.14159265358979323846 / (double)L) * (double)pos * band;
            ze[1 + lane] = cos(ang);
            ze[17 + lane] = -sin(ang);
        }
        __syncthreads();
        const double fr = (double)p->hy_freq[l * 64 + lane];
        {
            double a = (double)p->hy_b1[l * 64 + lane];
            for (int i = 0; i < 33; ++i) a += ze[i] * (double)p->hy_w1[(l * 33 + i) * 64 + lane];
            h1[lane] = sin(fr * a);
        }
        __syncthreads();
        {
            double a = (double)p->hy_b2[l * 64 + lane];
            for (int i = 0; i < 64; ++i) a += h1[i] * (double)p->hy_w2[(l * 64 + i) * 64 + lane];
            h2[lane] = sin(fr * a);
        }
        __syncthreads();
        if (act) {
            float* base = p->FILT + (size_t)l * FILT_L + (set ? (size_t)2 * 256 * 256 : 0);
            const size_t hb_off = (size_t)L * 256;
            const double max_decay = log(1e-2) / 0.3, min_decay = log(1e-2) / 1.5;
            for (int n = lane; n < 512; n += 64) {
                double a = 0.0;
                for (int i = 0; i < 64; ++i) a += h2[i] * (double)p->hy_w3[(size_t)(l * 64 + i) * 512 + n];
                const int c = n & 255;
                const double delta = min_decay + (double)c * ((max_decay - min_decay) / 255.0);
                const double win = exp(-t * fabs(delta));
                base[(n < 256 ? 0 : hb_off) + (size_t)pos * 256 + c] = (float)(a * win);
            }
        }
        __syncthreads();
    }
}

__device__ __forceinline__ void transpose_item(const float* W, int K, int N, bf16* WT, int dst_row, LAS float* scr, int k0, int n0, int lane) {
    const int nn = n0 + (lane & 31);
#pragma unroll 8
    for (int i = 0; i < 32; ++i) { const int kk = 2 * i + (lane >> 5); scr[kk * 33 + (lane & 31)] = (nn < N) ? W[(size_t)(k0 + kk) * N + nn] : 0.f; }
    asm volatile("s_waitcnt lgkmcnt(0)" ::: "memory");
    const int c = lane & 7;
#pragma unroll
    for (int j = 0; j < 4; ++j) { const int n = (lane >> 3) + 8 * j; const LAS float* s = scr + (8 * c) * 33 + n;
        u32x4 o; o.x = pk2(s[0 * 33], s[1 * 33]); o.y = pk2(s[2 * 33], s[3 * 33]); o.z = pk2(s[4 * 33], s[5 * 33]); o.w = pk2(s[6 * 33], s[7 * 33]);
        *(u32x4*)(WT + (size_t)(dst_row + n) * K + k0 + 8 * c) = o; }
    asm volatile("s_waitcnt lgkmcnt(0)" ::: "memory");
}
__device__ __forceinline__ void ph_wprep(KP p, LAS float* scr_all) {
    const int tix = otid();
    const int lane = tix & 63, wv = tix >> 6;
    LAS float* scr = scr_all + wv * (64 * 33);
    const int gw = blockIdx.x * 8 + wv, NGW = gridDim.x * 8;
    constexpr int I_GU = 16 * 176, I_DN = 44 * 32, I_IN = 16 * 112, I_OUT = 16 * 32, I_L = 2 * I_GU + 2 * I_DN + I_IN + I_OUT;
    for (int it = gw; it < DEPTH * I_L; it += NGW) {
        const int l = it / I_L; int r = it % I_L;
        if (r < 2 * I_GU) { const int f = r / I_GU, rr = r % I_GU, kb = rr / 176, nb = rr % 176, n0 = nb * 32;
            const int j = n0 < DFF ? n0 : n0 - DFF; const int dst = 256 * (j >> 7) + (n0 < DFF ? 0 : 128) + (j & 127);
            transpose_item(p->w_gu + (size_t)(l * 2 + f) * D * 2 * DFF, D, 2 * DFF, p->WGU + (size_t)(l * 2 + f) * 2 * DFF * D, dst, scr, kb * 64, n0, lane); continue; }
        r -= 2 * I_GU;
        if (r < 2 * I_DN) { const int f = r / I_DN, rr = r % I_DN, kb = rr / 32, nb = rr % 32;
            transpose_item(p->w_down + (size_t)(l * 2 + f) * DFF * D, DFF, D, p->WDN + (size_t)(l * 2 + f) * D * DFF, nb * 32, scr, kb * 64, nb * 32, lane); continue; }
        r -= 2 * I_DN;
        if (r < I_IN) { const int kb = r / 112, nb = r % 112;
            transpose_item(p->w_in + (size_t)l * D * INC, D, INC, p->WIN + (size_t)l * INCP * D, nb * 32, scr, kb * 64, nb * 32, lane); continue; }
        r -= I_IN;
        { const int kb = r / 32, nb = r % 32;
            transpose_item(p->w_out + (size_t)l * D * D, D, D, p->WOUT + (size_t)l * D * D, nb * 32, scr, kb * 64, nb * 32, lane); }
    }
}

__device__ __forceinline__ void ph_norm(KP p, int l, int s) {
    const int tix = otid();
    const int lane = tix & 63, wv = tix >> 6;
    const float* g = (s == 1) ? p->norm_mix + l * D : p->norm_ffn + (size_t)(l * 2 + (s == 2 ? 1 : 0)) * D;
    for (int r = blockIdx.x * 8 + wv; r < M; r += gridDim.x * 8) {
        int ci, T, row0, t, b; row_info(r, ci, T, row0, t, b);
        const float* ada = p->ADA + (size_t)(l * 3 + ci) * NADA * D;
        const float* shift = ada + (3 * s + 0) * D;
        const float* scale = ada + (3 * s + 1) * D;
        const float4* xr = (const float4*)(p->X + (size_t)r * D);
        float4 v[4]; float ss = 0.f;
#pragma unroll
        for (int j = 0; j < 4; ++j) { v[j] = xr[lane + 64 * j]; ss += v[j].x * v[j].x + v[j].y * v[j].y + v[j].z * v[j].z + v[j].w * v[j].w; }
        ss = wave_sum(ss, lane);
        const float rstd = 1.0f / sqrtf(ss * (1.0f / D) + RMS_EPS);
        u32x2* hr = (u32x2*)(p->H + (size_t)r * D);
#pragma unroll
        for (int j = 0; j < 4; ++j) {
            const int c4 = lane + 64 * j;
            const float4 gg = ((const float4*)g)[c4], sh = ((const float4*)shift)[c4], scl = ((const float4*)scale)[c4];
            const float ox = v[j].x * rstd * gg.x * (1.f + scl.x) + sh.x;
            const float oy = v[j].y * rstd * gg.y * (1.f + scl.y) + sh.y;
            const float oz = v[j].z * rstd * gg.z * (1.f + scl.z) + sh.z;
            const float ow = v[j].w * rstd * gg.w * (1.f + scl.w) + sh.w;
            u32x2 o; o.x = pk2(ox, oy); o.y = pk2(oz, ow);
            hr[c4] = o;
        }
    }
}

__device__ __forceinline__ void ph_mla_prep(KP p, int l, LAS float* lds_f) {
    const int tix = otid();
    const int sub = tix >> 8, tid = tix & 255, lane = tid & 63, wv = tid >> 6;
    LAS float* base = lds_f + sub * 1344;
    LAS float* cqn = base; LAS float* ckvn = base + 256; LAS float* kr = base + 384; LAS float* qraw = base + 416; LAS float* kvraw = base + 800;
    LAS float* red = base + 1312; LAS float* rs = base + 1320;
    const int NIT = M + NB_S * PAST, vb = blockIdx.x * 2 + sub, NVB = gridDim.x * 2;
    const int trips = (NIT + NVB - 1) / NVB;
    for (int it = 0; it < trips; ++it) {
        const int r = it * NVB + vb; const bool act = r < NIT;
        const bool isctx = act && r >= M;
        int ci = 0, T = 0, row0 = 0, t = 0, b = 0;
        bool sample = false;
        float x = 0.f, y = 0.f;
        if (act && !isctx) {
            row_info(r, ci, T, row0, t, b); sample = r >= M_P;
            const float* u = p->U + (size_t)r * INCP + MLA_OFF;
            x = u[tid];
            if (tid < 128) y = u[256 + tid];
            if (tid < 32) kr[tid] = u[384 + tid];
        }
        {
            const float ss = wave_sum(x * x, lane);
            if (lane == 0) red[wv] = ss;
            const float s2 = wave_sum(y * y, lane);
            if (lane == 0) red[4 + wv] = s2;
        }
        __syncthreads();
        if (act && !isctx) {
            const float rstd_q = 1.0f / sqrtf((red[0] + red[1] + red[2] + red[3]) * (1.0f / 256.f) + RMS_EPS);
            const float rstd_kv = 1.0f / sqrtf((red[4] + red[5]) * (1.0f / 128.f) + RMS_EPS);
            cqn[tid] = x * rstd_q * p->q_norm_a[l * 256 + tid];
            if (tid < 128) {
                const float cv = y * rstd_kv * p->kv_norm_a[l * 128 + tid];
                ckvn[tid] = cv;
                if (!sample) p->o_ckv[((size_t)(b * DEPTH + l) * T_P + t) * 128 + tid] = cv;
            }
            if (tid < 32 && !sample) p->o_krope[((size_t)(b * DEPTH + l) * T_P + t) * 32 + tid] = kr[tid];
        } else if (isctx) {
            const int idx = r - M; b = idx >> 8; t = idx & 255;
            if (tid < 128) ckvn[tid] = p->cache_ckv[((size_t)(b * DEPTH + l) * PAST + t) * 128 + tid];
            if (tid < 32) kr[tid] = p->cache_krope[((size_t)(b * DEPTH + l) * PAST + t) * 32 + tid];
        }
        __syncthreads();
        if (act && !isctx) {
            const float* wq = p->w_q_up + (size_t)l * 256 * 384;
            for (int n = tid; n < 384; n += 256) {
                float a = 0.f;
#pragma unroll 8
                for (int k = 0; k < 256; ++k) a += cqn[k] * wq[k * 384 + n];
                qraw[n] = a;
            }
        }
        if (act) {
            const float* wkv = p->w_kv_up + (size_t)l * 128 * 512;
            for (int n = tid; n < 512; n += 256) {
                float a = 0.f;
#pragma unroll 8
                for (int k = 0; k < 128; ++k) a += ckvn[k] * wkv[k * 512 + n];
                kvraw[n] = a;
            }
        }
        __syncthreads();
        if (act && tid < 8) {
            const int h = tid & 3; float ss = 0.f;
            if (tid < 4) { if (!isctx) for (int d = 0; d < 96; ++d) { const float v = qraw[h * 96 + d]; ss += v * v; } }
            else { for (int d = 0; d < 64; ++d) { const float v = kvraw[h * 128 + d]; ss += v * v; } for (int d = 0; d < 32; ++d) ss += kr[d] * kr[d]; }
            rs[tid] = 1.0f / sqrtf(ss * (1.0f / 96.f) + RMS_EPS);
        }
        __syncthreads();
        if (act) {
            const bool rope = sample && !isctx;
            const int tr = rope ? t : 0;
            const float* cs = p->ROPE + tr * 16; const float* sn = p->ROPE + 1024 * 16 + tr * 16;
            const float* qn0 = p->qk_norm + (size_t)(l * 2 + 0) * 96; const float* qn1 = p->qk_norm + (size_t)(l * 2 + 1) * 96;
            if (!isctx) {
                for (int e = tid; e < 384; e += 256) {
                    const int h = e / 96, d = e % 96;
                    float v = qraw[e] * rs[h] * qn0[d];
                    if (rope && d >= 64) {
                        if (d < 80) { const int i = d - 64; const float x2 = qraw[e + 16] * rs[h] * qn0[d + 16]; v = v * cs[i] - x2 * sn[i]; }
                        else { const int i = d - 80; const float x1 = qraw[e - 16] * rs[h] * qn0[d - 16]; v = v * cs[i] + x1 * sn[i]; }
                    }
                    p->Q[(size_t)r * 384 + e] = v;
                }
            }
            float *Kd, *Vd;
            if (isctx) { Kd = p->KS + ((size_t)(b * 4) * NKS + T_S + t) * 96; Vd = p->VS + ((size_t)(b * 4) * NKS + T_S + t) * 64; }
            else if (sample) { Kd = p->KS + ((size_t)(b * 4) * NKS + t) * 96; Vd = p->VS + ((size_t)(b * 4) * NKS + t) * 64; }
            else { Kd = p->KP + ((size_t)(b * 4) * T_P + t) * 96; Vd = p->VP + ((size_t)(b * 4) * T_P + t) * 64; }
            const size_t hstrK = (size_t)((isctx || sample) ? NKS : T_P) * 96, hstrV = (size_t)((isctx || sample) ? NKS : T_P) * 64;
            for (int e = tid; e < 384; e += 256) {
                const int h = e / 96, d = e % 96;
                const float raw = (d < 64) ? kvraw[h * 128 + d] : kr[d - 64];
                float v = raw * rs[4 + h] * qn1[d];
                if (rope && d >= 64) {
                    if (d < 80) { const int i = d - 64; const float x2 = kr[d + 16 - 64] * rs[4 + h] * qn1[d + 16]; v = v * cs[i] - x2 * sn[i]; }
                    else { const int i = d - 80; const float x1 = kr[d - 16 - 64] * rs[4 + h] * qn1[d - 16]; v = v * cs[i] + x1 * sn[i]; }
                }
                Kd[h * hstrK + d] = v;
            }
            {
                const int h = tid >> 6, d = tid & 63;
                Vd[h * hstrV + d] = kvraw[h * 128 + 64 + d];
            }
        }
        __syncthreads();
    }
}

__device__ __forceinline__ void ph_gdn_hy_prep(KP p, int l) {
    const int tix = otid();
    const int sub = tix >> 8, tid = tix & 255, lane = tix & 63;
    for (int r = blockIdx.x * 2 + sub; r < M; r += gridDim.x * 2) {
        int ci, T, row0, t, b; row_info(r, ci, T, row0, t, b);
        {
            const float* u = p->U + (size_t)r * INCP + GD_OFF;
            const float* cw = p->gdn_conv_w + (size_t)l * 3 * 768;
            float val[3];
#pragma unroll
            for (int part = 0; part < 3; ++part) {
                const int ch = part * 256 + tid;
                float a = cw[768 + ch] * u[ch];
                if (t > 0) a += cw[ch] * u[ch - INCP];
                if (t < T - 1) a += cw[2 * 768 + ch] * u[ch + INCP];
                val[part] = siluf_(a);
            }
            const float sq = wave_sum(val[0] * val[0], lane), sk = wave_sum(val[1] * val[1], lane);
            p->GQ[(size_t)r * 256 + tid] = val[0] * (1.0f / sqrtf(sq + 1e-6f)) * 0.125f;
            p->GK[(size_t)r * 256 + tid] = val[1] * (1.0f / sqrtf(sk + 1e-6f));
            p->GV[(size_t)r * 256 + tid] = val[2];
            if (tid < 8) {
                const float a = u[1024 + tid], bb = u[1032 + tid];
                const float x = a + p->gdn_dt_bias[l * 8 + tid];
                const float sp = (x > 20.f) ? x : log1pf(expf(x));
                p->GLA[(size_t)r * 8 + tid] = -expf(p->gdn_a_log[l * 8 + tid]) * sp;
                p->GBT[(size_t)r * 8 + tid] = sigmoidf_(bb);
            }
        }
        {
            const float* u = p->U + (size_t)r * INCP + HY_OFF;
            const float* cw = p->hy_conv_w + (size_t)l * 3 * 768;
            const float* cb = p->hy_conv_b + (size_t)l * 768;
            float val[3];
#pragma unroll
            for (int part = 0; part < 3; ++part) {
                const int ch = part * 256 + tid;
                float a = cw[768 + ch] * u[ch] + cb[ch];
                if (t > 0) a += cw[ch] * u[ch - INCP];
                if (t < T - 1) a += cw[2 * 768 + ch] * u[ch + INCP];
                val[part] = a;
            }
            p->X0[(size_t)r * 256 + tid] = val[0];
            p->Z[(size_t)r * 256 + tid] = val[1] * val[2];
        }
    }
}

__device__ __forceinline__ void ph_attn(KP p) {
    const int tix = otid();
    const int NI = NB_P * 4 * T_P + NB_S * 4 * T_S;
    const float scale = 0.10206207261596577f;
    for (int idx = blockIdx.x * NTHREADS + tix; idx < NI; idx += gridDim.x * NTHREADS) {
        int r, h, nk; const float *Kb, *Vb;
        if (idx < NB_P * 4 * T_P) { const int b = idx >> 10; h = (idx >> 8) & 3; const int t = idx & 255; r = b * T_P + t; nk = T_P;
            Kb = p->KP + (size_t)(b * 4 + h) * T_P * 96; Vb = p->VP + (size_t)(b * 4 + h) * T_P * 64; }
        else { const int j = idx - NB_P * 4 * T_P; const int b = j >> 12; h = (j >> 10) & 3; const int t = j & 1023; r = M_P + b * T_S + t; nk = NKS;
            Kb = p->KS + (size_t)(b * 4 + h) * NKS * 96; Vb = p->VS + (size_t)(b * 4 + h) * NKS * 64; }
        float q[96];
        const float4* qp = (const float4*)(p->Q + (size_t)r * 384 + h * 96);
#pragma unroll
        for (int i = 0; i < 24; ++i) { const float4 v = qp[i]; q[4 * i] = v.x * scale; q[4 * i + 1] = v.y * scale; q[4 * i + 2] = v.z * scale; q[4 * i + 3] = v.w * scale; }
        float acc[64];
#pragma unroll
        for (int i = 0; i < 64; ++i) acc[i] = 0.f;
        float mx = -1e30f, den = 0.f;
        for (int s = 0; s < nk; ++s) {
            const float4* kp = (const float4*)(Kb + (size_t)s * 96);
            float dot = 0.f;
#pragma unroll
            for (int i = 0; i < 24; ++i) { const float4 kv = kp[i]; dot += q[4 * i] * kv.x + q[4 * i + 1] * kv.y + q[4 * i + 2] * kv.z + q[4 * i + 3] * kv.w; }
            const float mn = fmaxf(mx, dot);
            const float corr = expf(mx - mn), pr = expf(dot - mn);
            den = den * corr + pr;
            const float4* vp = (const float4*)(Vb + (size_t)s * 64);
#pragma unroll
            for (int i = 0; i < 16; ++i) { const float4 vv = vp[i];
                acc[4 * i] = acc[4 * i] * corr + pr * vv.x; acc[4 * i + 1] = acc[4 * i + 1] * corr + pr * vv.y;
                acc[4 * i + 2] = acc[4 * i + 2] * corr + pr * vv.z; acc[4 * i + 3] = acc[4 * i + 3] * corr + pr * vv.w; }
            mx = mn;
        }
        const float inv = 1.0f / den;
        u32x2* op = (u32x2*)(p->OCAT + (size_t)r * D + 512 + h * 64);
#pragma unroll
        for (int i = 0; i < 16; ++i) { u32x2 o; o.x = pk2(acc[4 * i] * inv, acc[4 * i + 1] * inv); o.y = pk2(acc[4 * i + 2] * inv, acc[4 * i + 3] * inv); op[i] = o; }
    }
}

__device__ __forceinline__ void scan_hgrn(KP p, int l, int item, int lane) {
    const int seq = item >> 3, dir = (item >> 2) & 1, h = item & 3;
    const bool prompt = seq < NB_P;
    const int T = prompt ? T_P : T_S, row0 = prompt ? seq * T_P : M_P + (seq - NB_P) * T_S;
    float S[64];
    if (prompt) {
#pragma unroll
        for (int k = 0; k < 64; ++k) S[k] = 0.f;
    } else {
        const float* s0 = p->state_hgrn + ((size_t)(((seq - NB_P) * DEPTH + l) * 2 + dir) * 4 + h) * 4096;
#pragma unroll
        for (int k = 0; k < 64; ++k) S[k] = s0[k * 64 + lane];
    }
    const float lbv = p->LB[(l * 2 + dir) * 256 + h * 64 + lane];
    for (int step = 0; step < T; ++step) {
        const int t = dir ? T - 1 - step : step;
        const float* u = p->U + (size_t)(row0 + t) * INCP + HG_OFF;
        const float qv = u[h * 64 + lane] * 0.125f;
        const float vi = u[256 + h * 64 + lane];
        const float z = u[768 + dir * 256 + h * 64 + lane];
        const float fv = lbv + (1.f - lbv) * sigmoidf_(z);
        float o = 0.f;
#pragma unroll
        for (int k = 0; k < 64; ++k) {
            const float fk = bcast(fv, k), qk = bcast(qv, k);
            S[k] = fk * S[k] + (1.f - fk) * vi;
            o += qk * S[k];
        }
        p->OH[((size_t)dir * M + row0 + t) * 256 + h * 64 + lane] = o;
    }
    if (prompt) {
        float* so = p->o_shg + ((size_t)((seq * DEPTH + l) * 2 + dir) * 4 + h) * 4096;
#pragma unroll
        for (int k = 0; k < 64; ++k) so[k * 64 + lane] = S[k];
    }
}
__device__ __forceinline__ void scan_gdn(KP p, int l, int item, int lane) {
    const int seq = item >> 3, dir = (item >> 2) & 1, h = item & 3;
    const bool prompt = seq < NB_P;
    const int T = prompt ? T_P : T_S, row0 = prompt ? seq * T_P : M_P + (seq - NB_P) * T_S;
    float S[64];
    if (prompt) {
#pragma unroll
        for (int k = 0; k < 64; ++k) S[k] = 0.f;
    } else {
        const float* s0 = p->state_gdn + ((size_t)(((seq - NB_P) * DEPTH + l) * 2 + dir) * 4 + h) * 4096;
#pragma unroll
        for (int k = 0; k < 64; ++k) S[k] = s0[k * 64 + lane];
    }
    for (int step = 0; step < T; ++step) {
        const int t = dir ? T - 1 - step : step;
        const size_t r = (size_t)(row0 + t);
        const float qv = p->GQ[r * 256 + h * 64 + lane], kv = p->GK[r * 256 + h * 64 + lane], vi = p->GV[r * 256 + h * 64 + lane];
        const float a = expf(p->GLA[r * 8 + dir * 4 + h]), beta = p->GBT[r * 8 + dir * 4 + h];
        float kS = 0.f;
#pragma unroll
        for (int k = 0; k < 64; ++k) kS += bcast(kv, k) * S[k];
        const float cc = beta * (vi - a * kS);
        float o = 0.f;
#pragma unroll
        for (int k = 0; k < 64; ++k) { S[k] = a * S[k] + bcast(kv, k) * cc; o += bcast(qv, k) * S[k]; }
        p->OG[((size_t)dir * M + r) * 256 + h * 64 + lane] = o;
    }
    if (prompt) {
        float* so = p->o_sgd + ((size_t)((seq * DEPTH + l) * 2 + dir) * 4 + h) * 4096;
#pragma unroll
        for (int k = 0; k < 64; ++k) so[k * 64 + lane] = S[k];
    }
}
__device__ __forceinline__ void ph_scans(KP p, int l) {
    const int tix = otid();
    const int lane = tix & 63, wv = tix >> 6;
    const int gw = wv * gridDim.x + blockIdx.x;
    for (int item = gw; item < 2 * 144; item += gridDim.x * 8) {
        if (item < 144) scan_hgrn(p, l, item, lane); else scan_gdn(p, l, item - 144, lane);
    }
}

__device__ __forceinline__ void ph_headnorm(KP p, int l) {
    const int tix = otid();
    const int lane = tix & 63, wv = tix >> 6;
    for (int item = blockIdx.x * 8 + wv; item < M * 8; item += gridDim.x * 8) {
        const int r = item >> 3, which = (item >> 2) & 1, h = item & 3;
        const int c = h * 64 + lane;
        const float* O = which ? p->OG : p->OH;
        const float o = O[(size_t)r * 256 + c] + O[((size_t)M + r) * 256 + c];
        const float ss = wave_sum(o * o, lane);
        const float rstd = 1.0f / sqrtf(ss * (1.0f / 64.f) + RMS_EPS);
        const float gn = which ? p->gdn_norm[l * 64 + lane] : p->hgrn_norm[l * 256 + c];
        const float g = which ? p->U[(size_t)r * INCP + GD_OFF + 768 + c] : p->U[(size_t)r * INCP + HG_OFF + 512 + c];
        p->OCAT[(size_t)r * D + (which ? 768 : 0) + c] = (bf16)f2bf(o * rstd * gn * siluf_(g));
    }
}

__device__ __forceinline__ void ph_hyena(KP p, int l) {
    const int tix = otid();
    const int sub = tix >> 8, tid = tix & 255;
    for (int r = blockIdx.x * 2 + sub; r < M; r += gridDim.x * 2) {
        int ci, T, row0, t, b; row_info(r, ci, T, row0, t, b);
        const float* base = p->FILT + (size_t)l * FILT_L + (r >= M_P ? (size_t)2 * 256 * 256 : 0);
        const float* hf = base; const float* hb = base + (size_t)T * 256;
        const float* z = p->Z + (size_t)row0 * 256 + tid;
        float y = 0.f;
        for (int s = 0; s <= t; ++s) y += hf[(size_t)(t - s) * 256 + tid] * z[(size_t)s * 256];
        for (int s = t + 1; s < T; ++s) y += hb[(size_t)(s - t) * 256 + tid] * z[(size_t)s * 256];
        const float zz = z[(size_t)t * 256];
        p->OCAT[(size_t)r * D + 256 + tid] = (bf16)f2bf(p->X0[(size_t)r * 256 + tid] * (y + zz * p->hy_skip[l * 256 + tid]));
    }
}

__global__ void __launch_bounds__(NTHREADS, 2) fwd_megakernel(P p) {
    extern __shared__ __attribute__((aligned(16))) unsigned char lds_raw[];
    LAS unsigned char* lds = (LAS unsigned char*)lds_raw;
    cg::grid_group grid = cg::this_grid();
    const int G = gridDim.x;
#define GRID_SYNC() grid.sync()

    ph_init(FRESH_P());
#ifndef NO_ADA
    ph_ada(FRESH_P(), (LAS float*)lds);
#endif
#ifndef NO_SMALL
    ph_small(FRESH_P());
#endif
#ifndef NO_FILT
    ph_filt(FRESH_P(), (LAS double*)lds);
#endif
#ifndef NO_WPREP
    ph_wprep(FRESH_P(), (LAS float*)lds);
#endif
    GRID_SYNC();

#pragma unroll 1
    for (int l = 0; l < DEPTH; ++l) {
#pragma unroll 1
        for (int f = 0; f < 2; ++f) {
            if (f == 1) {
                ph_norm(FRESH_P(), l, 1);
                GRID_SYNC();
#ifndef NO_GIN
                { KP q = FRESH_P(); pg8::Gemm g{q->H, q->WIN + (size_t)l * INCP * D, M, INCP, D}; pg8::StaticOrder S; S.init(M, INCP, G, (int)blockIdx.x);
                  EpiF32 E{q->U, INCP};
                  pg8::gemm_phase<EpiF32, pg8::StaticOrder, true, true>(lds, g, S, E); }
#endif
                GRID_SYNC();
#ifndef NO_MLAP
                ph_mla_prep(FRESH_P(), l, (LAS float*)lds);
#endif
#ifndef NO_GHP
                ph_gdn_hy_prep(FRESH_P(), l);
#endif
                GRID_SYNC();
#ifndef NO_SCANS
                ph_scans(FRESH_P(), l);
#endif
#ifndef NO_ATTN
                ph_attn(FRESH_P());
#endif
#ifndef NO_HY
                ph_hyena(FRESH_P(), l);
#endif
                GRID_SYNC();
#ifndef NO_HN
                ph_headnorm(FRESH_P(), l);
#endif
                GRID_SYNC();
#ifndef NO_GOUT
                { KP q = FRESH_P(); pg8::Gemm g{q->OCAT, q->WOUT + (size_t)l * D * D, M, D, D}; pg8::StaticOrder S; S.init(M, D, G, (int)blockIdx.x);
                  EpiResid E{q->X, q->ADA + (size_t)(l * 3) * NADA * D + 5 * D, 1.0f};
                  pg8::gemm_phase<EpiResid, pg8::StaticOrder, true, true>(lds, g, S, E); }
#endif
                GRID_SYNC();
            }
            const int s = f == 0 ? 0 : 2;
            ph_norm(FRESH_P(), l, s);
            GRID_SYNC();
#ifndef NO_GGU
            { KP q = FRESH_P(); pg8::Gemm g{q->H, q->WGU + (size_t)(l * 2 + f) * 2 * DFF * D, M, 2 * DFF, D}; pg8::StaticOrder S; S.init(M, 2 * DFF, G, (int)blockIdx.x);
              EpiSwiGLU E{q->ACT};
              pg8::gemm_phase<EpiSwiGLU, pg8::StaticOrder, true, true>(lds, g, S, E); }
#endif
            GRID_SYNC();
#ifndef NO_GDN
            { KP q = FRESH_P(); pg8::Gemm g{q->ACT, q->WDN + (size_t)(l * 2 + f) * D * DFF, M, D, DFF}; pg8::StaticOrder S; S.init(M, D, G, (int)blockIdx.x);
              EpiResid E{q->X, q->ADA + (size_t)(l * 3) * NADA * D + (3 * s + 2) * D, 0.5f};
              pg8::gemm_phase<EpiResid, pg8::StaticOrder, true, true>(lds, g, S, E); }
#endif
            GRID_SYNC();
        }
    }
}

}

extern "C" void kernel_launch(void* const* d_in, const int* in_sizes, int n_in, void* d_out, int out_size, void* d_ws, size_t ws_size, hipStream_t stream) {
    P p{};
    const float* const* in = (const float* const*)d_in;
    p.x_prompt = in[0]; p.x_sample = in[1]; p.cache_ckv = in[2]; p.cache_krope = in[3]; p.state_hgrn = in[4]; p.state_gdn = in[5]; p.c = in[6]; p.c_ctx = in[7];
    p.w_ada = in[8]; p.b_ada = in[9]; p.norm_ffn = in[10]; p.w_gu = in[11]; p.w_down = in[12]; p.norm_mix = in[13]; p.w_in = in[14]; p.w_out = in[15];
    p.hgrn_lb = in[16]; p.hgrn_norm = in[17]; p.hy_conv_w = in[18]; p.hy_conv_b = in[19]; p.hy_w1 = in[20]; p.hy_b1 = in[21]; p.hy_freq = in[22];
    p.hy_w2 = in[23]; p.hy_b2 = in[24]; p.hy_w3 = in[25]; p.hy_skip = in[26]; p.q_norm_a = in[27]; p.w_q_up = in[28]; p.kv_norm_a = in[29];
    p.w_kv_up = in[30]; p.qk_norm = in[31]; p.gdn_conv_w = in[32]; p.gdn_a_log = in[33]; p.gdn_dt_bias = in[34]; p.gdn_norm = in[35];
    float* out = (float*)d_out;
    p.X = out;
    p.o_ckv = out + (size_t)M * D;
    p.o_krope = p.o_ckv + (size_t)NB_P * DEPTH * T_P * 128;
    p.o_shg = p.o_krope + (size_t)NB_P * DEPTH * T_P * 32;
    p.o_sgd = p.o_shg + (size_t)NB_P * DEPTH * 2 * 4 * 64 * 64;
    unsigned char* w = (unsigned char*)d_ws;
    auto take = [&](size_t bytes) { unsigned char* r = w; w += (bytes + 255) & ~(size_t)255; return r; };
    p.ADA = (float*)take((size_t)DEPTH * 3 * NADA * D * 4);
    p.LB = (float*)take(DEPTH * 512 * 4);
    p.FILT = (float*)take(DEPTH * FILT_L * 4);
    p.ROPE = (float*)take(2 * 1024 * 16 * 4);
    p.WGU = (bf16*)take((size_t)DEPTH * 2 * 2 * DFF * D * 2);
    p.WDN = (bf16*)take((size_t)DEPTH * 2 * D * DFF * 2);
    p.WIN = (bf16*)take((size_t)DEPTH * INCP * D * 2);
    p.WOUT = (bf16*)take((size_t)DEPTH * D * D * 2);
    p.H = (bf16*)take((size_t)M * D * 2);
    p.ACT = (bf16*)take((size_t)M * DFF * 2);
    p.OCAT = (bf16*)take((size_t)M * D * 2);
    p.U = (float*)take((size_t)M * INCP * 4);
    p.Q = (float*)take((size_t)M * 384 * 4);
    p.KP = (float*)take((size_t)NB_P * 4 * T_P * 96 * 4); p.VP = (float*)take((size_t)NB_P * 4 * T_P * 64 * 4);
    p.KS = (float*)take((size_t)NB_S * 4 * NKS * 96 * 4); p.VS = (float*)take((size_t)NB_S * 4 * NKS * 64 * 4);
    p.GQ = (float*)take((size_t)M * 256 * 4); p.GK = (float*)take((size_t)M * 256 * 4); p.GV = (float*)take((size_t)M * 256 * 4);
    p.GLA = (float*)take((size_t)M * 8 * 4); p.GBT = (float*)take((size_t)M * 8 * 4);
    p.Z = (float*)take((size_t)M * 256 * 4); p.X0 = (float*)take((size_t)M * 256 * 4);
    p.OH = (float*)take((size_t)2 * M * 256 * 4); p.OG = (float*)take((size_t)2 * M * 256 * 4);

    static int grid_blocks = 0;
    if (!grid_blocks) {
        int dev = 0, cus = 0, per_cu = 0;
        hipGetDevice(&dev);
        hipDeviceGetAttribute(&cus, hipDeviceAttributeMultiprocessorCount, dev);
        hipFuncSetAttribute((const void*)fwd_megakernel, hipFuncAttributeMaxDynamicSharedMemorySize, LDS_BYTES);
        hipOccupancyMaxActiveBlocksPerMultiprocessor(&per_cu, (const void*)fwd_megakernel, NTHREADS, LDS_BYTES);
        if (per_cu < 1) { fprintf(stderr, "kernel_launch: occupancy query reports %d blocks per CU\n", per_cu); per_cu = 1; }
        if (per_cu > 1) per_cu = 1;
        grid_blocks = cus * per_cu;
    }
    void* args[] = {&p};
    hipError_t e = hipLaunchCooperativeKernel((const void*)fwd_megakernel, dim3(grid_blocks), dim3(NTHREADS), args, LDS_BYTES, stream);
    if (e != hipSuccess) fprintf(stderr, "cooperative launch failed: %s (grid %d)\n", hipGetErrorString(e), grid_blocks);
}
```

```cpp
#include <hip/hip_runtime.h>
#include <hip/hip_cooperative_groups.h>
#include <stdint.h>
#include <math.h>
#include <cstdio>
namespace cg = cooperative_groups;

namespace pg8 {
#define PG8_LAS __attribute__((address_space(3)))
typedef unsigned short bf16_t;
typedef short bf16x8 __attribute__((ext_vector_type(8)));
typedef float f32x4 __attribute__((ext_vector_type(4)));
typedef unsigned u32x4 __attribute__((ext_vector_type(4)));
constexpr int BM = 256, BK = 64, HALF = 128, HTB = HALF * BK * 2  , STAGE_BYTES = 8 * HTB, NXCD = 8, WGM = 8;

__host__ __device__ __forceinline__ int lds_byte(int r, int c) { const int st = (r >> 4) * 2 + (c >> 5), rr = r & 15, cc = c & 31, ob = rr * 64 + cc * 2; return st * 1024 + (ob ^ (((ob >> 9) & 1) << 5)); }
__host__ __device__ __forceinline__ void stage_rc(int b, int& R, int& C) { const int st = b / 1024, sb = b % 1024, swz = sb ^ (((sb >> 9) & 1) << 5); R = (st >> 1) * 16 + swz / 64; C = (st & 1) * 32 + (swz % 64) / 2; }
__host__ __device__ __forceinline__ int perm32(int rho) { const int n = rho >> 4, i = rho & 15; return 8 * (i >> 2) + 4 * n + (i & 3); }

struct Unit { int pm, pn; };
struct Gemm { const bf16_t* A; const bf16_t* Bt; int M, N, K; };

struct StaticOrder {
    int nM, nN, nwg, G, c;
    __host__ __device__ void init(int M, int N, int G_, int c_) { nM = M / BM; nN = N / BM; nwg = nM * nN; G = G_; c = c_; }
    __host__ __device__ bool next(int i, Unit& u) const {
        const long L = (long)i * G + c; if (L >= nwg) return false;
        int wgid = (int)L; { const int q = nwg / NXCD, r = nwg % NXCD, xcd = wgid % NXCD, off = wgid / NXCD; wgid = (xcd < r ? xcd * (q + 1) : r * (q + 1) + (xcd - r) * q) + off; }
        const int nig = WGM * nN, gid = wgid / nig, fm = gid * WGM, gsz = (nM - fm) < WGM ? (nM - fm) : WGM;
        u.pm = fm + ((wgid % nig) % gsz); u.pn = (wgid % nig) / gsz; return true;
    }
    __device__ __forceinline__ void a_ready(const Unit&) const {}
    __device__ __forceinline__ void done(const Unit&) const {}
};

__device__ __forceinline__ unsigned cvt_pk_bf16(float lo, float hi) { unsigned r; asm volatile("v_cvt_pk_bf16_f32 %0, %1, %2" : "=v"(r) : "v"(lo), "v"(hi)); return r; }

template <class Epi, class Sched, bool ALIGN_EPI = false, bool SP2 = false>
__device__ __forceinline__ void gemm_phase(PG8_LAS unsigned char* lds, const Gemm g, const Sched& S, const Epi& E) {
    int tid_ = threadIdx.x; asm volatile("" : "+v"(tid_));
    const int tid = tid_, wid = __builtin_amdgcn_readfirstlane(tid >> 6), lane = tid & 63, wr = wid >> 2, wc = wid & 3, fr = lane & 15, fq = lane >> 4;
    const int K = g.K, nt = K / BK;
    unsigned voffA[2], voffB[2];
#pragma unroll
    for (int i = 0; i < 2; ++i) { int R, C; stage_rc(tid * 16 + i * 8192, R, C); const int Rb = Epi::PERM ? ((R & ~31) + perm32(R & 31)) : R;
        voffA[i] = (unsigned)(R * K + C) * 2u; voffB[i] = (unsigned)(Rb * K + C) * 2u; }
    const size_t kstep = (size_t)(BK * 2);
    const size_t hstep = (size_t)HALF * K * 2;
    const size_t tstep = 2 * hstep;
    const unsigned ldsw = (unsigned)wid * 1024u;
    const int aoff = lds_byte(wr * 64 + fr, fq * 8), boff = lds_byte(wc * 32 + fr, fq * 8);
#define PG8_SA(b, h) (((b) * 2 + (h)) * HTB)
#define PG8_SB(b, h) ((4 + (b) * 2 + (h)) * HTB)
#define PG8_STAGE(bufoff, gbase, voff) do { _Pragma("unroll") for (int _i = 0; _i < 2; ++_i) \
        __builtin_amdgcn_global_load_lds((const unsigned*)((const char*)(gbase) + (voff)[_i]), (PG8_LAS unsigned*)(lds + (bufoff) + ldsw + _i * 8192), 16, 0, 0); } while (0)
#define PG8_LDA(dst, b, h) do { _Pragma("unroll") for (int m = 0; m < 4; ++m) _Pragma("unroll") for (int k = 0; k < 2; ++k) dst[m][k] = *(const PG8_LAS bf16x8*)(lds + PG8_SA(b, h) + aoff + m * 2048 + k * 1024); } while (0)
#define PG8_LDB(dst, b, h) do { _Pragma("unroll") for (int n = 0; n < 2; ++n) _Pragma("unroll") for (int k = 0; k < 2; ++k) dst[n][k] = *(const PG8_LAS bf16x8*)(lds + PG8_SB(b, h) + boff + n * 2048 + k * 1024); } while (0)
#define PG8_MMA(ai, bj, At, Bt) do { __builtin_amdgcn_s_setprio(1); _Pragma("unroll") for (int m = 0; m < 4; ++m) _Pragma("unroll") for (int n = 0; n < 2; ++n) _Pragma("unroll") for (int k = 0; k < 2; ++k) \
        acc[ai][bj][m][n] = __builtin_amdgcn_mfma_f32_16x16x32_bf16(Bt[n][k], At[m][k], acc[ai][bj][m][n], 0, 0, 0); __builtin_amdgcn_s_setprio(0); } while (0)
#define PG8_WAIT_V(n) asm volatile("s_waitcnt vmcnt(" #n ")" ::: "memory")
#define PG8_WAIT_L(n) asm volatile("s_waitcnt lgkmcnt(" #n ")" ::: "memory")
#define PG8_BAR __builtin_amdgcn_s_barrier()
#define PG8_SCHED __builtin_amdgcn_sched_barrier(0)
    Unit cur, nxt; int ui = 0;
    if (!S.next(0, cur)) return;
    f32x4 acc[2][2][4][2];
#pragma unroll
    for (int a = 0; a < 2; ++a)
#pragma unroll
        for (int b = 0; b < 2; ++b)
#pragma unroll
            for (int m = 0; m < 4; ++m)
#pragma unroll
                for (int n = 0; n < 2; ++n) acc[a][b][m][n] = (f32x4){0.f, 0.f, 0.f, 0.f};
    bf16x8 At[4][2], B0[2][2], B1[2][2];
    const char* cA = (const char*)g.A + (size_t)cur.pm * tstep; const char* cB = (const char*)g.Bt + (size_t)cur.pn * tstep;
    S.a_ready(cur);
    if constexpr (SP2) {
        PG8_STAGE(PG8_SB(0, 0), cB, voffB); PG8_STAGE(PG8_SB(0, 1), cB + hstep, voffB); PG8_STAGE(PG8_SA(0, 0), cA, voffA); PG8_STAGE(PG8_SA(0, 1), cA + hstep, voffA);
        if (wr == 1) PG8_BAR;
        PG8_WAIT_V(2); PG8_BAR;
        PG8_STAGE(PG8_SB(1, 0), cB + kstep, voffB); PG8_STAGE(PG8_SA(1, 0), cA + kstep, voffA); PG8_STAGE(PG8_SB(1, 1), cB + hstep + kstep, voffB);
        PG8_WAIT_V(6); PG8_BAR;
    } else {
        PG8_STAGE(PG8_SB(0, 0), cB, voffB); PG8_STAGE(PG8_SA(0, 0), cA, voffA); PG8_STAGE(PG8_SB(0, 1), cB + hstep, voffB); PG8_STAGE(PG8_SA(0, 1), cA + hstep, voffA);
        if (wr == 1) PG8_BAR;
        PG8_WAIT_V(4); PG8_BAR;
        PG8_STAGE(PG8_SB(1, 0), cB + kstep, voffB); PG8_STAGE(PG8_SA(1, 0), cA + kstep, voffA); PG8_STAGE(PG8_SB(1, 1), cB + hstep + kstep, voffB);
        PG8_WAIT_V(6); PG8_BAR;
    }
    for (;;) {
        const bool has_next = S.next(ui + 1, nxt);
        const char* nA = has_next ? (const char*)g.A + (size_t)nxt.pm * tstep : cA; const char* nB = has_next ? (const char*)g.Bt + (size_t)nxt.pn * tstep : cB;
        for (int t = 0; t < nt; t += 2) {
            const bool last = (t == nt - 2);
            const char* a1 = cA + (size_t)(t + 1) * kstep;
            const char* a2 = last ? nA : cA + (size_t)(t + 2) * kstep; const char* b2 = last ? nB : cB + (size_t)(t + 2) * kstep;
            const char* a3 = a2 + kstep; const char* b3 = b2 + kstep;
            if (last && has_next) S.a_ready(nxt);
            if constexpr (SP2) {
            PG8_LDB(B0, 0, 0); PG8_LDB(B1, 0, 1); PG8_SCHED; PG8_LDA(At, 0, 0); PG8_STAGE(PG8_SA(1, 1), a1 + hstep, voffA);
            PG8_WAIT_V(8); PG8_WAIT_L(0); PG8_BAR; PG8_MMA(0, 0, At, B0); PG8_MMA(0, 1, At, B1); PG8_BAR; PG8_SCHED;
            PG8_LDA(At, 0, 1); PG8_STAGE(PG8_SB(0, 0), b2, voffB); PG8_STAGE(PG8_SB(0, 1), b2 + hstep, voffB); PG8_STAGE(PG8_SA(0, 0), a2, voffA);
            PG8_WAIT_V(8); PG8_WAIT_L(0); PG8_BAR; PG8_MMA(1, 0, At, B0); PG8_MMA(1, 1, At, B1); PG8_BAR; PG8_SCHED;
            PG8_LDB(B0, 1, 0); PG8_LDB(B1, 1, 1); PG8_SCHED; PG8_LDA(At, 1, 0); PG8_STAGE(PG8_SA(0, 1), a2 + hstep, voffA);
            PG8_WAIT_V(8); PG8_WAIT_L(0); PG8_BAR; PG8_MMA(0, 0, At, B0); PG8_MMA(0, 1, At, B1); PG8_BAR; PG8_SCHED;
            PG8_LDA(At, 1, 1); PG8_STAGE(PG8_SB(1, 0), b3, voffB); PG8_STAGE(PG8_SB(1, 1), b3 + hstep, voffB); PG8_STAGE(PG8_SA(1, 0), a3, voffA);
            PG8_WAIT_V(8); PG8_WAIT_L(0); PG8_BAR; PG8_MMA(1, 0, At, B0); PG8_MMA(1, 1, At, B1); PG8_BAR; PG8_SCHED;
            } else {
            PG8_LDB(B0, 0, 0); PG8_SCHED; PG8_LDA(At, 0, 0); PG8_STAGE(PG8_SA(1, 1), a1 + hstep, voffA);
            PG8_WAIT_L(8); PG8_BAR; PG8_WAIT_L(0); PG8_MMA(0, 0, At, B0); PG8_BAR; PG8_SCHED;
            PG8_LDB(B1, 0, 1); PG8_STAGE(PG8_SB(0, 0), b2, voffB);
            PG8_BAR; PG8_WAIT_L(0); PG8_MMA(0, 1, At, B1); PG8_BAR;
            PG8_LDA(At, 0, 1); PG8_STAGE(PG8_SA(0, 0), a2, voffA);
            PG8_BAR; PG8_WAIT_L(0); PG8_MMA(1, 0, At, B0); PG8_BAR; PG8_SCHED;
            PG8_STAGE(PG8_SB(0, 1), b2 + hstep, voffB);
            PG8_WAIT_V(6); PG8_BAR; PG8_MMA(1, 1, At, B1); PG8_BAR;
            PG8_LDB(B0, 1, 0); PG8_SCHED; PG8_LDA(At, 1, 0); PG8_STAGE(PG8_SA(0, 1), a2 + hstep, voffA);
            PG8_WAIT_L(8); PG8_BAR; PG8_WAIT_L(0); PG8_MMA(0, 0, At, B0); PG8_BAR; PG8_SCHED;
            PG8_LDB(B1, 1, 1); PG8_STAGE(PG8_SB(1, 0), b3, voffB);
            PG8_BAR; PG8_WAIT_L(0); PG8_MMA(0, 1, At, B1); PG8_BAR;
            PG8_LDA(At, 1, 1); PG8_STAGE(PG8_SA(1, 0), a3, voffA);
            PG8_BAR; PG8_WAIT_L(0); PG8_MMA(1, 0, At, B0); PG8_BAR; PG8_SCHED;
            PG8_STAGE(PG8_SB(1, 1), b3 + hstep, voffB);
            PG8_WAIT_V(6); PG8_BAR; PG8_MMA(1, 1, At, B1); PG8_BAR;
            }
        }
        if constexpr (ALIGN_EPI) { if (wr == 0) PG8_BAR; }
        if constexpr (!Epi::AFTER_DRAIN) { E(acc, cur, wr, wc, fr, fq); S.done(cur); }
        if (!has_next) break;
#pragma unroll
        for (int a = 0; a < 2; ++a)
#pragma unroll
            for (int b = 0; b < 2; ++b)
#pragma unroll
                for (int m = 0; m < 4; ++m)
#pragma unroll
                    for (int n = 0; n < 2; ++n) acc[a][b][m][n] = (f32x4){0.f, 0.f, 0.f, 0.f};
        cur = nxt; cA = nA; cB = nB; ++ui;
        if constexpr (ALIGN_EPI) { if (wr == 1) PG8_BAR; }
    }
    PG8_WAIT_V(0);
    if constexpr (!ALIGN_EPI) { if (wr == 0) PG8_BAR; }
    PG8_BAR;
    if constexpr (Epi::AFTER_DRAIN) { E.fused(acc, cur, wr, wc, fr, fq, lds, wid, lane); S.done(cur); }
#undef PG8_SA
#undef PG8_SB
#undef PG8_STAGE
#undef PG8_LDA
#undef PG8_LDB
#undef PG8_MMA
#undef PG8_WAIT_V
#undef PG8_WAIT_L
#undef PG8_BAR
#undef PG8_SCHED
}
}

namespace {
#define LAS __attribute__((address_space(3)))
typedef unsigned short bf16;
typedef float f32x4 __attribute__((ext_vector_type(4)));
typedef unsigned u32x4 __attribute__((ext_vector_type(4)));
typedef unsigned u32x2 __attribute__((ext_vector_type(2)));
typedef short bf16x8 __attribute__((ext_vector_type(8)));
typedef short bf16x4 __attribute__((ext_vector_type(4)));

constexpr int NTHREADS = 512;
constexpr int D = 1024, NB_P = 16, T_P = 256, NB_S = 2, T_S = 1024, DEPTH = 4, PAST = 256;
constexpr int M_P = NB_P * T_P, M_S = NB_S * T_S, M = M_P + M_S;
constexpr int DFF = 2816, NADA = 9, INC = 3504, INCP = 3584;
constexpr int HG_OFF = 0, HY_OFF = 1280, MLA_OFF = 2048, GD_OFF = 2464;
constexpr int NKS = T_S + PAST;
constexpr float RMS_EPS = 1e-6f;
constexpr int LDS_BYTES = 147456;
constexpr size_t FILT_L = 2 * (256 + 1024) * 256;

struct P {
    const float *x_prompt, *x_sample, *cache_ckv, *cache_krope, *state_hgrn, *state_gdn, *c, *c_ctx;
    const float *w_ada, *b_ada, *norm_ffn, *w_gu, *w_down, *norm_mix, *w_in, *w_out, *hgrn_lb, *hgrn_norm;
    const float *hy_conv_w, *hy_conv_b, *hy_w1, *hy_b1, *hy_freq, *hy_w2, *hy_b2, *hy_w3, *hy_skip;
    const float *q_norm_a, *w_q_up, *kv_norm_a, *w_kv_up, *qk_norm, *gdn_conv_w, *gdn_a_log, *gdn_dt_bias, *gdn_norm;
    float *X;
    float *o_ckv, *o_krope, *o_shg, *o_sgd;
    float *ADA;
    float *LB;
    float *FILT;
    float *ROPE;
    bf16 *WGU;
    bf16 *WDN;
    bf16 *WIN;
    bf16 *WOUT;
    bf16 *WQT, *WKVT;
    bf16 *H;
    bf16 *ACT;
    bf16 *OCAT;
    float *U;
    bf16 *QB;
    bf16 *KBP, *VTP;
    bf16 *KBS, *VTS;
    float *GQ, *GK, *GV;
    float *GA, *GBT;
    float *HF, *HQ;
    float *Z, *X0;
    float *OH, *OG;
    float *HS, *HD;
    float *GS, *GP;
    unsigned *BAR;
};

typedef const __attribute__((address_space(4))) P* KP;
#define FRESH_P() ({ KP k_ = (KP)__builtin_amdgcn_kernarg_segment_ptr(); asm volatile("" : "+s"(k_)); k_; })
__device__ __forceinline__ int otid() { int t = threadIdx.x; asm volatile("" : "+v"(t)); return t; }
__device__ __forceinline__ float sigmoidf_(float x) { return 1.f / (1.f + expf(-x)); }
__device__ __forceinline__ float siluf_(float x) { return x / (1.f + expf(-x)); }
__device__ __forceinline__ unsigned f2bf(float f) { unsigned u = __builtin_bit_cast(unsigned, f); return (u + 0x7fffu + ((u >> 16) & 1u)) >> 16; }
__device__ __forceinline__ unsigned pk2(float lo, float hi) { return f2bf(lo) | (f2bf(hi) << 16); }

__device__ __forceinline__ void row_info(int r, int& ci, int& T, int& row0, int& t, int& b) {
    if (r < M_P) { b = r >> 8; t = r & 255; T = T_P; row0 = b << 8; ci = 0; }
    else { const int rr = r - M_P; b = rr >> 10; t = rr & 1023; T = T_S; row0 = M_P + (b << 10); ci = 1 + b; }
}
__device__ __forceinline__ int panel_ci(int pm) { return pm < 16 ? 0 : 1 + ((pm - 16) >> 2); }

__device__ __forceinline__ float wave_sum(float v, int lane) {
#pragma unroll
    for (int o = 1; o < 64; o <<= 1) v += __builtin_bit_cast(float, __builtin_amdgcn_ds_bpermute((lane ^ o) << 2, __builtin_bit_cast(int, v)));
    return v;
}
__device__ __forceinline__ float bcast(float v, int k) { return __builtin_bit_cast(float, __builtin_amdgcn_readlane(__builtin_bit_cast(int, v), k)); }

struct EpiSwiGLU {
    static constexpr bool PERM = true, AFTER_DRAIN = false;
    bf16* O;
    __device__ __forceinline__ void operator()(const f32x4 (&acc)[2][2][4][2], const pg8::Unit& u, int wr, int wc, int fr, int fq) const {
        const int row0 = u.pm * 256 + wr * 64 + fr, col0 = u.pn * 128 + wc * 32 + 8 * fq;
#pragma unroll
        for (int ai = 0; ai < 2; ++ai)
#pragma unroll
            for (int m = 0; m < 4; ++m) {
                bf16* rowp = O + (size_t)(row0 + ai * 128 + m * 16) * DFF + col0;
                float v[8];
#pragma unroll
                for (int n = 0; n < 2; ++n)
#pragma unroll
                    for (int i = 0; i < 4; ++i) { const float g = acc[ai][0][m][n][i], up = acc[ai][1][m][n][i];
                        v[4 * n + i] = g * __builtin_amdgcn_rcpf(1.f + __expf(-g)) * up; }
                u32x4 w; w.x = pg8::cvt_pk_bf16(v[0], v[1]); w.y = pg8::cvt_pk_bf16(v[2], v[3]); w.z = pg8::cvt_pk_bf16(v[4], v[5]); w.w = pg8::cvt_pk_bf16(v[6], v[7]);
                *(u32x4*)rowp = w;
            }
    }
};
struct EpiF32 {
    static constexpr bool PERM = false, AFTER_DRAIN = false;
    float* C; int ldc;
    __device__ __forceinline__ void operator()(const f32x4 (&acc)[2][2][4][2], const pg8::Unit& u, int wr, int wc, int fr, int fq) const {
        const int row0 = u.pm * 256 + wr * 64 + fr, col0 = u.pn * 256 + wc * 32 + 4 * fq;
#pragma unroll
        for (int ai = 0; ai < 2; ++ai)
#pragma unroll
            for (int m = 0; m < 4; ++m) { float* rowp = C + (size_t)(row0 + ai * 128 + m * 16) * ldc + col0;
#pragma unroll
                for (int bj = 0; bj < 2; ++bj)
#pragma unroll
                    for (int n = 0; n < 2; ++n) *(f32x4*)(rowp + bj * 128 + n * 16) = acc[ai][bj][m][n]; }
    }
};
struct EpiResid {
    static constexpr bool PERM = false, AFTER_DRAIN = false;
    float* X; const float* gate; float coef;
    __device__ __forceinline__ void operator()(const f32x4 (&acc)[2][2][4][2], const pg8::Unit& u, int wr, int wc, int fr, int fq) const {
        const int row0 = u.pm * 256 + wr * 64 + fr, col0 = u.pn * 256 + wc * 32 + 4 * fq;
        const float* g = gate + (size_t)panel_ci(u.pm) * NADA * D + col0;
        f32x4 gv[2][2];
#pragma unroll
        for (int bj = 0; bj < 2; ++bj)
#pragma unroll
            for (int n = 0; n < 2; ++n) gv[bj][n] = *(const f32x4*)(g + bj * 128 + n * 16) * coef;
#pragma unroll
        for (int ai = 0; ai < 2; ++ai)
#pragma unroll
            for (int m = 0; m < 4; ++m) { float* rowp = X + (size_t)(row0 + ai * 128 + m * 16) * D + col0;
#pragma unroll
                for (int bj = 0; bj < 2; ++bj)
#pragma unroll
                    for (int n = 0; n < 2; ++n) { f32x4* q = (f32x4*)(rowp + bj * 128 + n * 16); *q = *q + gv[bj][n] * acc[ai][bj][m][n]; } }
    }
};

__device__ __forceinline__ void ph_init(KP p) {
    const int tix = otid();
    const int n4 = M * D / 4, np4 = M_P * D / 4;
    for (int i = blockIdx.x * NTHREADS + tix; i < n4; i += gridDim.x * NTHREADS) {
        const float4 v = (i < np4) ? ((const float4*)p->x_prompt)[i] : ((const float4*)p->x_sample)[i - np4];
        ((float4*)p->X)[i] = v;
    }
}

__device__ __forceinline__ void ph_ada(KP p, LAS float* sc  ) {
    const int tix = otid();
    for (int i = tix; i < 3 * 1024; i += NTHREADS) {
        const int ci = i >> 10, k = i & 1023;
        const float v = (ci == 0) ? p->c_ctx[k] : p->c[(ci - 1) * 1024 + k];
        sc[i] = siluf_(v);
    }
    __syncthreads();
    const int NJ = NADA * D;
    for (int idx = blockIdx.x * NTHREADS + tix; idx < DEPTH * NJ; idx += gridDim.x * NTHREADS) {
        const int l = idx / NJ, j = idx % NJ;
        const float* w = p->w_ada + (size_t)l * D * NJ + j;
        float a0 = 0.f, a1 = 0.f, a2 = 0.f;
#pragma unroll 8
        for (int k = 0; k < D; ++k) { const float wv = w[(size_t)k * NJ]; a0 += sc[k] * wv; a1 += sc[1024 + k] * wv; a2 += sc[2048 + k] * wv; }
        const float bb = p->b_ada[l * NJ + j];
        p->ADA[(size_t)(l * 3 + 0) * NJ + j] = a0 + bb;
        p->ADA[(size_t)(l * 3 + 1) * NJ + j] = a1 + bb;
        p->ADA[(size_t)(l * 3 + 2) * NJ + j] = a2 + bb;
    }
    __syncthreads();
}

__device__ __forceinline__ void ph_small(KP p) {
    const int tix = otid();
    const int gt = blockIdx.x * NTHREADS + tix, gn = gridDim.x * NTHREADS;
    for (int i = gt; i < 512; i += gn) {
        float v[4], mx = -1e30f;
        for (int l = 0; l < 4; ++l) { v[l] = p->hgrn_lb[l * 512 + i]; mx = fmaxf(mx, v[l]); }
        float s = 0.f;
        for (int l = 0; l < 4; ++l) { v[l] = expf(v[l] - mx); s += v[l]; }
        float cum = 0.f;
        for (int l = 0; l < 4; ++l) { if (l > 0) cum += v[l] / s; p->LB[l * 512 + i] = cum; }
    }
    for (int i = gt; i < 1024 * 16; i += gn) {
        const int t = i >> 4, j = i & 15;
        const int row = t >> 6, col = t & 63;
        const double inv = pow(10000.0, -(double)(j & 7) / 8.0);
        const double ang = (double)((j < 8) ? row : col) * inv;
        p->ROPE[i] = (float)cos(ang);
        p->ROPE[1024 * 16 + i] = (float)sin(ang);
    }
}

__device__ __forceinline__ void ph_filt(KP p, LAS double* scr  ) {
    const int tix = otid();
    const int lane = tix & 63, wv = tix >> 6;
    LAS double* ze = scr + wv * 168; LAS double* h1 = ze + 40; LAS double* h2 = h1 + 64;
    const int NIT = DEPTH * 1280, gw = blockIdx.x * 8 + wv, NGW = gridDim.x * 8;
    const int trips = (NIT + NGW - 1) / NGW;
    for (int it = 0; it < trips; ++it) {
        const int item = it * NGW + gw; const bool act = item < NIT;
        const int l = act ? item / 1280 : 0, q = act ? item % 1280 : 0;
        const int set = (q < 256) ? 0 : 1, pos = set ? q - 256 : q, L = set ? 1024 : 256;
        const double t = (double)pos / (double)(L - 1);
        if (lane == 0) ze[0] = t;
        if (lane < 16) {
            const double band = 1e-4 + (double)lane * ((15.0 - 1e-4) / 15.0);
            const double ang = (2.0 * 3.14159265358979323846 / (double)L) * (double)pos * band;
            ze[1 + lane] = cos(ang);
            ze[17 + lane] = -sin(ang);
        }
        __syncthreads();
        const double fr = (double)p->hy_freq[l * 64 + lane];
        {
            double a = (double)p->hy_b1[l * 64 + lane];
            for (int i = 0; i < 33; ++i) a += ze[i] * (double)p->hy_w1[(l * 33 + i) * 64 + lane];
            h1[lane] = sin(fr * a);
        }
        __syncthreads();
        {
            double a = (double)p->hy_b2[l * 64 + lane];
            for (int i = 0; i < 64; ++i) a += h1[i] * (double)p->hy_w2[(l * 64 + i) * 64 + lane];
            h2[lane] = sin(fr * a);
        }
        __syncthreads();
        if (act) {
            float* base = p->FILT + (size_t)l * FILT_L + (set ? (size_t)2 * 256 * 256 : 0);
            const double max_decay = log(1e-2) / 0.3, min_decay = log(1e-2) / 1.5;
            for (int n = lane; n < 512; n += 64) {
                double a = 0.0;
                for (int i = 0; i < 64; ++i) a += h2[i] * (double)p->hy_w3[(size_t)(l * 64 + i) * 512 + n];
                const int c = n & 255;
                const double delta = min_decay + (double)c * ((max_decay - min_decay) / 255.0);
                const double win = exp(-t * fabs(delta));
                if (n < 256) base[(size_t)(L + pos) * 256 + c] = (float)(a * win);
                else if (pos > 0) base[(size_t)(L - pos) * 256 + c] = (float)(a * win);
            }
        }
        __syncthreads();
    }
}

__device__ __forceinline__ void transpose_item(const float* W, int K, int N, bf16* WT, int dst_row, LAS float* scr, int k0, int n0, int lane) {
    const int nn = n0 + (lane & 31);
#pragma unroll 8
    for (int i = 0; i < 32; ++i) { const int kk = 2 * i + (lane >> 5); scr[kk * 33 + (lane & 31)] = (nn < N) ? W[(size_t)(k0 + kk) * N + nn] : 0.f; }
    asm volatile("s_waitcnt lgkmcnt(0)" ::: "memory");
    const int c = lane & 7;
#pragma unroll
    for (int j = 0; j < 4; ++j) { const int n = (lane >> 3) + 8 * j; const LAS float* s = scr + (8 * c) * 33 + n;
        u32x4 o; o.x = pk2(s[0 * 33], s[1 * 33]); o.y = pk2(s[2 * 33], s[3 * 33]); o.z = pk2(s[4 * 33], s[5 * 33]); o.w = pk2(s[6 * 33], s[7 * 33]);
        *(u32x4*)(WT + (size_t)(dst_row + n) * K + k0 + 8 * c) = o; }
    asm volatile("s_waitcnt lgkmcnt(0)" ::: "memory");
}
__device__ __forceinline__ void ph_wprep(KP p, LAS float* scr_all) {
    const int tix = otid();
    const int lane = tix & 63, wv = tix >> 6;
    LAS float* scr = scr_all + wv * (64 * 33);
    const int gw = blockIdx.x * 8 + wv, NGW = gridDim.x * 8;
    constexpr int I_GU = 16 * 176, I_DN = 44 * 32, I_IN = 16 * 112, I_OUT = 16 * 32, I_Q = 4 * 12, I_KV = 2 * 16, I_L = 2 * I_GU + 2 * I_DN + I_IN + I_OUT + I_Q + I_KV;
    for (int it = gw; it < DEPTH * I_L; it += NGW) {
        const int l = it / I_L; int r = it % I_L;
        if (r < 2 * I_GU) { const int f = r / I_GU, rr = r % I_GU, kb = rr / 176, nb = rr % 176, n0 = nb * 32;
            const int j = n0 < DFF ? n0 : n0 - DFF; const int dst = 256 * (j >> 7) + (n0 < DFF ? 0 : 128) + (j & 127);
            transpose_item(p->w_gu + (size_t)(l * 2 + f) * D * 2 * DFF, D, 2 * DFF, p->WGU + (size_t)(l * 2 + f) * 2 * DFF * D, dst, scr, kb * 64, n0, lane); continue; }
        r -= 2 * I_GU;
        if (r < 2 * I_DN) { const int f = r / I_DN, rr = r % I_DN, kb = rr / 32, nb = rr % 32;
            transpose_item(p->w_down + (size_t)(l * 2 + f) * DFF * D, DFF, D, p->WDN + (size_t)(l * 2 + f) * D * DFF, nb * 32, scr, kb * 64, nb * 32, lane); continue; }
        r -= 2 * I_DN;
        if (r < I_IN) { const int kb = r / 112, nb = r % 112;
            transpose_item(p->w_in + (size_t)l * D * INC, D, INC, p->WIN + (size_t)l * INCP * D, nb * 32, scr, kb * 64, nb * 32, lane); continue; }
        r -= I_IN;
        if (r < I_OUT) { const int kb = r / 32, nb = r % 32;
            transpose_item(p->w_out + (size_t)l * D * D, D, D, p->WOUT + (size_t)l * D * D, nb * 32, scr, kb * 64, nb * 32, lane); continue; }
        r -= I_OUT;
        if (r < I_Q) { const int kb = r / 12, nb = r % 12;
            transpose_item(p->w_q_up + (size_t)l * 256 * 384, 256, 384, p->WQT + (size_t)l * 384 * 256, nb * 32, scr, kb * 64, nb * 32, lane); continue; }
        r -= I_Q;
        { const int kb = r / 16, nb = r % 16;
            transpose_item(p->w_kv_up + (size_t)l * 128 * 512, 128, 512, p->WKVT + (size_t)l * 512 * 128, nb * 32, scr, kb * 64, nb * 32, lane); }
    }
}

__device__ __forceinline__ void ph_norm(KP p, int l, int s) {
    const int tix = otid();
    const int lane = tix & 63, wv = tix >> 6;
    const float* g = (s == 1) ? p->norm_mix + l * D : p->norm_ffn + (size_t)(l * 2 + (s == 2 ? 1 : 0)) * D;
    for (int r = blockIdx.x * 8 + wv; r < M; r += gridDim.x * 8) {
        int ci, T, row0, t, b; row_info(r, ci, T, row0, t, b);
        const float* ada = p->ADA + (size_t)(l * 3 + ci) * NADA * D;
        const float* shift = ada + (3 * s + 0) * D;
        const float* scale = ada + (3 * s + 1) * D;
        const float4* xr = (const float4*)(p->X + (size_t)r * D);
        float4 v[4]; float ss = 0.f;
#pragma unroll
        for (int j = 0; j < 4; ++j) { v[j] = xr[lane + 64 * j]; ss += v[j].x * v[j].x + v[j].y * v[j].y + v[j].z * v[j].z + v[j].w * v[j].w; }
        ss = wave_sum(ss, lane);
        const float rstd = 1.0f / sqrtf(ss * (1.0f / D) + RMS_EPS);
        u32x2* hr = (u32x2*)(p->H + (size_t)r * D);
#pragma unroll
        for (int j = 0; j < 4; ++j) {
            const int c4 = lane + 64 * j;
            const float4 gg = ((const float4*)g)[c4], sh = ((const float4*)shift)[c4], scl = ((const float4*)scale)[c4];
            const float ox = v[j].x * rstd * gg.x * (1.f + scl.x) + sh.x;
            const float oy = v[j].y * rstd * gg.y * (1.f + scl.y) + sh.y;
            const float oz = v[j].z * rstd * gg.z * (1.f + scl.z) + sh.z;
            const float ow = v[j].w * rstd * gg.w * (1.f + scl.w) + sh.w;
            u32x2 o; o.x = pk2(ox, oy); o.y = pk2(oz, ow);
            hr[c4] = o;
        }
    }
}

__device__ __forceinline__ float red16(float v, int lane) {
#pragma unroll
    for (int o = 1; o < 16; o <<= 1) v += __builtin_bit_cast(float, __builtin_amdgcn_ds_bpermute((lane ^ o) << 2, __builtin_bit_cast(int, v)));
    return v;
}
__device__ __forceinline__ float red_g(float v, int lane) {
    v += __builtin_bit_cast(float, __builtin_amdgcn_ds_bpermute((lane ^ 16) << 2, __builtin_bit_cast(int, v)));
    v += __builtin_bit_cast(float, __builtin_amdgcn_ds_bpermute((lane ^ 32) << 2, __builtin_bit_cast(int, v)));
    return v;
}
__device__ __forceinline__ bf16x8 pack8(const float (&v)[8]) {
    u32x4 w; w.x = pg8::cvt_pk_bf16(v[0], v[1]); w.y = pg8::cvt_pk_bf16(v[2], v[3]); w.z = pg8::cvt_pk_bf16(v[4], v[5]); w.w = pg8::cvt_pk_bf16(v[6], v[7]);
    return __builtin_bit_cast(bf16x8, w);
}
__device__ __forceinline__ void mla_wave(KP p, int l, int item, int lane) {
    const int tq = lane & 15, g = lane >> 4;
    const bool isctx = item >= 384;
    int tok0 = 0, b = 0, t0 = 0;
    bool sample = false;
    if (!isctx) { tok0 = item * 16; sample = tok0 >= M_P; if (sample) { b = (tok0 - M_P) >> 10; t0 = (tok0 - M_P) & 1023; } else { b = tok0 >> 8; t0 = tok0 & 255; } }
    else { const int j = item - 384; b = j >> 4; t0 = (j & 15) * 16; }
    const float qscale = 0.10206207261596577f;
    bf16x8 aq[8], akv[4];
    if (!isctx) {
        const float* u = p->U + (size_t)(tok0 + tq) * INCP + MLA_OFF;
        {
            float x[8][8]; float ss = 0.f;
#pragma unroll
            for (int s = 0; s < 8; ++s) { const f32x4 a = *(const f32x4*)(u + 32 * s + 8 * g), c = *(const f32x4*)(u + 32 * s + 8 * g + 4);
#pragma unroll
                for (int j = 0; j < 4; ++j) { x[s][j] = a[j]; x[s][4 + j] = c[j]; ss += a[j] * a[j] + c[j] * c[j]; } }
            ss = red_g(ss, lane);
            const float rstd = 1.0f / sqrtf(ss * (1.0f / 256.f) + RMS_EPS);
#pragma unroll
            for (int s = 0; s < 8; ++s) { const float* gn = p->q_norm_a + l * 256 + 32 * s + 8 * g; float v[8];
#pragma unroll
                for (int j = 0; j < 8; ++j) v[j] = x[s][j] * rstd * gn[j];
                aq[s] = pack8(v); }
        }
        {
            float x[4][8]; float ss = 0.f;
#pragma unroll
            for (int s = 0; s < 4; ++s) { const f32x4 a = *(const f32x4*)(u + 256 + 32 * s + 8 * g), c = *(const f32x4*)(u + 256 + 32 * s + 8 * g + 4);
#pragma unroll
                for (int j = 0; j < 4; ++j) { x[s][j] = a[j]; x[s][4 + j] = c[j]; ss += a[j] * a[j] + c[j] * c[j]; } }
            ss = red_g(ss, lane);
            const float rstd = 1.0f / sqrtf(ss * (1.0f / 128.f) + RMS_EPS);
            float* oc = p->o_ckv + ((size_t)(b * DEPTH + l) * T_P + t0 + tq) * 128;
#pragma unroll
            for (int s = 0; s < 4; ++s) { const float* gn = p->kv_norm_a + l * 128 + 32 * s + 8 * g; float v[8];
#pragma unroll
                for (int j = 0; j < 8; ++j) v[j] = x[s][j] * rstd * gn[j];
                akv[s] = pack8(v);
                if (!sample) { *(f32x4*)(oc + 32 * s + 8 * g) = (f32x4){v[0], v[1], v[2], v[3]}; *(f32x4*)(oc + 32 * s + 8 * g + 4) = (f32x4){v[4], v[5], v[6], v[7]}; } }
        }
    } else {
        const float* cp = p->cache_ckv + ((size_t)(b * DEPTH + l) * PAST + t0 + tq) * 128;
#pragma unroll
        for (int s = 0; s < 4; ++s) { const f32x4 a = *(const f32x4*)(cp + 32 * s + 8 * g), c = *(const f32x4*)(cp + 32 * s + 8 * g + 4);
            const float v[8] = {a[0], a[1], a[2], a[3], c[0], c[1], c[2], c[3]}; akv[s] = pack8(v); }
    }
    float kr[2][4];
#pragma unroll
    for (int i = 0; i < 4; ++i)
#pragma unroll
        for (int tt = 0; tt < 2; ++tt) {
            const int tk = 4 * g + i;
            kr[tt][i] = isctx ? p->cache_krope[((size_t)(b * DEPTH + l) * PAST + t0 + tk) * 32 + 16 * tt + tq]
                              : p->U[(size_t)(tok0 + tk) * INCP + MLA_OFF + 384 + 16 * tt + tq];
            if (!isctx && !sample) p->o_krope[((size_t)(b * DEPTH + l) * T_P + t0 + tk) * 32 + 16 * tt + tq] = kr[tt][i];
        }
    const bool rope = sample && !isctx;
    float cs[4], sn[4];
#pragma unroll
    for (int i = 0; i < 4; ++i) { const int t = rope ? t0 + 4 * g + i : 0; cs[i] = p->ROPE[t * 16 + tq]; sn[i] = p->ROPE[1024 * 16 + t * 16 + tq]; }
    const float* qn0 = p->qk_norm + (size_t)(l * 2 + 0) * 96; const float* qn1 = p->qk_norm + (size_t)(l * 2 + 1) * 96;
    if (!isctx) {
        const bf16* Wq = p->WQT + (size_t)l * 384 * 256;
#pragma unroll 1
        for (int h = 0; h < 4; ++h) {
            f32x4 c[6];
#pragma unroll
            for (int tile = 0; tile < 6; ++tile) { c[tile] = (f32x4){0.f, 0.f, 0.f, 0.f};
                const bf16* wr = Wq + (size_t)(h * 96 + 16 * tile + tq) * 256 + 8 * g;
#pragma unroll
                for (int s = 0; s < 8; ++s) c[tile] = __builtin_amdgcn_mfma_f32_16x16x32_bf16(aq[s], *(const bf16x8*)(wr + 32 * s), c[tile], 0, 0, 0); }
            float rstd[4];
#pragma unroll
            for (int i = 0; i < 4; ++i) { float ss = 0.f;
#pragma unroll
                for (int tile = 0; tile < 6; ++tile) ss += c[tile][i] * c[tile][i];
                ss = red16(ss, lane); rstd[i] = 1.0f / sqrtf(ss * (1.0f / 96.f) + RMS_EPS); }
#pragma unroll
            for (int i = 0; i < 4; ++i) {
                float v[6];
#pragma unroll
                for (int tile = 0; tile < 6; ++tile) v[tile] = c[tile][i] * rstd[i] * qn0[16 * tile + tq];
                if (rope) { const float x1 = v[4], x2 = v[5]; v[4] = x1 * cs[i] - x2 * sn[i]; v[5] = x2 * cs[i] + x1 * sn[i]; }
                bf16* qo = p->QB + (size_t)(tok0 + 4 * g + i) * 384 + h * 96 + tq;
#pragma unroll
                for (int tile = 0; tile < 6; ++tile) qo[16 * tile] = (bf16)f2bf(v[tile] * qscale);
            }
        }
    }
    {
        const bf16* Wkv = p->WKVT + (size_t)l * 512 * 128;
        const bool smp = isctx || sample;
        const int nk = smp ? NKS : T_P, key0 = (isctx ? T_S + t0 : t0) + 4 * g;
        bf16* Kbase = smp ? p->KBS + (size_t)(b * 4) * NKS * 96 : p->KBP + (size_t)(b * 4) * T_P * 96;
        bf16* Vbase = smp ? p->VTS + (size_t)(b * 4) * 64 * NKS : p->VTP + (size_t)(b * 4) * 64 * T_P;
#pragma unroll 1
        for (int h = 0; h < 4; ++h) {
            f32x4 c[8];
#pragma unroll
            for (int tile = 0; tile < 8; ++tile) { c[tile] = (f32x4){0.f, 0.f, 0.f, 0.f};
                const bf16* wr = Wkv + (size_t)(h * 128 + 16 * tile + tq) * 128 + 8 * g;
#pragma unroll
                for (int s = 0; s < 4; ++s) c[tile] = __builtin_amdgcn_mfma_f32_16x16x32_bf16(akv[s], *(const bf16x8*)(wr + 32 * s), c[tile], 0, 0, 0); }
#pragma unroll
            for (int i = 0; i < 4; ++i) {
                float ss = kr[0][i] * kr[0][i] + kr[1][i] * kr[1][i];
#pragma unroll
                for (int tile = 0; tile < 4; ++tile) ss += c[tile][i] * c[tile][i];
                ss = red16(ss, lane);
                const float rstd = 1.0f / sqrtf(ss * (1.0f / 96.f) + RMS_EPS);
                float v[6];
#pragma unroll
                for (int tile = 0; tile < 4; ++tile) v[tile] = c[tile][i] * rstd * qn1[16 * tile + tq];
                v[4] = kr[0][i] * rstd * qn1[64 + tq]; v[5] = kr[1][i] * rstd * qn1[80 + tq];
                if (rope) { const float x1 = v[4], x2 = v[5]; v[4] = x1 * cs[i] - x2 * sn[i]; v[5] = x2 * cs[i] + x1 * sn[i]; }
                bf16* ko = Kbase + ((size_t)h * nk + key0 + i) * 96 + tq;
#pragma unroll
                for (int tile = 0; tile < 6; ++tile) ko[16 * tile] = (bf16)f2bf(v[tile]);
            }
#pragma unroll
            for (int tile = 4; tile < 8; ++tile) {
                u32x2 w; w.x = pk2(c[tile][0], c[tile][1]); w.y = pk2(c[tile][2], c[tile][3]);
                *(u32x2*)(Vbase + ((size_t)h * 64 + 16 * (tile - 4) + tq) * nk + key0) = w;
            }
        }
    }
}
__device__ __forceinline__ void ph_mla_prep(KP p, int l) {
    const int tix = otid();
    const int lane = tix & 63, wv = tix >> 6;
    for (int it = wv * gridDim.x + blockIdx.x; it < 416; it += gridDim.x * 8) mla_wave(p, l, it, lane);
}

__device__ __forceinline__ void ph_tok_prep(KP p, int l) {
    const int tix = otid();
    const int sub = tix >> 8, tid = tix & 255, lane = tix & 63;
    for (int r = blockIdx.x * 2 + sub; r < M; r += gridDim.x * 2) {
        int ci, T, row0, t, b; row_info(r, ci, T, row0, t, b);
        {
            const float* u = p->U + (size_t)r * INCP + GD_OFF;
            const float* cw = p->gdn_conv_w + (size_t)l * 3 * 768;
            float val[3];
#pragma unroll
            for (int part = 0; part < 3; ++part) {
                const int ch = part * 256 + tid;
                float a = cw[768 + ch] * u[ch];
                if (t > 0) a += cw[ch] * u[ch - INCP];
                if (t < T - 1) a += cw[2 * 768 + ch] * u[ch + INCP];
                val[part] = siluf_(a);
            }
            const float sq = wave_sum(val[0] * val[0], lane), sk = wave_sum(val[1] * val[1], lane);
            p->GQ[(size_t)r * 256 + tid] = val[0] * (1.0f / sqrtf(sq + 1e-6f)) * 0.125f;
            p->GK[(size_t)r * 256 + tid] = val[1] * (1.0f / sqrtf(sk + 1e-6f));
            p->GV[(size_t)r * 256 + tid] = val[2];
            if (tid < 8) {
                const float a = u[1024 + tid], bb = u[1032 + tid];
                const float x = a + p->gdn_dt_bias[l * 8 + tid];
                const float sp = (x > 20.f) ? x : log1pf(expf(x));
                p->GA[(size_t)r * 8 + tid] = expf(-expf(p->gdn_a_log[l * 8 + tid]) * sp);
                p->GBT[(size_t)r * 8 + tid] = sigmoidf_(bb);
            }
        }
        {
            const float* u = p->U + (size_t)r * INCP + HY_OFF;
            const float* cw = p->hy_conv_w + (size_t)l * 3 * 768;
            const float* cb = p->hy_conv_b + (size_t)l * 768;
            float val[3];
#pragma unroll
            for (int part = 0; part < 3; ++part) {
                const int ch = part * 256 + tid;
                float a = cw[768 + ch] * u[ch] + cb[ch];
                if (t > 0) a += cw[ch] * u[ch - INCP];
                if (t < T - 1) a += cw[2 * 768 + ch] * u[ch + INCP];
                val[part] = a;
            }
            p->X0[(size_t)r * 256 + tid] = val[0];
            p->Z[(size_t)r * 256 + tid] = val[1] * val[2];
        }
        {
            const float* u = p->U + (size_t)r * INCP + HG_OFF;
            p->HQ[(size_t)r * 256 + tid] = u[tid] * 0.125f;
#pragma unroll
            for (int d = 0; d < 2; ++d) {
                const float lbv = p->LB[(l * 2 + d) * 256 + tid];
                p->HF[((size_t)d * M + r) * 256 + tid] = lbv + (1.f - lbv) * sigmoidf_(u[768 + d * 256 + tid]);
            }
        }
    }
}

constexpr int NCS = 96, NITEM = NCS * 8;
struct ChunkInfo { int seq, c, nch, T, row0; bool prompt; };
__device__ __forceinline__ ChunkInfo chunk_info(int cs) {
    ChunkInfo ci;
    if (cs < 64) { ci.seq = cs >> 2; ci.c = cs & 3; ci.nch = 4; ci.T = T_P; ci.row0 = ci.seq * T_P; ci.prompt = true; }
    else { const int j = cs - 64; ci.seq = 16 + (j >> 4); ci.c = j & 15; ci.nch = 16; ci.T = T_S; ci.row0 = M_P + (j >> 4) * T_S; ci.prompt = false; }
    return ci;
}
__device__ __forceinline__ int first_cs(int seq) { return seq < 16 ? seq * 4 : 64 + (seq - 16) * 16; }

__device__ __forceinline__ void hgrn_passA(KP p, int item, int lane) {
    const int cs = item >> 3, dir = (item >> 2) & 1, h = item & 3;
    const ChunkInfo ci = chunk_info(cs);
    float S[64];
#pragma unroll
    for (int v = 0; v < 64; ++v) S[v] = 0.f;
    float suf = 1.f;
    for (int s = 63; s >= 0; --s) {
        const int g = ci.c * 64 + s, t = dir ? ci.T - 1 - g : g;
        const size_t r = (size_t)(ci.row0 + t);
        const float f = p->HF[((size_t)dir * M + r) * 256 + h * 64 + lane];
        const float vv = p->U[r * INCP + HG_OFF + 256 + h * 64 + lane];
        const float w = (1.f - f) * suf;
#pragma unroll
        for (int v = 0; v < 64; ++v) S[v] += w * bcast(vv, v);
        suf *= f;
    }
    p->HD[(size_t)item * 64 + lane] = suf;
    f32x4* so = (f32x4*)(p->HS + (size_t)item * 4096 + lane * 64);
#pragma unroll
    for (int v = 0; v < 16; ++v) so[v] = (f32x4){S[4 * v], S[4 * v + 1], S[4 * v + 2], S[4 * v + 3]};
}
__device__ __forceinline__ void gdn_passA(KP p, int item, int half, int lane) {
    const int cs = item >> 3, dir = (item >> 2) & 1, h = item & 3;
    const ChunkInfo ci = chunk_info(cs);
    float S[64];
#pragma unroll
    for (int k = 0; k < 64; ++k) S[k] = (half && k == lane) ? 1.f : 0.f;
    for (int s = 0; s < 64; ++s) {
        const int g = ci.c * 64 + s, t = dir ? ci.T - 1 - g : g;
        const size_t r = (size_t)(ci.row0 + t);
        const float kv = p->GK[r * 256 + h * 64 + lane];
        const float vi = half ? 0.f : p->GV[r * 256 + h * 64 + lane];
        const float a = p->GA[r * 8 + dir * 4 + h], beta = p->GBT[r * 8 + dir * 4 + h];
        float kS = 0.f;
#pragma unroll
        for (int k = 0; k < 64; ++k) kS += bcast(kv, k) * S[k];
        const float cc = beta * (vi - a * kS);
#pragma unroll
        for (int k = 0; k < 64; ++k) S[k] = a * S[k] + bcast(kv, k) * cc;
    }
    float* so = (half ? p->GP : p->GS) + (size_t)item * 4096 + lane;
#pragma unroll
    for (int k = 0; k < 64; ++k) so[k * 64] = S[k];
}
__device__ __forceinline__ void ph_scanA(KP p) {
    const int tix = otid();
    const int lane = tix & 63, wv = tix >> 6;
    const int gw = wv * gridDim.x + blockIdx.x;
    for (int it = gw; it < 3 * NITEM; it += gridDim.x * 8) {
        if (it < 2 * NITEM) gdn_passA(p, it >> 1, it & 1, lane);
        else hgrn_passA(p, it - 2 * NITEM, lane);
    }
}

__device__ __forceinline__ void hgrn_passB(KP p, int l, int gt, int gn) {
    for (int e = gt; e < 18 * 8 * 4096; e += gn) {
        const int sdh = e >> 12, kvx = e & 4095, k = kvx >> 6;
        const int seq = sdh >> 3, dir = (sdh >> 2) & 1, h = sdh & 3;
        const bool prompt = seq < 16; const int nch = prompt ? 4 : 16, cs0 = first_cs(seq);
        float s = prompt ? 0.f : p->state_hgrn[((size_t)(((seq - 16) * DEPTH + l) * 2 + dir) * 4 + h) * 4096 + kvx];
        for (int c = 0; c < nch; ++c) {
            const size_t item = (size_t)((cs0 + c) * 2 + dir) * 4 + h;
            const float loc = p->HS[item * 4096 + kvx];
            p->HS[item * 4096 + kvx] = s;
            s = p->HD[item * 64 + k] * s + loc;
        }
        if (prompt) p->o_shg[((size_t)((seq * DEPTH + l) * 2 + dir) * 4 + h) * 4096 + kvx] = s;
    }
}
__device__ __forceinline__ void gdn_passB(KP p, int l, int sdh, LAS float* Sl  , int lane, int wv) {
    const int seq = sdh >> 3, dir = (sdh >> 2) & 1, h = sdh & 3;
    const bool prompt = seq < 16; const int nch = prompt ? 4 : 16, cs0 = first_cs(seq);
    {
        const float* s0 = p->state_gdn + ((size_t)(((prompt ? 0 : seq - 16) * DEPTH + l) * 2 + dir) * 4 + h) * 4096;
#pragma unroll
        for (int j = 0; j < 8; ++j) { const int k = wv * 8 + j; Sl[k * 64 + lane] = prompt ? 0.f : s0[k * 64 + lane]; }
    }
    __syncthreads();
    int cur = 0;
    for (int c = 0; c < nch; ++c) {
        const size_t item = (size_t)((cs0 + c) * 2 + dir) * 4 + h;
        LAS float* Sc = Sl + cur * 4096; LAS float* Sn = Sl + (cur ^ 1) * 4096;
        float acc[8], prow[8];
#pragma unroll
        for (int j = 0; j < 8; ++j) { const int k = wv * 8 + j;
            acc[j] = p->GS[item * 4096 + k * 64 + lane];
            prow[j] = p->GP[item * 4096 + k * 64 + lane];
            p->GS[item * 4096 + k * 64 + lane] = Sc[k * 64 + lane]; }
        if (c + 1 < nch || prompt) {
#pragma unroll 4
            for (int kk = 0; kk < 64; ++kk) {
                const float sv = Sc[kk * 64 + lane];
#pragma unroll
                for (int j = 0; j < 8; ++j) acc[j] += __builtin_bit_cast(float, __builtin_amdgcn_readlane(__builtin_bit_cast(int, prow[j]), kk)) * sv;
            }
#pragma unroll
            for (int j = 0; j < 8; ++j) Sn[(wv * 8 + j) * 64 + lane] = acc[j];
        }
        __syncthreads();
        cur ^= 1;
    }
    if (prompt) {
        float* so = p->o_sgd + ((size_t)((seq * DEPTH + l) * 2 + dir) * 4 + h) * 4096;
#pragma unroll
        for (int j = 0; j < 8; ++j) { const int k = wv * 8 + j; so[k * 64 + lane] = Sl[cur * 4096 + k * 64 + lane]; }
    }
    __syncthreads();
}

__device__ __forceinline__ void hgrn_passC(KP p, int item, int lane) {
    const int cs = item >> 3, dir = (item >> 2) & 1, h = item & 3;
    const ChunkInfo ci = chunk_info(cs);
    float S[64];
    {
        const float* s0 = p->HS + (size_t)item * 4096 + lane;
#pragma unroll
        for (int k = 0; k < 64; ++k) S[k] = s0[k * 64];
    }
    for (int s = 0; s < 64; ++s) {
        const int g = ci.c * 64 + s, t = dir ? ci.T - 1 - g : g;
        const size_t r = (size_t)(ci.row0 + t);
        const float fv = p->HF[((size_t)dir * M + r) * 256 + h * 64 + lane];
        const float qv = p->HQ[r * 256 + h * 64 + lane];
        const float vi = p->U[r * INCP + HG_OFF + 256 + h * 64 + lane];
        float o = 0.f;
#pragma unroll
        for (int k = 0; k < 64; ++k) {
            const float fk = bcast(fv, k);
            S[k] = fk * (S[k] - vi) + vi;
            o += bcast(qv, k) * S[k];
        }
        p->OH[((size_t)dir * M + r) * 256 + h * 64 + lane] = o;
    }
}
__device__ __forceinline__ void gdn_passC(KP p, int item, int lane) {
    const int cs = item >> 3, dir = (item >> 2) & 1, h = item & 3;
    const ChunkInfo ci = chunk_info(cs);
    float S[64];
    {
        const float* s0 = p->GS + (size_t)item * 4096 + lane;
#pragma unroll
        for (int k = 0; k < 64; ++k) S[k] = s0[k * 64];
    }
    for (int s = 0; s < 64; ++s) {
        const int g = ci.c * 64 + s, t = dir ? ci.T - 1 - g : g;
        const size_t r = (size_t)(ci.row0 + t);
        const float qv = p->GQ[r * 256 + h * 64 + lane], kv = p->GK[r * 256 + h * 64 + lane], vi = p->GV[r * 256 + h * 64 + lane];
        const float a = p->GA[r * 8 + dir * 4 + h], beta = p->GBT[r * 8 + dir * 4 + h];
        float kS = 0.f;
#pragma unroll
        for (int k = 0; k < 64; ++k) kS += bcast(kv, k) * S[k];
        const float cc = beta * (vi - a * kS);
        float o = 0.f;
#pragma unroll
        for (int k = 0; k < 64; ++k) { S[k] = a * S[k] + bcast(kv, k) * cc; o += bcast(qv, k) * S[k]; }
        p->OG[((size_t)dir * M + r) * 256 + h * 64 + lane] = o;
    }
}
__device__ __forceinline__ void ph_scanC(KP p) {
    const int tix = otid();
    const int lane = tix & 63, wv = tix >> 6;
    const int gw = wv * gridDim.x + blockIdx.x;
    for (int it = gw; it < 2 * NITEM; it += gridDim.x * 8) {
        if (it < NITEM) gdn_passC(p, it, lane); else hgrn_passC(p, it - NITEM, lane);
    }
}

struct KVFrag { bf16x8 k[2][3]; bf16x4 v[4][2]; };
__device__ __forceinline__ void attn_load(KVFrag& f, const bf16* Kb, const bf16* Vt, int nk, int k0, int q, int g) {
#pragma unroll
    for (int tt = 0; tt < 2; ++tt)
#pragma unroll
        for (int s = 0; s < 3; ++s) f.k[tt][s] = *(const bf16x8*)(Kb + (size_t)(k0 + 16 * tt + q) * 96 + 32 * s + 8 * g);
#pragma unroll
    for (int vt = 0; vt < 4; ++vt)
#pragma unroll
        for (int tt = 0; tt < 2; ++tt) f.v[vt][tt] = *(const bf16x4*)(Vt + (size_t)(16 * vt + q) * nk + k0 + 16 * tt + 4 * g);
}
__device__ __forceinline__ void attn_wave(KP p, int item, int lane) {
    int seq, h, qb, nk, r0; const bf16 *Kb, *Vt;
    if (item < 1024) { seq = item >> 6; h = (item >> 4) & 3; qb = item & 15; nk = T_P; r0 = seq * T_P + qb * 16;
        Kb = p->KBP + (size_t)(seq * 4 + h) * T_P * 96; Vt = p->VTP + (size_t)(seq * 4 + h) * 64 * T_P; }
    else { const int j = item - 1024; seq = j >> 8; h = (j >> 6) & 3; qb = j & 63; nk = NKS; r0 = M_P + seq * T_S + qb * 16;
        Kb = p->KBS + (size_t)(seq * 4 + h) * NKS * 96; Vt = p->VTS + (size_t)(seq * 4 + h) * 64 * NKS; }
    const int q = lane & 15, g = lane >> 4;
    bf16x8 qf[3];
#pragma unroll
    for (int s = 0; s < 3; ++s) qf[s] = *(const bf16x8*)(p->QB + (size_t)(r0 + q) * 384 + h * 96 + 32 * s + 8 * g);
    f32x4 o[4];
#pragma unroll
    for (int vt = 0; vt < 4; ++vt) o[vt] = (f32x4){0.f, 0.f, 0.f, 0.f};
    float m = -1e30f, lsum = 0.f;
    const int nblk = nk >> 5;
    KVFrag cur, nxt;
    attn_load(cur, Kb, Vt, nk, 0, q, g);
    for (int kb = 0; kb < nblk; ++kb) {
        const int kn = (kb + 1 < nblk) ? kb + 1 : kb;
        attn_load(nxt, Kb, Vt, nk, kn * 32, q, g);
        f32x4 s0 = (f32x4){0.f, 0.f, 0.f, 0.f}, s1 = (f32x4){0.f, 0.f, 0.f, 0.f};
#pragma unroll
        for (int s = 0; s < 3; ++s) { s0 = __builtin_amdgcn_mfma_f32_16x16x32_bf16(cur.k[0][s], qf[s], s0, 0, 0, 0); s1 = __builtin_amdgcn_mfma_f32_16x16x32_bf16(cur.k[1][s], qf[s], s1, 0, 0, 0); }
        float ml = fmaxf(fmaxf(fmaxf(s0[0], s0[1]), fmaxf(s0[2], s0[3])), fmaxf(fmaxf(s1[0], s1[1]), fmaxf(s1[2], s1[3])));
        ml = fmaxf(ml, __builtin_bit_cast(float, __builtin_amdgcn_ds_bpermute((lane ^ 16) << 2, __builtin_bit_cast(int, ml))));
        ml = fmaxf(ml, __builtin_bit_cast(float, __builtin_amdgcn_ds_bpermute((lane ^ 32) << 2, __builtin_bit_cast(int, ml))));
        const float mn = fmaxf(m, ml);
        const float corr = __expf(m - mn);
        float pv[8];
#pragma unroll
        for (int i = 0; i < 4; ++i) { pv[i] = __expf(s0[i] - mn); pv[4 + i] = __expf(s1[i] - mn); }
        lsum = lsum * corr + ((pv[0] + pv[1]) + (pv[2] + pv[3])) + ((pv[4] + pv[5]) + (pv[6] + pv[7]));
        m = mn;
        u32x4 pw; pw.x = pg8::cvt_pk_bf16(pv[0], pv[1]); pw.y = pg8::cvt_pk_bf16(pv[2], pv[3]); pw.z = pg8::cvt_pk_bf16(pv[4], pv[5]); pw.w = pg8::cvt_pk_bf16(pv[6], pv[7]);
        const bf16x8 pf = __builtin_bit_cast(bf16x8, pw);
#pragma unroll
        for (int vt = 0; vt < 4; ++vt) {
            bf16x8 af;
            af[0] = cur.v[vt][0][0]; af[1] = cur.v[vt][0][1]; af[2] = cur.v[vt][0][2]; af[3] = cur.v[vt][0][3];
            af[4] = cur.v[vt][1][0]; af[5] = cur.v[vt][1][1]; af[6] = cur.v[vt][1][2]; af[7] = cur.v[vt][1][3];
            o[vt] = __builtin_amdgcn_mfma_f32_16x16x32_bf16(af, pf, o[vt] * corr, 0, 0, 0);
        }
        cur = nxt;
    }
    lsum += __builtin_bit_cast(float, __builtin_amdgcn_ds_bpermute((lane ^ 16) << 2, __builtin_bit_cast(int, lsum)));
    lsum += __builtin_bit_cast(float, __builtin_amdgcn_ds_bpermute((lane ^ 32) << 2, __builtin_bit_cast(int, lsum)));
    const float inv = 1.0f / lsum;
    bf16* orow = p->OCAT + (size_t)(r0 + q) * D + 512 + h * 64 + 4 * g;
#pragma unroll
    for (int vt = 0; vt < 4; ++vt) { u32x2 w; w.x = pk2(o[vt][0] * inv, o[vt][1] * inv); w.y = pk2(o[vt][2] * inv, o[vt][3] * inv); *(u32x2*)(orow + 16 * vt) = w; }
}

__device__ __forceinline__ void hyena_wave(KP p, int l, int item, int lane) {
    int seq, tb, cw, T, row0, set;
    if (item < 1024) { seq = item >> 6; tb = (item >> 2) & 15; cw = item & 3; T = T_P; row0 = seq * T_P; set = 0; }
    else { const int j = item - 1024; seq = j >> 8; tb = (j >> 2) & 63; cw = j & 3; T = T_S; row0 = M_P + seq * T_S; set = 1; }
    const int c = cw * 64 + lane, t0 = tb * 16;
    const float* G = p->FILT + (size_t)l * FILT_L + (set ? (size_t)2 * 256 * 256 : 0) + c;
    const float* Zp = p->Z + (size_t)row0 * 256 + c;
    float acc[16];
#pragma unroll
    for (int i = 0; i < 16; ++i) acc[i] = 0.f;
    for (int s0 = 0; s0 < T; s0 += 16) {
        float tap[31], z[16];
        const float* gp = G + (size_t)(t0 - s0 - 15 + T) * 256;
#pragma unroll
        for (int i = 0; i < 31; ++i) tap[i] = gp[(size_t)i * 256];
#pragma unroll
        for (int j = 0; j < 16; ++j) z[j] = Zp[(size_t)(s0 + j) * 256];
#pragma unroll
        for (int i = 0; i < 16; ++i)
#pragma unroll
            for (int j = 0; j < 16; ++j) acc[i] += tap[i - j + 15] * z[j];
    }
    const float skip = p->hy_skip[l * 256 + c];
#pragma unroll
    for (int i = 0; i < 16; ++i) {
        const size_t r = (size_t)(row0 + t0 + i);
        const float zz = p->Z[r * 256 + c];
        p->OCAT[r * D + 256 + c] = (bf16)f2bf(p->X0[r * 256 + c] * (acc[i] + zz * skip));
    }
}

__device__ __forceinline__ void ph_mixB(KP p, int l, LAS float* lds_f) {
    const int tix = otid();
    const int lane = tix & 63, wv = tix >> 6;
    const int G = gridDim.x;
    {
        int sdh = -1;
        if ((int)blockIdx.x < 16) sdh = 128 + blockIdx.x; else if ((int)blockIdx.x < 144) sdh = blockIdx.x - 16;
        if (G >= 144) { if (sdh >= 0) gdn_passB(p, l, sdh, lds_f, lane, wv); }
        else { for (int i = blockIdx.x; i < 144; i += G) gdn_passB(p, l, i < 16 ? 128 + i : i - 16, lds_f, lane, wv); }
    }
    const int nb0 = (G > 32) ? 16 : 0, nblk = G - nb0;
    if ((int)blockIdx.x >= nb0) {
        const int vb = blockIdx.x - nb0;
        hgrn_passB(p, l, vb * NTHREADS + tix, nblk * NTHREADS);
        const int gw = wv * nblk + vb;
        for (int it = gw; it < 512 + 512 + 1024 + 1024; it += nblk * 8) {
            if (it < 512) attn_wave(p, 1024 + it, lane);
            else if (it < 1024) hyena_wave(p, l, 1024 + (it - 512), lane);
            else if (it < 2048) hyena_wave(p, l, it - 1024, lane);
            else attn_wave(p, it - 2048, lane);
        }
    }
}

__device__ __forceinline__ void ph_headnorm(KP p, int l) {
    const int tix = otid();
    const int lane = tix & 63, wv = tix >> 6;
    for (int item = blockIdx.x * 8 + wv; item < M * 8; item += gridDim.x * 8) {
        const int r = item >> 3, which = (item >> 2) & 1, h = item & 3;
        const int c = h * 64 + lane;
        const float* O = which ? p->OG : p->OH;
        const float o = O[(size_t)r * 256 + c] + O[((size_t)M + r) * 256 + c];
        const float ss = wave_sum(o * o, lane);
        const float rstd = 1.0f / sqrtf(ss * (1.0f / 64.f) + RMS_EPS);
        const float gn = which ? p->gdn_norm[l * 64 + lane] : p->hgrn_norm[l * 256 + c];
        const float g = which ? p->U[(size_t)r * INCP + GD_OFF + 768 + c] : p->U[(size_t)r * INCP + HG_OFF + 512 + c];
        p->OCAT[(size_t)r * D + (which ? 768 : 0) + c] = (bf16)f2bf(o * rstd * gn * siluf_(g));
    }
}

#define XB_TMO      128
#define XB_XCNT(j)  (256  + 64 * (j))
#define XB_XSUB(j)  (1280 + 64 * (j))
#define XB_XGEN(j)  (2304 + 64 * (j))
#define XB_TOP      3328
#define XB_TOPGEN   3392
#define XCD_BAR_WORDS 3456
#define XB_SPIN_CAP (1u << 18)

__device__ __forceinline__ unsigned xb_ld(unsigned* p)              { return __hip_atomic_load(p, __ATOMIC_RELAXED, __HIP_MEMORY_SCOPE_AGENT); }
__device__ __forceinline__ unsigned xb_add(unsigned* p, unsigned v) { return __hip_atomic_fetch_add(p, v, __ATOMIC_RELAXED, __HIP_MEMORY_SCOPE_AGENT); }
__device__ __forceinline__ unsigned xb_xcc_id() { return (unsigned)__builtin_amdgcn_s_getreg((3 << 11) | 20) & 0xFu; }
#define XB_SPIN(cond, bar) do { unsigned _sp = 0; while (cond) { __builtin_amdgcn_s_sleep(1); \
    if ((++_sp & 255u) == 0u) { if (xb_ld(&(bar)[XB_TMO])) break; if (_sp > XB_SPIN_CAP) { atomicAdd(&(bar)[XB_TMO], 1u); break; } } } } while (0)

struct XcdBarrier {
    unsigned* bar; unsigned x;
    volatile LAS unsigned* st;
};

__device__ __forceinline__ XcdBarrier xcd_barrier_post(unsigned* bar, volatile LAS unsigned* st) {
    XcdBarrier b; b.bar = bar; b.x = xb_xcc_id(); b.st = st;
    if (threadIdx.x == 0) (void)xb_add(&bar[XB_XCNT(b.x)], 1u);
    return b;
}
__device__ __forceinline__ void xcd_barrier_complete(unsigned* bar, unsigned x, unsigned& nloc, unsigned& nx) {
    const unsigned G = gridDim.x * gridDim.y * gridDim.z;
    unsigned sum, cnt, mine, sp = 0u;
    for (;;) {
        sum = 0u; cnt = 0u; mine = 0u;
#pragma unroll
        for (unsigned j = 0; j < 16; ++j) { const unsigned c = xb_ld(&bar[XB_XCNT(j)]); sum += c; cnt += (c > 0u) ? 1u : 0u; mine = (j == x) ? c : mine; }
        if (sum == G) break;
        __builtin_amdgcn_s_sleep(1);
        if ((++sp & 255u) == 0u) { if (xb_ld(&bar[XB_TMO])) break; if (sp > XB_SPIN_CAP) { atomicAdd(&bar[XB_TMO], 1u); break; } }
    }
    nloc = mine > 0u ? mine : 1u; nx = cnt > 0u ? cnt : 1u;
}

__device__ __forceinline__ void xcd_barrier(const XcdBarrier& b) {
    asm volatile("s_waitcnt vmcnt(0)" ::: "memory");
    __syncthreads();
    if (threadIdx.x == 0) {
        unsigned* bar = b.bar;
        __builtin_amdgcn_s_waitcnt(0);
        unsigned nloc = b.st[0], nx = b.st[1];
        if (nloc == 0u) { xcd_barrier_complete(bar, b.x, nloc, nx); b.st[0] = nloc; b.st[1] = nx; }
        const unsigned old = xb_add(&bar[XB_XSUB(b.x)], 1u);
        const unsigned gen = old / nloc;
        if (old + 1u == (gen + 1u) * nloc) {
            __builtin_amdgcn_fence(__ATOMIC_RELEASE, "agent");
            asm volatile("s_waitcnt vmcnt(0)" ::: "memory");
            const unsigned og = xb_add(&bar[XB_TOP], 1u);
            const unsigned tg = og / nx;
            if (og + 1u == (tg + 1u) * nx) xb_add(&bar[XB_TOPGEN], 1u);
            else XB_SPIN(xb_ld(&bar[XB_TOPGEN]) == tg, bar);
            __builtin_amdgcn_fence(__ATOMIC_ACQUIRE, "agent");
            xb_add(&bar[XB_XGEN(b.x)], 1u);
            asm volatile("s_waitcnt vmcnt(0)" ::: "memory");
        } else {
            XB_SPIN(xb_ld(&bar[XB_XGEN(b.x)]) == gen, bar);
            __builtin_amdgcn_fence(__ATOMIC_ACQUIRE, "agent");
            asm volatile("s_waitcnt vmcnt(0)" ::: "memory");
        }
    }
    __syncthreads();
}

__global__ void __launch_bounds__(NTHREADS, 2) fwd_megakernel(P p) {
    extern __shared__ __attribute__((aligned(16))) unsigned char lds_raw[];
    LAS unsigned char* lds = (LAS unsigned char*)lds_raw;
    const int G = gridDim.x;
    volatile LAS unsigned* MISC = (volatile LAS unsigned*)(lds + 131072);
    if (threadIdx.x < 64) MISC[threadIdx.x] = 0u;
    __syncthreads();
    (void)xcd_barrier_post(FRESH_P()->BAR, MISC + 8);
#define GRID_SYNC() do { XcdBarrier b_; b_.bar = FRESH_P()->BAR; b_.x = xb_xcc_id(); b_.st = (volatile LAS unsigned*)(lds + 131072) + 8; xcd_barrier(b_); } while (0)

    ph_init(FRESH_P());
#ifndef NO_ADA
    ph_ada(FRESH_P(), (LAS float*)lds);
#endif
#ifndef NO_SMALL
    ph_small(FRESH_P());
#endif
#ifndef NO_FILT
    ph_filt(FRESH_P(), (LAS double*)lds);
#endif
#ifndef NO_WPREP
    ph_wprep(FRESH_P(), (LAS float*)lds);
#endif
    GRID_SYNC();

#pragma unroll 1
    for (int l = 0; l < DEPTH; ++l) {
#pragma unroll 1
        for (int f = 0; f < 2; ++f) {
            if (f == 1) {
                ph_norm(FRESH_P(), l, 1);
                GRID_SYNC();
#ifndef NO_GIN
                { KP q = FRESH_P(); pg8::Gemm g{q->H, q->WIN + (size_t)l * INCP * D, M, INCP, D}; pg8::StaticOrder S; S.init(M, INCP, G, (int)blockIdx.x);
                  EpiF32 E{q->U, INCP};
                  pg8::gemm_phase<EpiF32, pg8::StaticOrder, true, true>(lds, g, S, E); }
#endif
                GRID_SYNC();
                ph_mla_prep(FRESH_P(), l);
                ph_tok_prep(FRESH_P(), l);
                GRID_SYNC();
                ph_scanA(FRESH_P());
                GRID_SYNC();
                ph_mixB(FRESH_P(), l, (LAS float*)lds);
                GRID_SYNC();
                ph_scanC(FRESH_P());
                GRID_SYNC();
                ph_headnorm(FRESH_P(), l);
                GRID_SYNC();
#ifndef NO_GOUT
                { KP q = FRESH_P(); pg8::Gemm g{q->OCAT, q->WOUT + (size_t)l * D * D, M, D, D}; pg8::StaticOrder S; S.init(M, D, G, (int)blockIdx.x);
                  EpiResid E{q->X, q->ADA + (size_t)(l * 3) * NADA * D + 5 * D, 1.0f};
                  pg8::gemm_phase<EpiResid, pg8::StaticOrder, true, true>(lds, g, S, E); }
#endif
                GRID_SYNC();
            }
            const int s = f == 0 ? 0 : 2;
            ph_norm(FRESH_P(), l, s);
            GRID_SYNC();
#ifndef NO_GGU
            { KP q = FRESH_P(); pg8::Gemm g{q->H, q->WGU + (size_t)(l * 2 + f) * 2 * DFF * D, M, 2 * DFF, D}; pg8::StaticOrder S; S.init(M, 2 * DFF, G, (int)blockIdx.x);
              EpiSwiGLU E{q->ACT};
              pg8::gemm_phase<EpiSwiGLU, pg8::StaticOrder, true, true>(lds, g, S, E); }
#endif
            GRID_SYNC();
#ifndef NO_GDN
            { KP q = FRESH_P(); pg8::Gemm g{q->ACT, q->WDN + (size_t)(l * 2 + f) * D * DFF, M, D, DFF}; pg8::StaticOrder S; S.init(M, D, G, (int)blockIdx.x);
              EpiResid E{q->X, q->ADA + (size_t)(l * 3) * NADA * D + (3 * s + 2) * D, 0.5f};
              pg8::gemm_phase<EpiResid, pg8::StaticOrder, true, true>(lds, g, S, E); }
#endif
            GRID_SYNC();
        }
    }
}

}

extern "C" void kernel_launch(void* const* d_in, const int* in_sizes, int n_in, void* d_out, int out_size, void* d_ws, size_t ws_size, hipStream_t stream) {
    P p{};
    const float* const* in = (const float* const*)d_in;
    p.x_prompt = in[0]; p.x_sample = in[1]; p.cache_ckv = in[2]; p.cache_krope = in[3]; p.state_hgrn = in[4]; p.state_gdn = in[5]; p.c = in[6]; p.c_ctx = in[7];
    p.w_ada = in[8]; p.b_ada = in[9]; p.norm_ffn = in[10]; p.w_gu = in[11]; p.w_down = in[12]; p.norm_mix = in[13]; p.w_in = in[14]; p.w_out = in[15];
    p.hgrn_lb = in[16]; p.hgrn_norm = in[17]; p.hy_conv_w = in[18]; p.hy_conv_b = in[19]; p.hy_w1 = in[20]; p.hy_b1 = in[21]; p.hy_freq = in[22];
    p.hy_w2 = in[23]; p.hy_b2 = in[24]; p.hy_w3 = in[25]; p.hy_skip = in[26]; p.q_norm_a = in[27]; p.w_q_up = in[28]; p.kv_norm_a = in[29];
    p.w_kv_up = in[30]; p.qk_norm = in[31]; p.gdn_conv_w = in[32]; p.gdn_a_log = in[33]; p.gdn_dt_bias = in[34]; p.gdn_norm = in[35];
    float* out = (float*)d_out;
    p.X = out;
    p.o_ckv = out + (size_t)M * D;
    p.o_krope = p.o_ckv + (size_t)NB_P * DEPTH * T_P * 128;
    p.o_shg = p.o_krope + (size_t)NB_P * DEPTH * T_P * 32;
    p.o_sgd = p.o_shg + (size_t)NB_P * DEPTH * 2 * 4 * 64 * 64;
    unsigned char* w = (unsigned char*)d_ws;
    auto take = [&](size_t bytes) { unsigned char* r = w; w += (bytes + 255) & ~(size_t)255; return r; };
    p.ADA = (float*)take((size_t)DEPTH * 3 * NADA * D * 4);
    p.LB = (float*)take(DEPTH * 512 * 4);
    p.FILT = (float*)take(DEPTH * FILT_L * 4);
    p.ROPE = (float*)take(2 * 1024 * 16 * 4);
    p.WGU = (bf16*)take((size_t)DEPTH * 2 * 2 * DFF * D * 2);
    p.WDN = (bf16*)take((size_t)DEPTH * 2 * D * DFF * 2);
    p.WIN = (bf16*)take((size_t)DEPTH * INCP * D * 2);
    p.WOUT = (bf16*)take((size_t)DEPTH * D * D * 2);
    p.WQT = (bf16*)take((size_t)DEPTH * 384 * 256 * 2); p.WKVT = (bf16*)take((size_t)DEPTH * 512 * 128 * 2);
    p.H = (bf16*)take((size_t)M * D * 2);
    p.ACT = (bf16*)take((size_t)M * DFF * 2);
    p.OCAT = (bf16*)take((size_t)M * D * 2);
    p.U = (float*)take((size_t)M * INCP * 4);
    p.QB = (bf16*)take((size_t)M * 384 * 2);
    p.KBP = (bf16*)take((size_t)NB_P * 4 * T_P * 96 * 2); p.VTP = (bf16*)take((size_t)NB_P * 4 * 64 * T_P * 2);
    p.KBS = (bf16*)take((size_t)NB_S * 4 * NKS * 96 * 2); p.VTS = (bf16*)take((size_t)NB_S * 4 * 64 * NKS * 2);
    p.GQ = (float*)take((size_t)M * 256 * 4); p.GK = (float*)take((size_t)M * 256 * 4); p.GV = (float*)take((size_t)M * 256 * 4);
    p.GA = (float*)take((size_t)M * 8 * 4); p.GBT = (float*)take((size_t)M * 8 * 4);
    p.HF = (float*)take((size_t)2 * M * 256 * 4); p.HQ = (float*)take((size_t)M * 256 * 4);
    p.Z = (float*)take((size_t)M * 256 * 4); p.X0 = (float*)take((size_t)M * 256 * 4);
    p.OH = (float*)take((size_t)2 * M * 256 * 4); p.OG = (float*)take((size_t)2 * M * 256 * 4);
    p.HS = (float*)take((size_t)768 * 4096 * 4); p.HD = (float*)take((size_t)768 * 64 * 4);
    p.GS = (float*)take((size_t)768 * 4096 * 4); p.GP = (float*)take((size_t)768 * 4096 * 4);
    p.BAR = (unsigned*)take(16384);

    static int grid_blocks = 0;
    if (!grid_blocks) {
        int dev = 0, cus = 0, per_cu = 0;
        hipGetDevice(&dev);
        hipDeviceGetAttribute(&cus, hipDeviceAttributeMultiprocessorCount, dev);
        hipFuncSetAttribute((const void*)fwd_megakernel, hipFuncAttributeMaxDynamicSharedMemorySize, LDS_BYTES);
        hipOccupancyMaxActiveBlocksPerMultiprocessor(&per_cu, (const void*)fwd_megakernel, NTHREADS, LDS_BYTES);
        if (per_cu < 1) { fprintf(stderr, "kernel_launch: occupancy query reports %d blocks per CU\n", per_cu); per_cu = 1; }
        if (per_cu > 1) per_cu = 1;
        grid_blocks = cus * per_cu;
    }
    (void)hipMemsetAsync(p.BAR, 0, 16384, stream);
    void* args[] = {&p};
    hipError_t e = hipLaunchCooperativeKernel((const void*)fwd_megakernel, dim3(grid_blocks), dim3(NTHREADS), args, LDS_BYTES, stream);
    if (e != hipSuccess) fprintf(stderr, "cooperative launch failed: %s (grid %d)\n", hipGetErrorString(e), grid_blocks);
}
```

```cpp
#define REP_SCANC 2
#include <hip/hip_runtime.h>
#include <hip/hip_cooperative_groups.h>
#include <stdint.h>
#include <math.h>
#include <cstdio>
#include <type_traits>
namespace cg = cooperative_groups;

namespace pg8 {
#define PG8_LAS __attribute__((address_space(3)))
typedef unsigned short bf16_t;
typedef short bf16x8 __attribute__((ext_vector_type(8)));
typedef float f32x4 __attribute__((ext_vector_type(4)));
typedef unsigned u32x4 __attribute__((ext_vector_type(4)));
constexpr int BM = 256, BK = 64, HALF = 128, HTB = HALF * BK * 2  , STAGE_BYTES = 8 * HTB, NXCD = 8, WGM = 8;

__host__ __device__ __forceinline__ int lds_byte(int r, int c) { const int st = (r >> 4) * 2 + (c >> 5), rr = r & 15, cc = c & 31, ob = rr * 64 + cc * 2; return st * 1024 + (ob ^ (((ob >> 9) & 1) << 5)); }
__host__ __device__ __forceinline__ void stage_rc(int b, int& R, int& C) { const int st = b / 1024, sb = b % 1024, swz = sb ^ (((sb >> 9) & 1) << 5); R = (st >> 1) * 16 + swz / 64; C = (st & 1) * 32 + (swz % 64) / 2; }
__host__ __device__ __forceinline__ int perm32(int rho) { const int n = rho >> 4, i = rho & 15; return 8 * (i >> 2) + 4 * n + (i & 3); }

struct Unit { int pm, pn; };
struct Gemm { const bf16_t* A; const bf16_t* Bt; int M, N, K; };

struct StaticOrder {
    int nM, nN, nwg, G, c;
    __host__ __device__ void init(int M, int N, int G_, int c_) { nM = M / BM; nN = N / BM; nwg = nM * nN; G = G_; c = c_; }
    __host__ __device__ bool next(int i, Unit& u) const {
        const long L = (long)i * G + c; if (L >= nwg) return false;
        int wgid = (int)L; { const int q = nwg / NXCD, r = nwg % NXCD, xcd = wgid % NXCD, off = wgid / NXCD; wgid = (xcd < r ? xcd * (q + 1) : r * (q + 1) + (xcd - r) * q) + off; }
        const int nig = WGM * nN, gid = wgid / nig, fm = gid * WGM, gsz = (nM - fm) < WGM ? (nM - fm) : WGM;
        u.pm = fm + ((wgid % nig) % gsz); u.pn = (wgid % nig) / gsz; return true;
    }
    __device__ __forceinline__ void a_ready(const Unit&) const {}
    __device__ __forceinline__ void done(const Unit&) const {}
};

__device__ __forceinline__ unsigned cvt_pk_bf16(float lo, float hi) { unsigned r; asm volatile("v_cvt_pk_bf16_f32 %0, %1, %2" : "=v"(r) : "v"(lo), "v"(hi)); return r; }

template <class Epi, class Sched, bool ALIGN_EPI = false, bool SP2 = false>
__device__ __forceinline__ void gemm_phase(PG8_LAS unsigned char* lds, const Gemm g, const Sched& S, const Epi& E) {
    int tid_ = threadIdx.x; asm volatile("" : "+v"(tid_));
    const int tid = tid_, wid = __builtin_amdgcn_readfirstlane(tid >> 6), lane = tid & 63, wr = wid >> 2, wc = wid & 3, fr = lane & 15, fq = lane >> 4;
    const int K = g.K, nt = K / BK;
    unsigned voffA[2], voffB[2];
#pragma unroll
    for (int i = 0; i < 2; ++i) { int R, C; stage_rc(tid * 16 + i * 8192, R, C); const int Rb = Epi::PERM ? ((R & ~31) + perm32(R & 31)) : R;
        voffA[i] = (unsigned)(R * K + C) * 2u; voffB[i] = (unsigned)(Rb * K + C) * 2u; }
    const size_t kstep = (size_t)(BK * 2);
    const size_t hstep = (size_t)HALF * K * 2;
    const size_t tstep = 2 * hstep;
    const unsigned ldsw = (unsigned)wid * 1024u;
    const int aoff = lds_byte(wr * 64 + fr, fq * 8), boff = lds_byte(wc * 32 + fr, fq * 8);
#define PG8_SA(b, h) (((b) * 2 + (h)) * HTB)
#define PG8_SB(b, h) ((4 + (b) * 2 + (h)) * HTB)
#define PG8_STAGE(bufoff, gbase, voff) do { _Pragma("unroll") for (int _i = 0; _i < 2; ++_i) \
        __builtin_amdgcn_global_load_lds((const unsigned*)((const char*)(gbase) + (voff)[_i]), (PG8_LAS unsigned*)(lds + (bufoff) + ldsw + _i * 8192), 16, 0, 0); } while (0)
#define PG8_LDA(dst, b, h) do { _Pragma("unroll") for (int m = 0; m < 4; ++m) _Pragma("unroll") for (int k = 0; k < 2; ++k) dst[m][k] = *(const PG8_LAS bf16x8*)(lds + PG8_SA(b, h) + aoff + m * 2048 + k * 1024); } while (0)
#define PG8_LDB(dst, b, h) do { _Pragma("unroll") for (int n = 0; n < 2; ++n) _Pragma("unroll") for (int k = 0; k < 2; ++k) dst[n][k] = *(const PG8_LAS bf16x8*)(lds + PG8_SB(b, h) + boff + n * 2048 + k * 1024); } while (0)
#define PG8_MMA(ai, bj, At, Bt) do { __builtin_amdgcn_s_setprio(1); _Pragma("unroll") for (int m = 0; m < 4; ++m) _Pragma("unroll") for (int n = 0; n < 2; ++n) _Pragma("unroll") for (int k = 0; k < 2; ++k) \
        acc[ai][bj][m][n] = __builtin_amdgcn_mfma_f32_16x16x32_bf16(Bt[n][k], At[m][k], acc[ai][bj][m][n], 0, 0, 0); __builtin_amdgcn_s_setprio(0); } while (0)
#define PG8_WAIT_V(n) asm volatile("s_waitcnt vmcnt(" #n ")" ::: "memory")
#define PG8_WAIT_L(n) asm volatile("s_waitcnt lgkmcnt(" #n ")" ::: "memory")
#define PG8_BAR __builtin_amdgcn_s_barrier()
#define PG8_SCHED __builtin_amdgcn_sched_barrier(0)
    Unit cur, nxt; int ui = 0;
    if (!S.next(0, cur)) return;
    f32x4 acc[2][2][4][2];
#pragma unroll
    for (int a = 0; a < 2; ++a)
#pragma unroll
        for (int b = 0; b < 2; ++b)
#pragma unroll
            for (int m = 0; m < 4; ++m)
#pragma unroll
                for (int n = 0; n < 2; ++n) acc[a][b][m][n] = (f32x4){0.f, 0.f, 0.f, 0.f};
    bf16x8 At[4][2], B0[2][2], B1[2][2];
    const char* cA = (const char*)g.A + (size_t)cur.pm * tstep; const char* cB = (const char*)g.Bt + (size_t)cur.pn * tstep;
    S.a_ready(cur);
    if constexpr (SP2) {
        PG8_STAGE(PG8_SB(0, 0), cB, voffB); PG8_STAGE(PG8_SB(0, 1), cB + hstep, voffB); PG8_STAGE(PG8_SA(0, 0), cA, voffA); PG8_STAGE(PG8_SA(0, 1), cA + hstep, voffA);
        if (wr == 1) PG8_BAR;
        PG8_WAIT_V(2); PG8_BAR;
        PG8_STAGE(PG8_SB(1, 0), cB + kstep, voffB); PG8_STAGE(PG8_SA(1, 0), cA + kstep, voffA); PG8_STAGE(PG8_SB(1, 1), cB + hstep + kstep, voffB);
        PG8_WAIT_V(6); PG8_BAR;
    } else {
        PG8_STAGE(PG8_SB(0, 0), cB, voffB); PG8_STAGE(PG8_SA(0, 0), cA, voffA); PG8_STAGE(PG8_SB(0, 1), cB + hstep, voffB); PG8_STAGE(PG8_SA(0, 1), cA + hstep, voffA);
        if (wr == 1) PG8_BAR;
        PG8_WAIT_V(4); PG8_BAR;
        PG8_STAGE(PG8_SB(1, 0), cB + kstep, voffB); PG8_STAGE(PG8_SA(1, 0), cA + kstep, voffA); PG8_STAGE(PG8_SB(1, 1), cB + hstep + kstep, voffB);
        PG8_WAIT_V(6); PG8_BAR;
    }
    for (;;) {
        const bool has_next = S.next(ui + 1, nxt);
        const char* nA = has_next ? (const char*)g.A + (size_t)nxt.pm * tstep : cA; const char* nB = has_next ? (const char*)g.Bt + (size_t)nxt.pn * tstep : cB;
        for (int t = 0; t < nt; t += 2) {
            const bool last = (t == nt - 2);
            const char* a1 = cA + (size_t)(t + 1) * kstep;
            const char* a2 = last ? nA : cA + (size_t)(t + 2) * kstep; const char* b2 = last ? nB : cB + (size_t)(t + 2) * kstep;
            const char* a3 = a2 + kstep; const char* b3 = b2 + kstep;
            if (last && has_next) S.a_ready(nxt);
            if constexpr (SP2) {
            PG8_LDB(B0, 0, 0); PG8_LDB(B1, 0, 1); PG8_SCHED; PG8_LDA(At, 0, 0); PG8_STAGE(PG8_SA(1, 1), a1 + hstep, voffA);
            PG8_WAIT_V(8); PG8_WAIT_L(0); PG8_BAR; PG8_MMA(0, 0, At, B0); PG8_MMA(0, 1, At, B1); PG8_BAR; PG8_SCHED;
            PG8_LDA(At, 0, 1); PG8_STAGE(PG8_SB(0, 0), b2, voffB); PG8_STAGE(PG8_SB(0, 1), b2 + hstep, voffB); PG8_STAGE(PG8_SA(0, 0), a2, voffA);
            PG8_WAIT_V(8); PG8_WAIT_L(0); PG8_BAR; PG8_MMA(1, 0, At, B0); PG8_MMA(1, 1, At, B1); PG8_BAR; PG8_SCHED;
            PG8_LDB(B0, 1, 0); PG8_LDB(B1, 1, 1); PG8_SCHED; PG8_LDA(At, 1, 0); PG8_STAGE(PG8_SA(0, 1), a2 + hstep, voffA);
            PG8_WAIT_V(8); PG8_WAIT_L(0); PG8_BAR; PG8_MMA(0, 0, At, B0); PG8_MMA(0, 1, At, B1); PG8_BAR; PG8_SCHED;
            PG8_LDA(At, 1, 1); PG8_STAGE(PG8_SB(1, 0), b3, voffB); PG8_STAGE(PG8_SB(1, 1), b3 + hstep, voffB); PG8_STAGE(PG8_SA(1, 0), a3, voffA);
            PG8_WAIT_V(8); PG8_WAIT_L(0); PG8_BAR; PG8_MMA(1, 0, At, B0); PG8_MMA(1, 1, At, B1); PG8_BAR; PG8_SCHED;
            } else {
            PG8_LDB(B0, 0, 0); PG8_SCHED; PG8_LDA(At, 0, 0); PG8_STAGE(PG8_SA(1, 1), a1 + hstep, voffA);
            PG8_WAIT_L(8); PG8_BAR; PG8_WAIT_L(0); PG8_MMA(0, 0, At, B0); PG8_BAR; PG8_SCHED;
            PG8_LDB(B1, 0, 1); PG8_STAGE(PG8_SB(0, 0), b2, voffB);
            PG8_BAR; PG8_WAIT_L(0); PG8_MMA(0, 1, At, B1); PG8_BAR;
            PG8_LDA(At, 0, 1); PG8_STAGE(PG8_SA(0, 0), a2, voffA);
            PG8_BAR; PG8_WAIT_L(0); PG8_MMA(1, 0, At, B0); PG8_BAR; PG8_SCHED;
            PG8_STAGE(PG8_SB(0, 1), b2 + hstep, voffB);
            PG8_WAIT_V(6); PG8_BAR; PG8_MMA(1, 1, At, B1); PG8_BAR;
            PG8_LDB(B0, 1, 0); PG8_SCHED; PG8_LDA(At, 1, 0); PG8_STAGE(PG8_SA(0, 1), a2 + hstep, voffA);
            PG8_WAIT_L(8); PG8_BAR; PG8_WAIT_L(0); PG8_MMA(0, 0, At, B0); PG8_BAR; PG8_SCHED;
            PG8_LDB(B1, 1, 1); PG8_STAGE(PG8_SB(1, 0), b3, voffB);
            PG8_BAR; PG8_WAIT_L(0); PG8_MMA(0, 1, At, B1); PG8_BAR;
            PG8_LDA(At, 1, 1); PG8_STAGE(PG8_SA(1, 0), a3, voffA);
            PG8_BAR; PG8_WAIT_L(0); PG8_MMA(1, 0, At, B0); PG8_BAR; PG8_SCHED;
            PG8_STAGE(PG8_SB(1, 1), b3 + hstep, voffB);
            PG8_WAIT_V(6); PG8_BAR; PG8_MMA(1, 1, At, B1); PG8_BAR;
            }
        }
        if constexpr (ALIGN_EPI) { if (wr == 0) PG8_BAR; }
        if constexpr (!Epi::AFTER_DRAIN) { E(acc, cur, wr, wc, fr, fq); S.done(cur); }
        if (!has_next) break;
#pragma unroll
        for (int a = 0; a < 2; ++a)
#pragma unroll
            for (int b = 0; b < 2; ++b)
#pragma unroll
                for (int m = 0; m < 4; ++m)
#pragma unroll
                    for (int n = 0; n < 2; ++n) acc[a][b][m][n] = (f32x4){0.f, 0.f, 0.f, 0.f};
        cur = nxt; cA = nA; cB = nB; ++ui;
        if constexpr (ALIGN_EPI) { if (wr == 1) PG8_BAR; }
    }
    PG8_WAIT_V(0);
    if constexpr (!ALIGN_EPI) { if (wr == 0) PG8_BAR; }
    PG8_BAR;
    if constexpr (Epi::AFTER_DRAIN) { E.fused(acc, cur, wr, wc, fr, fq, lds, wid, lane); S.done(cur); }
#undef PG8_SA
#undef PG8_SB
#undef PG8_STAGE
#undef PG8_LDA
#undef PG8_LDB
#undef PG8_MMA
#undef PG8_WAIT_V
#undef PG8_WAIT_L
#undef PG8_BAR
#undef PG8_SCHED
}
}

namespace {
#define LAS __attribute__((address_space(3)))
typedef unsigned short bf16;
typedef float f32x4 __attribute__((ext_vector_type(4)));
typedef unsigned u32x4 __attribute__((ext_vector_type(4)));
typedef unsigned u32x2 __attribute__((ext_vector_type(2)));
typedef short bf16x8 __attribute__((ext_vector_type(8)));
typedef short bf16x4 __attribute__((ext_vector_type(4)));

constexpr int NTHREADS = 512;
constexpr int D = 1024, NB_P = 16, T_P = 256, NB_S = 2, T_S = 1024, DEPTH = 4, PAST = 256;
constexpr int M_P = NB_P * T_P, M_S = NB_S * T_S, M = M_P + M_S;
constexpr int DFF = 2816, NADA = 9, INC = 3504, INCP = 3584;
constexpr int HG_OFF = 0, HY_OFF = 1280, MLA_OFF = 2048, GD_OFF = 2464;
constexpr int NKS = T_S + PAST;
constexpr float RMS_EPS = 1e-6f;
constexpr int LDS_BYTES = 147456;
constexpr size_t FILT_L = 2 * (256 + 1024) * 256;

struct P {
    const float *x_prompt, *x_sample, *cache_ckv, *cache_krope, *state_hgrn, *state_gdn, *c, *c_ctx;
    const float *w_ada, *b_ada, *norm_ffn, *w_gu, *w_down, *norm_mix, *w_in, *w_out, *hgrn_lb, *hgrn_norm;
    const float *hy_conv_w, *hy_conv_b, *hy_w1, *hy_b1, *hy_freq, *hy_w2, *hy_b2, *hy_w3, *hy_skip;
    const float *q_norm_a, *w_q_up, *kv_norm_a, *w_kv_up, *qk_norm, *gdn_conv_w, *gdn_a_log, *gdn_dt_bias, *gdn_norm;
    float *X;
    float *o_ckv, *o_krope, *o_shg, *o_sgd;
    float *ADA;
    float *LB;
    float *FILT;
    float *ROPE;
    bf16 *WGU;
    bf16 *WDN;
    bf16 *WIN;
    bf16 *WOUT;
    bf16 *WQT, *WKVT;
    bf16 *H;
    bf16 *ACT;
    bf16 *OCAT;
    float *U;
    bf16 *QB;
    bf16 *KBP, *VTP;
    bf16 *KBS, *VTS;
    float *GQ, *GK, *GV;
    float *GA, *GBT;
    float *HF, *HQ;
    float *Z, *X0;
    float *OH, *OG;
    float *HS, *HD;
    float *GS, *GP;
    float *HS2, *GS2;
    bf16 *GKB, *GQB;
    float *GLA;
    bf16 *ATT, *WN, *QG, *KOT;
    float *UB, *EGL;
    unsigned *BAR;
};

typedef const __attribute__((address_space(4))) P* KP;
#define FRESH_P() ({ KP k_ = (KP)__builtin_amdgcn_kernarg_segment_ptr(); asm volatile("" : "+s"(k_)); k_; })
__device__ __forceinline__ int otid() { int t = threadIdx.x; asm volatile("" : "+v"(t)); return t; }
__device__ __forceinline__ float sigmoidf_(float x) { return 1.f / (1.f + expf(-x)); }
__device__ __forceinline__ float siluf_(float x) { return x / (1.f + expf(-x)); }
__device__ __forceinline__ unsigned f2bf(float f) { unsigned u = __builtin_bit_cast(unsigned, f); return (u + 0x7fffu + ((u >> 16) & 1u)) >> 16; }
__device__ __forceinline__ unsigned pk2(float lo, float hi) { return f2bf(lo) | (f2bf(hi) << 16); }

__device__ __forceinline__ void row_info(int r, int& ci, int& T, int& row0, int& t, int& b) {
    if (r < M_P) { b = r >> 8; t = r & 255; T = T_P; row0 = b << 8; ci = 0; }
    else { const int rr = r - M_P; b = rr >> 10; t = rr & 1023; T = T_S; row0 = M_P + (b << 10); ci = 1 + b; }
}
__device__ __forceinline__ int panel_ci(int pm) { return pm < 16 ? 0 : 1 + ((pm - 16) >> 2); }

__device__ __forceinline__ float wave_sum(float v, int lane) {
#pragma unroll
    for (int o = 1; o < 64; o <<= 1) v += __builtin_bit_cast(float, __builtin_amdgcn_ds_bpermute((lane ^ o) << 2, __builtin_bit_cast(int, v)));
    return v;
}
__device__ __forceinline__ float bcast(float v, int k) { return __builtin_bit_cast(float, __builtin_amdgcn_readlane(__builtin_bit_cast(int, v), k)); }

struct EpiSwiGLU {
    static constexpr bool PERM = true, AFTER_DRAIN = false;
    bf16* O;
    __device__ __forceinline__ void operator()(const f32x4 (&acc)[2][2][4][2], const pg8::Unit& u, int wr, int wc, int fr, int fq) const {
        const int row0 = u.pm * 256 + wr * 64 + fr, col0 = u.pn * 128 + wc * 32 + 8 * fq;
#pragma unroll
        for (int ai = 0; ai < 2; ++ai)
#pragma unroll
            for (int m = 0; m < 4; ++m) {
                bf16* rowp = O + (size_t)(row0 + ai * 128 + m * 16) * DFF + col0;
                float v[8];
#pragma unroll
                for (int n = 0; n < 2; ++n)
#pragma unroll
                    for (int i = 0; i < 4; ++i) { const float g = acc[ai][0][m][n][i], up = acc[ai][1][m][n][i];
                        v[4 * n + i] = g * __builtin_amdgcn_rcpf(1.f + __expf(-g)) * up; }
                u32x4 w; w.x = pg8::cvt_pk_bf16(v[0], v[1]); w.y = pg8::cvt_pk_bf16(v[2], v[3]); w.z = pg8::cvt_pk_bf16(v[4], v[5]); w.w = pg8::cvt_pk_bf16(v[6], v[7]);
                *(u32x4*)rowp = w;
            }
    }
};
struct EpiF32 {
    static constexpr bool PERM = false, AFTER_DRAIN = false;
    float* C; int ldc;
    __device__ __forceinline__ void operator()(const f32x4 (&acc)[2][2][4][2], const pg8::Unit& u, int wr, int wc, int fr, int fq) const {
        const int row0 = u.pm * 256 + wr * 64 + fr, col0 = u.pn * 256 + wc * 32 + 4 * fq;
#pragma unroll
        for (int ai = 0; ai < 2; ++ai)
#pragma unroll
            for (int m = 0; m < 4; ++m) { float* rowp = C + (size_t)(row0 + ai * 128 + m * 16) * ldc + col0;
#pragma unroll
                for (int bj = 0; bj < 2; ++bj)
#pragma unroll
                    for (int n = 0; n < 2; ++n) *(f32x4*)(rowp + bj * 128 + n * 16) = acc[ai][bj][m][n]; }
    }
};
struct EpiResid {
    static constexpr bool PERM = false, AFTER_DRAIN = false;
    float* X; const float* gate; float coef;
    __device__ __forceinline__ void operator()(const f32x4 (&acc)[2][2][4][2], const pg8::Unit& u, int wr, int wc, int fr, int fq) const {
        const int row0 = u.pm * 256 + wr * 64 + fr, col0 = u.pn * 256 + wc * 32 + 4 * fq;
        const float* g = gate + (size_t)panel_ci(u.pm) * NADA * D + col0;
        f32x4 gv[2][2];
#pragma unroll
        for (int bj = 0; bj < 2; ++bj)
#pragma unroll
            for (int n = 0; n < 2; ++n) gv[bj][n] = *(const f32x4*)(g + bj * 128 + n * 16) * coef;
#pragma unroll
        for (int ai = 0; ai < 2; ++ai)
#pragma unroll
            for (int m = 0; m < 4; ++m) { float* rowp = X + (size_t)(row0 + ai * 128 + m * 16) * D + col0;
#pragma unroll
                for (int bj = 0; bj < 2; ++bj)
#pragma unroll
                    for (int n = 0; n < 2; ++n) { f32x4* q = (f32x4*)(rowp + bj * 128 + n * 16); *q = *q + gv[bj][n] * acc[ai][bj][m][n]; } }
    }
};

__device__ __forceinline__ void ph_init(KP p) {
    const int tix = otid();
    const int n4 = M * D / 4, np4 = M_P * D / 4;
    for (int i = blockIdx.x * NTHREADS + tix; i < n4; i += gridDim.x * NTHREADS) {
        const float4 v = (i < np4) ? ((const float4*)p->x_prompt)[i] : ((const float4*)p->x_sample)[i - np4];
        ((float4*)p->X)[i] = v;
    }
}

__device__ __forceinline__ void ph_ada(KP p, LAS float* sc  ) {
    const int tix = otid();
    const int lane = tix & 63, wv = tix >> 6;
    for (int i = tix; i < 3 * 1024; i += NTHREADS) {
        const int ci = i >> 10, k = i & 1023;
        const float v = (ci == 0) ? p->c_ctx[k] : p->c[(ci - 1) * 1024 + k];
        sc[i] = siluf_(v);
    }
    __syncthreads();
    LAS float* part = sc + 3 * 1024;
    const int NJ = NADA * D, NG = DEPTH * (NJ / 64);
    const int trips = (NG + gridDim.x - 1) / gridDim.x;
    for (int it = 0; it < trips; ++it) {
        const int item = it * gridDim.x + blockIdx.x; const bool act = item < NG;
        const int l = act ? item / (NJ / 64) : 0, j = (act ? item % (NJ / 64) : 0) * 64 + lane;
        float a0 = 0.f, a1 = 0.f, a2 = 0.f;
        if (act) {
            const float* w = p->w_ada + (size_t)l * D * NJ + (size_t)(wv * 128) * NJ + j;
#pragma unroll 16
            for (int k = 0; k < 128; ++k) { const float wvv = w[(size_t)k * NJ]; const int kk = wv * 128 + k; a0 += sc[kk] * wvv; a1 += sc[1024 + kk] * wvv; a2 += sc[2048 + kk] * wvv; }
        }
        part[(wv * 3 + 0) * 64 + lane] = a0; part[(wv * 3 + 1) * 64 + lane] = a1; part[(wv * 3 + 2) * 64 + lane] = a2;
        __syncthreads();
        if (act && wv < 3) {
            float s = p->b_ada[l * NJ + j];
#pragma unroll
            for (int w8 = 0; w8 < 8; ++w8) s += part[(w8 * 3 + wv) * 64 + lane];
            p->ADA[(size_t)(l * 3 + wv) * NJ + j] = s;
        }
        __syncthreads();
    }
}

__device__ __forceinline__ void ph_small(KP p) {
    const int tix = otid();
    const int gt = blockIdx.x * NTHREADS + tix, gn = gridDim.x * NTHREADS;
    for (int i = gt; i < 512; i += gn) {
        float v[4], mx = -1e30f;
        for (int l = 0; l < 4; ++l) { v[l] = p->hgrn_lb[l * 512 + i]; mx = fmaxf(mx, v[l]); }
        float s = 0.f;
        for (int l = 0; l < 4; ++l) { v[l] = expf(v[l] - mx); s += v[l]; }
        float cum = 0.f;
        for (int l = 0; l < 4; ++l) { if (l > 0) cum += v[l] / s; p->LB[l * 512 + i] = cum; }
    }
    for (int i = gt; i < 1024 * 16; i += gn) {
        const int t = i >> 4, j = i & 15;
        const int row = t >> 6, col = t & 63;
        const double inv = pow(10000.0, -(double)(j & 7) / 8.0);
        const double ang = (double)((j < 8) ? row : col) * inv;
        p->ROPE[i] = (float)cos(ang);
        p->ROPE[1024 * 16 + i] = (float)sin(ang);
    }
}

__device__ __forceinline__ void ph_filt(KP p, LAS double* scr  ) {
    const int tix = otid();
    const int lane = tix & 63, wv = tix >> 6;
    LAS double* ze = scr + wv * 168; LAS double* h1 = ze + 40; LAS double* h2 = h1 + 64;
    const int NIT = DEPTH * 1280, gw = blockIdx.x * 8 + wv, NGW = gridDim.x * 8;
    const int trips = (NIT + NGW - 1) / NGW;
    for (int it = 0; it < trips; ++it) {
        const int item = it * NGW + gw; const bool act = item < NIT;
        const int l = act ? item / 1280 : 0, q = act ? item % 1280 : 0;
        const int set = (q < 256) ? 0 : 1, pos = set ? q - 256 : q, L = set ? 1024 : 256;
        const double t = (double)pos / (double)(L - 1);
        if (lane == 0) ze[0] = t;
        if (lane < 16) {
            const double band = 1e-4 + (double)lane * ((15.0 - 1e-4) / 15.0);
            const double ang = (2.0 * 3.14159265358979323846 / (double)L) * (double)pos * band;
            ze[1 + lane] = cos(ang);
            ze[17 + lane] = -sin(ang);
        }
        __syncthreads();
        const double fr = (double)p->hy_freq[l * 64 + lane];
        {
            double a = (double)p->hy_b1[l * 64 + lane];
            for (int i = 0; i < 33; ++i) a += ze[i] * (double)p->hy_w1[(l * 33 + i) * 64 + lane];
            h1[lane] = sin(fr * a);
        }
        __syncthreads();
        {
            double a = (double)p->hy_b2[l * 64 + lane];
            for (int i = 0; i < 64; ++i) a += h1[i] * (double)p->hy_w2[(l * 64 + i) * 64 + lane];
            h2[lane] = sin(fr * a);
        }
        __syncthreads();
        if (act) {
            float* base = p->FILT + (size_t)l * FILT_L + (set ? (size_t)2 * 256 * 256 : 0);
            const double max_decay = log(1e-2) / 0.3, min_decay = log(1e-2) / 1.5;
            for (int n = lane; n < 512; n += 64) {
                double a = 0.0;
                for (int i = 0; i < 64; ++i) a += h2[i] * (double)p->hy_w3[(size_t)(l * 64 + i) * 512 + n];
                const int c = n & 255;
                const double delta = min_decay + (double)c * ((max_decay - min_decay) / 255.0);
                const double win = exp(-t * fabs(delta));
                if (n < 256) base[(size_t)(L + pos) * 256 + c] = (float)(a * win);
                else if (pos > 0) base[(size_t)(L - pos) * 256 + c] = (float)(a * win);
            }
        }
        __syncthreads();
    }
}

__device__ __forceinline__ void transpose_item(const float* W, int K, int N, bf16* WT, int dst_row, LAS float* scr, int k0, int n0, int lane) {
    const int nn = n0 + (lane & 31);
#pragma unroll 8
    for (int i = 0; i < 32; ++i) { const int kk = 2 * i + (lane >> 5); scr[kk * 33 + (lane & 31)] = (nn < N) ? W[(size_t)(k0 + kk) * N + nn] : 0.f; }
    asm volatile("s_waitcnt lgkmcnt(0)" ::: "memory");
    const int c = lane & 7;
#pragma unroll
    for (int j = 0; j < 4; ++j) { const int n = (lane >> 3) + 8 * j; const LAS float* s = scr + (8 * c) * 33 + n;
        u32x4 o; o.x = pk2(s[0 * 33], s[1 * 33]); o.y = pk2(s[2 * 33], s[3 * 33]); o.z = pk2(s[4 * 33], s[5 * 33]); o.w = pk2(s[6 * 33], s[7 * 33]);
        *(u32x4*)(WT + (size_t)(dst_row + n) * K + k0 + 8 * c) = o; }
    asm volatile("s_waitcnt lgkmcnt(0)" ::: "memory");
}
constexpr int WP_I_GU = 16 * 176, WP_I_DN = 44 * 32, WP_I_IN = 16 * 112, WP_I_OUT = 16 * 32, WP_I_Q = 4 * 12, WP_I_KV = 2 * 16;
constexpr int WP_I_L = 2 * WP_I_GU + 2 * WP_I_DN + WP_I_IN + WP_I_OUT + WP_I_Q + WP_I_KV;
__device__ __forceinline__ void wprep_range(KP p, LAS float* scr_all, int l, int first, int count, int wblock, int nwblocks) {
    const int tix = otid();
    const int lane = tix & 63, wv = tix >> 6;
    LAS float* scr = scr_all + wv * (64 * 33);
    for (int it = first + wblock * 8 + wv; it < first + count; it += nwblocks * 8) {
        int r = it;
        if (r < 2 * WP_I_GU) { const int f = r / WP_I_GU, rr = r % WP_I_GU, kb = rr / 176, nb = rr % 176, n0 = nb * 32;
            const int j = n0 < DFF ? n0 : n0 - DFF; const int dst = 256 * (j >> 7) + (n0 < DFF ? 0 : 128) + (j & 127);
            transpose_item(p->w_gu + (size_t)(l * 2 + f) * D * 2 * DFF, D, 2 * DFF, p->WGU + (size_t)(l * 2 + f) * 2 * DFF * D, dst, scr, kb * 64, n0, lane); continue; }
        r -= 2 * WP_I_GU;
        if (r < 2 * WP_I_DN) { const int f = r / WP_I_DN, rr = r % WP_I_DN, kb = rr / 32, nb = rr % 32;
            transpose_item(p->w_down + (size_t)(l * 2 + f) * DFF * D, DFF, D, p->WDN + (size_t)(l * 2 + f) * D * DFF, nb * 32, scr, kb * 64, nb * 32, lane); continue; }
        r -= 2 * WP_I_DN;
        if (r < WP_I_IN) { const int kb = r / 112, nb = r % 112;
            transpose_item(p->w_in + (size_t)l * D * INC, D, INC, p->WIN + (size_t)l * INCP * D, nb * 32, scr, kb * 64, nb * 32, lane); continue; }
        r -= WP_I_IN;
        if (r < WP_I_OUT) { const int kb = r / 32, nb = r % 32;
            transpose_item(p->w_out + (size_t)l * D * D, D, D, p->WOUT + (size_t)l * D * D, nb * 32, scr, kb * 64, nb * 32, lane); continue; }
        r -= WP_I_OUT;
        if (r < WP_I_Q) { const int kb = r / 12, nb = r % 12;
            transpose_item(p->w_q_up + (size_t)l * 256 * 384, 256, 384, p->WQT + (size_t)l * 384 * 256, nb * 32, scr, kb * 64, nb * 32, lane); continue; }
        r -= WP_I_Q;
        { const int kb = r / 16, nb = r % 16;
            transpose_item(p->w_kv_up + (size_t)l * 128 * 512, 128, 512, p->WKVT + (size_t)l * 512 * 128, nb * 32, scr, kb * 64, nb * 32, lane); }
    }
}
__device__ __forceinline__ void ph_wprep(KP p, LAS float* scr_all) {
    wprep_range(p, scr_all, 0, 0, WP_I_L, blockIdx.x, gridDim.x);
}
__device__ __forceinline__ void wprep_idle(KP p, LAS float* scr_all, int l_next, int third, int nunits) {
    if (l_next >= DEPTH) return;
    const int G = gridDim.x;
    const int first = (WP_I_L * third) / 3, count = (WP_I_L * (third + 1)) / 3 - first;
    if (G > nunits) { if ((int)blockIdx.x >= nunits) wprep_range(p, scr_all, l_next, first, count, blockIdx.x - nunits, G - nunits); }
    else { __syncthreads(); wprep_range(p, scr_all, l_next, first, count, blockIdx.x, G); }
}

__device__ __forceinline__ void ph_norm(KP p, int l, int s) {
    const int tix = otid();
    const int lane = tix & 63, wv = tix >> 6;
    const float* g = (s == 1) ? p->norm_mix + l * D : p->norm_ffn + (size_t)(l * 2 + (s == 2 ? 1 : 0)) * D;
    for (int r = blockIdx.x * 8 + wv; r < M; r += gridDim.x * 8) {
        int ci, T, row0, t, b; row_info(r, ci, T, row0, t, b);
        const float* ada = p->ADA + (size_t)(l * 3 + ci) * NADA * D;
        const float* shift = ada + (3 * s + 0) * D;
        const float* scale = ada + (3 * s + 1) * D;
        const float4* xr = (const float4*)(p->X + (size_t)r * D);
        float4 v[4]; float ss = 0.f;
#pragma unroll
        for (int j = 0; j < 4; ++j) { v[j] = xr[lane + 64 * j]; ss += v[j].x * v[j].x + v[j].y * v[j].y + v[j].z * v[j].z + v[j].w * v[j].w; }
        ss = wave_sum(ss, lane);
        const float rstd = 1.0f / sqrtf(ss * (1.0f / D) + RMS_EPS);
        u32x2* hr = (u32x2*)(p->H + (size_t)r * D);
#pragma unroll
        for (int j = 0; j < 4; ++j) {
            const int c4 = lane + 64 * j;
            const float4 gg = ((const float4*)g)[c4], sh = ((const float4*)shift)[c4], scl = ((const float4*)scale)[c4];
            const float ox = v[j].x * rstd * gg.x * (1.f + scl.x) + sh.x;
            const float oy = v[j].y * rstd * gg.y * (1.f + scl.y) + sh.y;
            const float oz = v[j].z * rstd * gg.z * (1.f + scl.z) + sh.z;
            const float ow = v[j].w * rstd * gg.w * (1.f + scl.w) + sh.w;
            u32x2 o; o.x = pk2(ox, oy); o.y = pk2(oz, ow);
            hr[c4] = o;
        }
    }
}

__device__ __forceinline__ float red16(float v, int lane) {
#pragma unroll
    for (int o = 1; o < 16; o <<= 1) v += __builtin_bit_cast(float, __builtin_amdgcn_ds_bpermute((lane ^ o) << 2, __builtin_bit_cast(int, v)));
    return v;
}
__device__ __forceinline__ float red_g(float v, int lane) {
    v += __builtin_bit_cast(float, __builtin_amdgcn_ds_bpermute((lane ^ 16) << 2, __builtin_bit_cast(int, v)));
    v += __builtin_bit_cast(float, __builtin_amdgcn_ds_bpermute((lane ^ 32) << 2, __builtin_bit_cast(int, v)));
    return v;
}
__device__ __forceinline__ bf16x8 pack8(const float (&v)[8]) {
    u32x4 w; w.x = pg8::cvt_pk_bf16(v[0], v[1]); w.y = pg8::cvt_pk_bf16(v[2], v[3]); w.z = pg8::cvt_pk_bf16(v[4], v[5]); w.w = pg8::cvt_pk_bf16(v[6], v[7]);
    return __builtin_bit_cast(bf16x8, w);
}
__device__ __forceinline__ void mla_wave(KP p, int l, int group, int part, int lane) {
    asm volatile("" : "+v"(lane));
    const int tq = lane & 15, g = lane >> 4;
    const bool isctx = group >= 384;
    int tok0 = 0, b = 0, t0 = 0;
    bool sample = false;
    if (!isctx) { tok0 = group * 16; sample = tok0 >= M_P; if (sample) { b = (tok0 - M_P) >> 10; t0 = (tok0 - M_P) & 1023; } else { b = tok0 >> 8; t0 = tok0 & 255; } }
    else { const int j = group - 384; b = j >> 4; t0 = (j & 15) * 16; }
    const float qscale = 0.10206207261596577f;
    const bool rope = sample && !isctx;
    float cs[4], sn[4];
#pragma unroll
    for (int i = 0; i < 4; ++i) { const int t = rope ? t0 + 4 * g + i : 0; cs[i] = p->ROPE[t * 16 + tq]; sn[i] = p->ROPE[1024 * 16 + t * 16 + tq]; }
    if (part < 4) {
        const int h = part;
        const float* u = p->U + (size_t)(tok0 + tq) * INCP + MLA_OFF;
        bf16x8 aq[8];
        {
            float x[8][8]; float ss = 0.f;
#pragma unroll
            for (int s = 0; s < 8; ++s) { const f32x4 a = *(const f32x4*)(u + 32 * s + 8 * g), c = *(const f32x4*)(u + 32 * s + 8 * g + 4);
#pragma unroll
                for (int j = 0; j < 4; ++j) { x[s][j] = a[j]; x[s][4 + j] = c[j]; ss += a[j] * a[j] + c[j] * c[j]; } }
            ss = red_g(ss, lane);
            const float rstd = 1.0f / sqrtf(ss * (1.0f / 256.f) + RMS_EPS);
#pragma unroll
            for (int s = 0; s < 8; ++s) { const float* gn = p->q_norm_a + l * 256 + 32 * s + 8 * g; float v[8];
#pragma unroll
                for (int j = 0; j < 8; ++j) v[j] = x[s][j] * rstd * gn[j];
                aq[s] = pack8(v); }
        }
        const float* qn0 = p->qk_norm + (size_t)(l * 2 + 0) * 96;
        const bf16* Wq = p->WQT + (size_t)l * 384 * 256;
        f32x4 c[6];
#pragma unroll
        for (int tile = 0; tile < 6; ++tile) { c[tile] = (f32x4){0.f, 0.f, 0.f, 0.f};
            const bf16* wr = Wq + (size_t)(h * 96 + 16 * tile + tq) * 256 + 8 * g;
#pragma unroll
            for (int s = 0; s < 8; ++s) c[tile] = __builtin_amdgcn_mfma_f32_16x16x32_bf16(aq[s], *(const bf16x8*)(wr + 32 * s), c[tile], 0, 0, 0); }
#pragma unroll
        for (int i = 0; i < 4; ++i) {
            float ss = 0.f;
#pragma unroll
            for (int tile = 0; tile < 6; ++tile) ss += c[tile][i] * c[tile][i];
            ss = red16(ss, lane);
            const float rstd = 1.0f / sqrtf(ss * (1.0f / 96.f) + RMS_EPS);
            float v[6];
#pragma unroll
            for (int tile = 0; tile < 6; ++tile) v[tile] = c[tile][i] * rstd * qn0[16 * tile + tq];
            if (rope) { const float x1 = v[4], x2 = v[5]; v[4] = x1 * cs[i] - x2 * sn[i]; v[5] = x2 * cs[i] + x1 * sn[i]; }
            bf16* qo = p->QB + (size_t)(tok0 + 4 * g + i) * 384 + h * 96 + tq;
#pragma unroll
            for (int tile = 0; tile < 6; ++tile) qo[16 * tile] = (bf16)f2bf(v[tile] * qscale);
        }
    } else {
        const int h = part - 4;
        bf16x8 akv[4];
        if (!isctx) {
            const float* u = p->U + (size_t)(tok0 + tq) * INCP + MLA_OFF;
            float x[4][8]; float ss = 0.f;
#pragma unroll
            for (int s = 0; s < 4; ++s) { const f32x4 a = *(const f32x4*)(u + 256 + 32 * s + 8 * g), c = *(const f32x4*)(u + 256 + 32 * s + 8 * g + 4);
#pragma unroll
                for (int j = 0; j < 4; ++j) { x[s][j] = a[j]; x[s][4 + j] = c[j]; ss += a[j] * a[j] + c[j] * c[j]; } }
            ss = red_g(ss, lane);
            const float rstd = 1.0f / sqrtf(ss * (1.0f / 128.f) + RMS_EPS);
            float* oc = p->o_ckv + ((size_t)(b * DEPTH + l) * T_P + t0 + tq) * 128;
#pragma unroll
            for (int s = 0; s < 4; ++s) { const float* gn = p->kv_norm_a + l * 128 + 32 * s + 8 * g; float v[8];
#pragma unroll
                for (int j = 0; j < 8; ++j) v[j] = x[s][j] * rstd * gn[j];
                akv[s] = pack8(v);
                if (!sample && h == 0) { *(f32x4*)(oc + 32 * s + 8 * g) = (f32x4){v[0], v[1], v[2], v[3]}; *(f32x4*)(oc + 32 * s + 8 * g + 4) = (f32x4){v[4], v[5], v[6], v[7]}; } }
        } else {
            const float* cp = p->cache_ckv + ((size_t)(b * DEPTH + l) * PAST + t0 + tq) * 128;
#pragma unroll
            for (int s = 0; s < 4; ++s) { const f32x4 a = *(const f32x4*)(cp + 32 * s + 8 * g), c = *(const f32x4*)(cp + 32 * s + 8 * g + 4);
                const float v[8] = {a[0], a[1], a[2], a[3], c[0], c[1], c[2], c[3]}; akv[s] = pack8(v); }
        }
        float kr[2][4];
#pragma unroll
        for (int i = 0; i < 4; ++i)
#pragma unroll
            for (int tt = 0; tt < 2; ++tt) {
                const int tk = 4 * g + i;
                kr[tt][i] = isctx ? p->cache_krope[((size_t)(b * DEPTH + l) * PAST + t0 + tk) * 32 + 16 * tt + tq]
                                  : p->U[(size_t)(tok0 + tk) * INCP + MLA_OFF + 384 + 16 * tt + tq];
                if (!isctx && !sample && h == 0) p->o_krope[((size_t)(b * DEPTH + l) * T_P + t0 + tk) * 32 + 16 * tt + tq] = kr[tt][i];
            }
        const float* qn1 = p->qk_norm + (size_t)(l * 2 + 1) * 96;
        const bf16* Wkv = p->WKVT + (size_t)l * 512 * 128;
        const bool smp = isctx || sample;
        const int nk = smp ? NKS : T_P, key0 = (isctx ? T_S + t0 : t0) + 4 * g;
        bf16* Kbase = smp ? p->KBS + (size_t)(b * 4) * NKS * 96 : p->KBP + (size_t)(b * 4) * T_P * 96;
        bf16* Vbase = smp ? p->VTS + (size_t)(b * 4) * 64 * NKS : p->VTP + (size_t)(b * 4) * 64 * T_P;
        f32x4 c[8];
#pragma unroll
        for (int tile = 0; tile < 8; ++tile) { c[tile] = (f32x4){0.f, 0.f, 0.f, 0.f};
            const bf16* wr = Wkv + (size_t)(h * 128 + 16 * tile + tq) * 128 + 8 * g;
#pragma unroll
            for (int s = 0; s < 4; ++s) c[tile] = __builtin_amdgcn_mfma_f32_16x16x32_bf16(akv[s], *(const bf16x8*)(wr + 32 * s), c[tile], 0, 0, 0); }
#pragma unroll
        for (int i = 0; i < 4; ++i) {
            float ss = kr[0][i] * kr[0][i] + kr[1][i] * kr[1][i];
#pragma unroll
            for (int tile = 0; tile < 4; ++tile) ss += c[tile][i] * c[tile][i];
            ss = red16(ss, lane);
            const float rstd = 1.0f / sqrtf(ss * (1.0f / 96.f) + RMS_EPS);
            float v[6];
#pragma unroll
            for (int tile = 0; tile < 4; ++tile) v[tile] = c[tile][i] * rstd * qn1[16 * tile + tq];
            v[4] = kr[0][i] * rstd * qn1[64 + tq]; v[5] = kr[1][i] * rstd * qn1[80 + tq];
            if (rope) { const float x1 = v[4], x2 = v[5]; v[4] = x1 * cs[i] - x2 * sn[i]; v[5] = x2 * cs[i] + x1 * sn[i]; }
            bf16* ko = Kbase + ((size_t)h * nk + key0 + i) * 96 + tq;
#pragma unroll
            for (int tile = 0; tile < 6; ++tile) ko[16 * tile] = (bf16)f2bf(v[tile]);
        }
#pragma unroll
        for (int tile = 4; tile < 8; ++tile) {
            u32x2 w; w.x = pk2(c[tile][0], c[tile][1]); w.y = pk2(c[tile][2], c[tile][3]);
            *(u32x2*)(Vbase + ((size_t)h * 64 + 16 * (tile - 4) + tq) * nk + key0) = w;
        }
    }
}

__device__ __forceinline__ void tok_wave(KP p, int l, int run, int kind, int cg, int lane) {
    asm volatile("" : "+v"(lane));
    const int r0 = run * 16;
    int ci, T, row0, t0, b; row_info(r0, ci, T, row0, t0, b);
    const bool first = (t0 == 0), last = (t0 + 16 == T);
    if (kind == 0) {
        const float* u = p->U + (size_t)r0 * INCP + GD_OFF + cg * 64 + lane;
        const float* cw = p->gdn_conv_w + (size_t)l * 3 * 768 + cg * 64 + lane;
        float uq[18], uk[18];
#pragma unroll
        for (int i = 0; i < 18; ++i) { const bool ok = !((i == 0 && first) || (i == 17 && last));
            uq[i] = ok ? u[(ptrdiff_t)(i - 1) * INCP] : 0.f; uk[i] = ok ? u[(ptrdiff_t)(i - 1) * INCP + 256] : 0.f; }
        const float q0 = cw[0], q1 = cw[768], q2 = cw[1536], k0 = cw[256], k1 = cw[768 + 256], k2 = cw[1536 + 256];
#pragma unroll
        for (int i = 0; i < 16; ++i) {
            const float vq = siluf_(q0 * uq[i] + q1 * uq[i + 1] + q2 * uq[i + 2]);
            const float vk = siluf_(k0 * uk[i] + k1 * uk[i + 1] + k2 * uk[i + 2]);
            const float sq = wave_sum(vq * vq, lane), sk = wave_sum(vk * vk, lane);
            p->GQ[(size_t)(r0 + i) * 256 + cg * 64 + lane] = vq * (1.0f / sqrtf(sq + 1e-6f)) * 0.125f;
            const float qn_ = vq * (1.0f / sqrtf(sq + 1e-6f)) * 0.125f, kn_ = vk * (1.0f / sqrtf(sk + 1e-6f));
            p->GK[(size_t)(r0 + i) * 256 + cg * 64 + lane] = kn_;
            p->GQB[(size_t)(r0 + i) * 256 + cg * 64 + lane] = (bf16)f2bf(qn_);
            p->GKB[(size_t)(r0 + i) * 256 + cg * 64 + lane] = (bf16)f2bf(kn_);
        }
    } else if (kind == 1) {
        const float* u = p->U + (size_t)r0 * INCP + GD_OFF + 512 + cg * 64 + lane;
        const float* cw = p->gdn_conv_w + (size_t)l * 3 * 768 + 512 + cg * 64 + lane;
        float uv[18];
#pragma unroll
        for (int i = 0; i < 18; ++i) { const bool ok = !((i == 0 && first) || (i == 17 && last)); uv[i] = ok ? u[(ptrdiff_t)(i - 1) * INCP] : 0.f; }
        const float w0 = cw[0], w1 = cw[768], w2 = cw[1536];
#pragma unroll
        for (int i = 0; i < 16; ++i) p->GV[(size_t)(r0 + i) * 256 + cg * 64 + lane] = siluf_(w0 * uv[i] + w1 * uv[i + 1] + w2 * uv[i + 2]);
        if (cg == 0 && lane < 8) {
            const float dtb = p->gdn_dt_bias[l * 8 + lane], na = -expf(p->gdn_a_log[l * 8 + lane]);
#pragma unroll
            for (int i = 0; i < 16; ++i) {
                const float* ua = p->U + (size_t)(r0 + i) * INCP + GD_OFF + 1024 + lane;
                const float x = ua[0] + dtb, bb = ua[8];
                const float sp = (x > 20.f) ? x : log1pf(expf(x));
                p->GA[(size_t)(r0 + i) * 8 + lane] = expf(na * sp);
                p->GLA[(size_t)(r0 + i) * 8 + lane] = na * sp;
                p->GBT[(size_t)(r0 + i) * 8 + lane] = sigmoidf_(bb);
            }
        }
    } else if (kind == 2) {
        const int c = cg * 64 + lane;
        const float* u = p->U + (size_t)r0 * INCP + HY_OFF + c;
        const float* cw = p->hy_conv_w + (size_t)l * 3 * 768 + c;
        const float* cb = p->hy_conv_b + (size_t)l * 768 + c;
        float u0[18], u1[18], u2[18];
#pragma unroll
        for (int i = 0; i < 18; ++i) { const bool ok = !((i == 0 && first) || (i == 17 && last));
            u0[i] = ok ? u[(ptrdiff_t)(i - 1) * INCP] : 0.f; u1[i] = ok ? u[(ptrdiff_t)(i - 1) * INCP + 256] : 0.f; u2[i] = ok ? u[(ptrdiff_t)(i - 1) * INCP + 512] : 0.f; }
        const float a0 = cw[0], a1 = cw[768], a2 = cw[1536], b0 = cw[256], b1 = cw[768 + 256], b2 = cw[1536 + 256], c0 = cw[512], c1 = cw[768 + 512], c2 = cw[1536 + 512];
        const float ba = cb[0], bb = cb[256], bc = cb[512];
#pragma unroll
        for (int i = 0; i < 16; ++i) {
            const float x0 = a0 * u0[i] + a1 * u0[i + 1] + a2 * u0[i + 2] + ba;
            const float x1 = b0 * u1[i] + b1 * u1[i + 1] + b2 * u1[i + 2] + bb;
            const float vv = c0 * u2[i] + c1 * u2[i + 1] + c2 * u2[i + 2] + bc;
            p->X0[(size_t)(r0 + i) * 256 + c] = x0;
            p->Z[(size_t)(r0 + i) * 256 + c] = x1 * vv;
        }
    } else {
        const int c = cg * 64 + lane;
        const float* u = p->U + (size_t)r0 * INCP + HG_OFF + c;
        const float lb0 = p->LB[(l * 2 + 0) * 256 + c], lb1 = p->LB[(l * 2 + 1) * 256 + c];
#pragma unroll
        for (int i = 0; i < 16; ++i) {
            const float q = u[(size_t)i * INCP], zf = u[(size_t)i * INCP + 768], zb = u[(size_t)i * INCP + 1024];
            p->HQ[(size_t)(r0 + i) * 256 + c] = q * 0.125f;
            p->HF[(size_t)(r0 + i) * 256 + c] = lb0 + (1.f - lb0) * sigmoidf_(zf);
            p->HF[((size_t)M + r0 + i) * 256 + c] = lb1 + (1.f - lb1) * sigmoidf_(zb);
        }
    }
}
__device__ __forceinline__ void ph_prep(KP p, int l) {
    const int tix = otid();
    const int lane = tix & 63, wv = tix >> 6;
    const int gw = wv * gridDim.x + blockIdx.x, NW = gridDim.x * 8;
    for (int it = gw; it < 3200 + 6144; it += NW) {
        if (it < 3072) mla_wave(p, l, it >> 3, it & 7, lane);
        else if (it < 3200) { const int j = it - 3072; mla_wave(p, l, 384 + (j >> 2), 4 + (j & 3), lane); }
        else { const int j = it - 3200; tok_wave(p, l, j >> 4, (j >> 2) & 3, j & 3, lane); }
    }
}

constexpr int NCS = 96, NITEM = NCS * 8;
constexpr int HCH = 32, NHCS = 192, NHITEM = NHCS * 8;
struct ChunkInfo { int seq, c, nch, T, row0; bool prompt; };
__device__ __forceinline__ ChunkInfo chunk_info(int cs) {
    ChunkInfo ci;
    if (cs < 64) { ci.seq = cs >> 2; ci.c = cs & 3; ci.nch = 4; ci.T = T_P; ci.row0 = ci.seq * T_P; ci.prompt = true; }
    else { const int j = cs - 64; ci.seq = 16 + (j >> 4); ci.c = j & 15; ci.nch = 16; ci.T = T_S; ci.row0 = M_P + (j >> 4) * T_S; ci.prompt = false; }
    return ci;
}
__device__ __forceinline__ int first_cs(int seq) { return seq < 16 ? seq * 4 : 64 + (seq - 16) * 16; }
__device__ __forceinline__ ChunkInfo hchunk_info(int cs) {
    ChunkInfo ci;
    if (cs < 128) { ci.seq = cs >> 3; ci.c = cs & 7; ci.nch = 8; ci.T = T_P; ci.row0 = ci.seq * T_P; ci.prompt = true; }
    else { const int j = cs - 128; ci.seq = 16 + (j >> 5); ci.c = j & 31; ci.nch = 32; ci.T = T_S; ci.row0 = M_P + (j >> 5) * T_S; ci.prompt = false; }
    return ci;
}
__device__ __forceinline__ int first_hcs(int seq) { return seq < 16 ? seq * 8 : 128 + (seq - 16) * 32; }

__device__ __forceinline__ void hgrn_passA(KP p, int item, int lane) {
    asm volatile("" : "+v"(lane));
    const int cs = item >> 3, dir = (item >> 2) & 1, h = item & 3;
    const ChunkInfo ci = hchunk_info(cs);
    float S[64];
#pragma unroll
    for (int v = 0; v < 64; ++v) S[v] = 0.f;
    float suf = 1.f;
    for (int s = HCH - 1; s >= 0; --s) {
        const int g = ci.c * HCH + s, t = dir ? ci.T - 1 - g : g;
        const size_t r = (size_t)(ci.row0 + t);
        const float f = p->HF[((size_t)dir * M + r) * 256 + h * 64 + lane];
        const float vv = p->U[r * INCP + HG_OFF + 256 + h * 64 + lane];
        const float w = (1.f - f) * suf;
#pragma unroll
        for (int v = 0; v < 64; ++v) S[v] += w * bcast(vv, v);
        suf *= f;
    }
    p->HD[(size_t)item * 64 + lane] = suf;
    f32x4* so = (f32x4*)(p->HS + (size_t)item * 4096 + lane * 64);
#pragma unroll
    for (int v = 0; v < 16; ++v) so[v] = (f32x4){S[4 * v], S[4 * v + 1], S[4 * v + 2], S[4 * v + 3]};
}
__device__ __forceinline__ void gdn_passA(KP p, int item, int half, int lane) {
    const int cs = item >> 3, dir = (item >> 2) & 1, h = item & 3;
    const ChunkInfo ci = chunk_info(cs);
    float S[64];
#pragma unroll
    for (int k = 0; k < 64; ++k) S[k] = (half && k == lane) ? 1.f : 0.f;
    for (int s = 0; s < 64; ++s) {
        const int g = ci.c * 64 + s, t = dir ? ci.T - 1 - g : g;
        const size_t r = (size_t)(ci.row0 + t);
        const float kv = p->GK[r * 256 + h * 64 + lane];
        const float vi = half ? 0.f : p->GV[r * 256 + h * 64 + lane];
        const float a = p->GA[r * 8 + dir * 4 + h], beta = p->GBT[r * 8 + dir * 4 + h];
        float kS = 0.f;
#pragma unroll
        for (int k = 0; k < 64; ++k) kS += bcast(kv, k) * S[k];
        const float cc = beta * (vi - a * kS);
#pragma unroll
        for (int k = 0; k < 64; ++k) S[k] = a * S[k] + bcast(kv, k) * cc;
    }
    float* so = (half ? p->GP : p->GS) + (size_t)item * 4096 + lane;
#pragma unroll
    for (int k = 0; k < 64; ++k) so[k * 64] = S[k];
}
template <int K0, int N, class F> __device__ __forceinline__ void sfor(F&& f) { if constexpr (K0 < N) { f(std::integral_constant<int, K0>{}); sfor<K0 + 1, N>(f); } }
__device__ __forceinline__ float perm_f(float v, int srclane) { return __builtin_bit_cast(float, __builtin_amdgcn_ds_bpermute(srclane << 2, __builtin_bit_cast(int, v))); }
__device__ __forceinline__ float rdl(float v, int k) { return __builtin_bit_cast(float, __builtin_amdgcn_readlane(__builtin_bit_cast(int, v), k)); }
__device__ __forceinline__ int gdn_row(const ChunkInfo& ci, int dir, int i) { const int g = ci.c * 64 + i; return ci.row0 + (dir ? ci.T - 1 - g : g); }

__device__ __forceinline__ void gdnL_wave(KP p, int item, int lane, LAS float* lm  ) {
    asm volatile("" : "+v"(lane));
    const int cs = item >> 3, dir = (item >> 2) & 1, h = item & 3;
    const ChunkInfo ci = chunk_info(cs);
    const int tq = lane & 15, g = lane >> 4;
    const int rl = gdn_row(ci, dir, lane);
    float G = p->GLA[(size_t)rl * 8 + dir * 4 + h];
    const float beta = p->GBT[(size_t)rl * 8 + dir * 4 + h];
#pragma unroll
    for (int o = 1; o < 64; o <<= 1) { const float t = perm_f(G, lane >= o ? lane - o : lane); if (lane >= o) G += t; }
    const float Glast = rdl(G, 63);
    const float eG = __expf(G);
    {
        bf16x8 kf[4][2], qf[4][2];
#pragma unroll
        for (int tt = 0; tt < 4; ++tt) { const size_t r = (size_t)gdn_row(ci, dir, 16 * tt + tq);
#pragma unroll
            for (int s = 0; s < 2; ++s) { kf[tt][s] = *(const bf16x8*)(p->GKB + r * 256 + h * 64 + 32 * s + 8 * g); qf[tt][s] = *(const bf16x8*)(p->GQB + r * 256 + h * 64 + 32 * s + 8 * g); } }
        bf16* att = p->ATT + (size_t)item * 4096;
#pragma unroll
        for (int rt = 0; rt < 4; ++rt)
#pragma unroll
            for (int ct = 0; ct <= rt; ++ct) {
                f32x4 kk = (f32x4){0.f, 0.f, 0.f, 0.f}, qk = (f32x4){0.f, 0.f, 0.f, 0.f};
#pragma unroll
                for (int s = 0; s < 2; ++s) { kk = __builtin_amdgcn_mfma_f32_16x16x32_bf16(kf[rt][s], kf[ct][s], kk, 0, 0, 0); qk = __builtin_amdgcn_mfma_f32_16x16x32_bf16(qf[rt][s], kf[ct][s], qk, 0, 0, 0); }
                const int j = 16 * ct + tq; const float Gj = perm_f(G, j);
#pragma unroll
                for (int r = 0; r < 4; ++r) { const int i = 16 * rt + 4 * g + r;
                    const float Gi = perm_f(G, i), bi = perm_f(beta, i);
                    const float dec = (j <= i) ? __expf(Gi - Gj) : 0.f;
                    lm[i * 64 + j] = (j < i) ? bi * kk[r] * dec : 0.f;
                    att[i * 64 + j] = (bf16)f2bf(qk[r] * dec); }
            }
    }
    asm volatile("s_waitcnt lgkmcnt(0)" ::: "memory");
#pragma unroll 1
    for (int which = 0; which < 2; ++which) {
        float X[64];
        const float* src = (which ? p->GK : p->GV) + h * 64 + lane;
        const float sc = which ? eG : 1.0f;
        const float bsc = beta * sc;
        sfor<0, 64>([&](auto ic) { constexpr int I = decltype(ic)::value; X[I] = rdl(bsc, I) * src[(size_t)gdn_row(ci, dir, I) * 256]; });
        sfor<1, 64>([&](auto ic) { constexpr int I = decltype(ic)::value;
            float a = X[I];
            sfor<0, (I + 3) / 4>([&](auto mc) { constexpr int M4 = decltype(mc)::value;
                const f32x4 l4 = *(const LAS f32x4*)(lm + I * 64 + 4 * M4);
                if constexpr (4 * M4 + 0 < I) a -= l4[0] * X[4 * M4 + 0];
                if constexpr (4 * M4 + 1 < I) a -= l4[1] * X[4 * M4 + 1];
                if constexpr (4 * M4 + 2 < I) a -= l4[2] * X[4 * M4 + 2];
                if constexpr (4 * M4 + 3 < I) a -= l4[3] * X[4 * M4 + 3]; });
            X[I] = a; });
        if (which == 0) { float* ub = p->UB + (size_t)item * 4096 + lane;
            sfor<0, 64>([&](auto ic) { constexpr int I = decltype(ic)::value; ub[I * 64] = X[I]; }); }
        else { bf16* wn = p->WN + (size_t)item * 4096 + lane;
            sfor<0, 64>([&](auto ic) { constexpr int I = decltype(ic)::value; wn[I * 64] = (bf16)f2bf(-X[I]); }); }
    }
    {
        bf16* qg = p->QG + (size_t)item * 4096 + lane;
        LAS bf16* kt = (LAS bf16*)lm;
        const float eo = __expf(Glast - G);
#pragma unroll 1
        for (int ib = 0; ib < 64; ib += 16) {
            float gq[16], gk[16];
#pragma unroll
            for (int i = 0; i < 16; ++i) { const size_t r = (size_t)gdn_row(ci, dir, ib + i); gq[i] = p->GQ[r * 256 + h * 64 + lane]; gk[i] = p->GK[r * 256 + h * 64 + lane]; }
#pragma unroll
            for (int i = 0; i < 16; ++i) { qg[(ib + i) * 64] = (bf16)f2bf(gq[i] * rdl(eG, ib + i)); kt[lane * 64 + ib + i] = (bf16)f2bf(gk[i] * rdl(eo, ib + i)); }
        }
        asm volatile("s_waitcnt lgkmcnt(0)" ::: "memory");
        u32x4* ko = (u32x4*)(p->KOT + (size_t)item * 4096);
#pragma unroll
        for (int it = 0; it < 8; ++it) ko[it * 64 + lane] = ((const LAS u32x4*)lm)[it * 64 + lane];
        if (lane == 0) p->EGL[item] = __expf(Glast);
        asm volatile("s_waitcnt lgkmcnt(0)" ::: "memory");
    }
}

__device__ __forceinline__ bf16x8 frag2(const bf16* p0) {
    const bf16x4 a = *(const bf16x4*)p0, b = *(const bf16x4*)(p0 + 16);
    bf16x8 f; f[0] = a[0]; f[1] = a[1]; f[2] = a[2]; f[3] = a[3]; f[4] = b[0]; f[5] = b[1]; f[6] = b[2]; f[7] = b[3]; return f;
}
__device__ __forceinline__ bf16x8 packC(const f32x4& t0, const f32x4& t1) { const float v[8] = {t0[0], t0[1], t0[2], t0[3], t1[0], t1[1], t1[2], t1[3]}; return pack8(v); }

struct GdnS1 { bf16x8 w[8]; f32x4 u[4]; };
__device__ __forceinline__ bf16x8 frag2o(const bf16* base  , int off) {
    const bf16x4 a = *(const bf16x4*)(base + off), b = *(const bf16x4*)(base + off + 16);
    bf16x8 f; f[0] = a[0]; f[1] = a[1]; f[2] = a[2]; f[3] = a[3]; f[4] = b[0]; f[5] = b[1]; f[6] = b[2]; f[7] = b[3]; return f;
}
__device__ __forceinline__ void gdnS_load1(GdnS1& o, KP p, size_t item, int lo, int uo) {
    const bf16* Wn = p->WN + item * 4096;
    const float* Ub = p->UB + item * 4096;
#pragma unroll
    for (int jt = 0; jt < 4; ++jt) { o.w[2 * jt] = frag2o(Wn, lo + (16 * jt) * 64); o.w[2 * jt + 1] = frag2o(Wn, lo + (16 * jt) * 64 + 32);
#pragma unroll
        for (int r = 0; r < 4; ++r) o.u[jt][r] = Ub[uo + (16 * jt + r) * 64]; }
}
__device__ __forceinline__ void gdnS_wave(KP p, int l, int sdh, int ct, int lane) {
    asm volatile("" : "+v"(lane));
    const int tq = lane & 15, g = lane >> 4;
    const int lo = tq * 64 + 4 * g, uo = (4 * g) * 64 + 16 * ct + tq;
    const int seq = sdh >> 3, dir = (sdh >> 2) & 1, h = sdh & 3;
    const bool prompt = seq < 16; const int nch = prompt ? 4 : 16, cs0 = first_cs(seq);
    f32x4 s[4];
    {
        const float* s0 = p->state_gdn + ((size_t)(((prompt ? 0 : seq - 16) * DEPTH + l) * 2 + dir) * 4 + h) * 4096 + 16 * ct + tq;
#pragma unroll
        for (int rt = 0; rt < 4; ++rt)
#pragma unroll
            for (int r = 0; r < 4; ++r) s[rt][r] = prompt ? 0.f : s0[(16 * rt + 4 * g + r) * 64];
    }
    for (int c = 0; c < nch; ++c) {
        const int cs = cs0 + c; const size_t item = (size_t)(cs * 2 + dir) * 4 + h;
        const ChunkInfo ci = chunk_info(cs);
        GdnS1 cur;
        gdnS_load1(cur, p, item, lo, uo);
        const bf16* Qg = p->QG + item * 4096;
        const bf16* At = p->ATT + item * 4096;
        const bf16* Kt = p->KOT + item * 4096;
        bf16x8 qf[8], af[6], kf[8];
#pragma unroll
        for (int it = 0; it < 4; ++it) { qf[2 * it] = frag2o(Qg, lo + (16 * it) * 64); qf[2 * it + 1] = frag2o(Qg, lo + (16 * it) * 64 + 32); }
        af[0] = frag2o(At, lo + (16 * 0) * 64); af[1] = frag2o(At, lo + (16 * 1) * 64);
        af[2] = frag2o(At, lo + (16 * 2) * 64); af[3] = frag2o(At, lo + (16 * 2) * 64 + 32);
        af[4] = frag2o(At, lo + (16 * 3) * 64); af[5] = frag2o(At, lo + (16 * 3) * 64 + 32);
        const float egl = p->EGL[item];
        const bf16x8 bS0 = packC(s[0], s[1]), bS1 = packC(s[2], s[3]);
        f32x4 vn[4];
#pragma unroll
        for (int jt = 0; jt < 4; ++jt) {
            vn[jt] = __builtin_amdgcn_mfma_f32_16x16x32_bf16(cur.w[2 * jt], bS0, cur.u[jt], 0, 0, 0);
            vn[jt] = __builtin_amdgcn_mfma_f32_16x16x32_bf16(cur.w[2 * jt + 1], bS1, vn[jt], 0, 0, 0);
        }
#pragma unroll
        for (int it = 0; it < 4; ++it) { kf[2 * it] = frag2o(Kt, lo + (16 * it) * 64); kf[2 * it + 1] = frag2o(Kt, lo + (16 * it) * 64 + 32); }
        const bf16x8 bV0 = packC(vn[0], vn[1]), bV1 = packC(vn[2], vn[3]);
        af[0][4] = 0; af[0][5] = 0; af[0][6] = 0; af[0][7] = 0;
        af[3][4] = 0; af[3][5] = 0; af[3][6] = 0; af[3][7] = 0;
        f32x4 o[4];
#pragma unroll
        for (int it = 0; it < 4; ++it) {
            o[it] = __builtin_amdgcn_mfma_f32_16x16x32_bf16(qf[2 * it], bS0, (f32x4){0.f, 0.f, 0.f, 0.f}, 0, 0, 0);
            o[it] = __builtin_amdgcn_mfma_f32_16x16x32_bf16(qf[2 * it + 1], bS1, o[it], 0, 0, 0);
        }
        o[0] = __builtin_amdgcn_mfma_f32_16x16x32_bf16(af[0], bV0, o[0], 0, 0, 0);
        o[1] = __builtin_amdgcn_mfma_f32_16x16x32_bf16(af[1], bV0, o[1], 0, 0, 0);
        o[2] = __builtin_amdgcn_mfma_f32_16x16x32_bf16(af[2], bV0, o[2], 0, 0, 0);
        o[2] = __builtin_amdgcn_mfma_f32_16x16x32_bf16(af[3], bV1, o[2], 0, 0, 0);
        o[3] = __builtin_amdgcn_mfma_f32_16x16x32_bf16(af[4], bV0, o[3], 0, 0, 0);
        o[3] = __builtin_amdgcn_mfma_f32_16x16x32_bf16(af[5], bV1, o[3], 0, 0, 0);
        if (c + 1 < nch || prompt) {
#pragma unroll
            for (int dt = 0; dt < 4; ++dt) {
                f32x4 a = s[dt] * egl;
                a = __builtin_amdgcn_mfma_f32_16x16x32_bf16(kf[2 * dt], bV0, a, 0, 0, 0);
                a = __builtin_amdgcn_mfma_f32_16x16x32_bf16(kf[2 * dt + 1], bV1, a, 0, 0, 0);
                s[dt] = a;
            }
        }
#pragma unroll
        for (int it = 0; it < 4; ++it)
#pragma unroll
            for (int r = 0; r < 4; ++r) { const size_t row = (size_t)gdn_row(ci, dir, 16 * it + 4 * g + r);
                p->OG[((size_t)dir * M + row) * 256 + h * 64 + 16 * ct + tq] = o[it][r]; }
    }
    if (prompt) {
        float* so = p->o_sgd + ((size_t)((seq * DEPTH + l) * 2 + dir) * 4 + h) * 4096 + 16 * ct + tq;
#pragma unroll
        for (int rt = 0; rt < 4; ++rt)
#pragma unroll
            for (int r = 0; r < 4; ++r) so[(16 * rt + 4 * g + r) * 64] = s[rt][r];
    }
}

__device__ __forceinline__ void ph_scanA(KP p, LAS unsigned char* lds) {
    const int tix = otid();
    const int lane = tix & 63, wv = tix >> 6;
    LAS float* lm = (LAS float*)(lds + wv * 16384);
    const int gw = wv * gridDim.x + blockIdx.x;
    const int NW = gridDim.x * 8, NIT = NITEM + NHITEM;
#pragma unroll 1
    for (int rnd = 0, it = gw; it < NIT; ++rnd) {
        if (it < NITEM) gdnL_wave(p, it, lane, lm);
        else hgrn_passA(p, it - NITEM, lane);
        it = (rnd == 0) ? NW + (NW - 1 - gw) : it + NW;
    }
}

template <int NCH>
__device__ __forceinline__ float hgrn_passB_elem(KP p, int cs0, int dir, int h, int k, int kvx, float s) {
    float loc[NCH], dd[NCH];
#pragma unroll
    for (int c = 0; c < NCH; ++c) { const size_t item = (size_t)((cs0 + c) * 2 + dir) * 4 + h; loc[c] = p->HS[item * 4096 + kvx]; dd[c] = p->HD[item * 64 + k]; }
#pragma unroll
    for (int c = 0; c < NCH; ++c) { const size_t item = (size_t)((cs0 + c) * 2 + dir) * 4 + h; p->HS2[item * 4096 + kvx] = s; s = dd[c] * s + loc[c]; }
    return s;
}
__device__ __forceinline__ void hgrn_passB(KP p, int l, int gt, int gn) {
    for (int e = gt; e < 18 * 8 * 4096; e += gn) {
        const int sdh = e >> 12, kvx = e & 4095, k = kvx >> 6;
        const int seq = sdh >> 3, dir = (sdh >> 2) & 1, h = sdh & 3;
        if (seq < 16) {
            const float s = hgrn_passB_elem<8>(p, first_hcs(seq), dir, h, k, kvx, 0.f);
            p->o_shg[((size_t)((seq * DEPTH + l) * 2 + dir) * 4 + h) * 4096 + kvx] = s;
        } else {
            const float s0 = p->state_hgrn[((size_t)(((seq - 16) * DEPTH + l) * 2 + dir) * 4 + h) * 4096 + kvx];
            (void)hgrn_passB_elem<32>(p, first_hcs(seq), dir, h, k, kvx, s0);
        }
    }
}
__device__ __forceinline__ void split8(const float (&x)[8], bf16x8& hi, bf16x8& lo) {
    float h[8], r[8];
#pragma unroll
    for (int j = 0; j < 8; ++j) { h[j] = __builtin_bit_cast(float, f2bf(x[j]) << 16); r[j] = x[j] - h[j]; }
    hi = pack8(h); lo = pack8(r);
}
__device__ __forceinline__ void gdn_passB_wave(KP p, int l, int sdh, int ct, int lane) {
    const int tq = lane & 15, g = lane >> 4;
    const int seq = sdh >> 3, dir = (sdh >> 2) & 1, h = sdh & 3;
    const bool prompt = seq < 16; const int nch = prompt ? 4 : 16, cs0 = first_cs(seq);
    f32x4 s[4];
    {
        const float* s0 = p->state_gdn + ((size_t)(((prompt ? 0 : seq - 16) * DEPTH + l) * 2 + dir) * 4 + h) * 4096 + 16 * ct + tq;
#pragma unroll
        for (int rt = 0; rt < 4; ++rt)
#pragma unroll
            for (int r = 0; r < 4; ++r) s[rt][r] = prompt ? 0.f : s0[(16 * rt + 4 * g + r) * 64];
    }
    for (int c = 0; c < nch; ++c) {
        const size_t item = (size_t)((cs0 + c) * 2 + dir) * 4 + h;
        const float* Ls = p->GS + item * 4096 + 16 * ct + tq;
        float* Ss = p->GS2 + item * 4096 + 16 * ct + tq;
        const float* Pm = p->GP + item * 4096;
        const bool need = (c + 1 < nch) || prompt;
        f32x4 acc[4];
#pragma unroll
        for (int rt = 0; rt < 4; ++rt)
#pragma unroll
            for (int r = 0; r < 4; ++r) { const int row = 16 * rt + 4 * g + r; acc[rt][r] = Ls[row * 64]; Ss[row * 64] = s[rt][r]; }
        if (need) {
            bf16x8 bh[2], bl[2];
#pragma unroll
            for (int ks = 0; ks < 2; ++ks) { const float x[8] = {s[2 * ks][0], s[2 * ks][1], s[2 * ks][2], s[2 * ks][3], s[2 * ks + 1][0], s[2 * ks + 1][1], s[2 * ks + 1][2], s[2 * ks + 1][3]};
                split8(x, bh[ks], bl[ks]); }
#pragma unroll
            for (int rt = 0; rt < 4; ++rt)
#pragma unroll
                for (int ks = 0; ks < 2; ++ks) {
                    const float* pr = Pm + (16 * rt + tq) * 64 + 32 * ks + 4 * g;
                    const f32x4 a0 = *(const f32x4*)pr, a1 = *(const f32x4*)(pr + 16);
                    const float x[8] = {a0[0], a0[1], a0[2], a0[3], a1[0], a1[1], a1[2], a1[3]};
                    bf16x8 ah, al; split8(x, ah, al);
                    acc[rt] = __builtin_amdgcn_mfma_f32_16x16x32_bf16(ah, bh[ks], acc[rt], 0, 0, 0);
                    acc[rt] = __builtin_amdgcn_mfma_f32_16x16x32_bf16(ah, bl[ks], acc[rt], 0, 0, 0);
                    acc[rt] = __builtin_amdgcn_mfma_f32_16x16x32_bf16(al, bh[ks], acc[rt], 0, 0, 0);
                }
#pragma unroll
            for (int rt = 0; rt < 4; ++rt) s[rt] = acc[rt];
        }
    }
    if (prompt) {
        float* so = p->o_sgd + ((size_t)((seq * DEPTH + l) * 2 + dir) * 4 + h) * 4096 + 16 * ct + tq;
#pragma unroll
        for (int rt = 0; rt < 4; ++rt)
#pragma unroll
            for (int r = 0; r < 4; ++r) so[(16 * rt + 4 * g + r) * 64] = s[rt][r];
    }
}

__device__ __forceinline__ void hgrn_passC(KP p, int item, int lane) {
    asm volatile("" : "+v"(lane));
    const int cs = item >> 3, dir = (item >> 2) & 1, h = item & 3;
    const ChunkInfo ci = hchunk_info(cs);
    float S[64];
    {
        const float* s0 = p->HS2 + (size_t)item * 4096 + lane;
#pragma unroll
        for (int k = 0; k < 64; ++k) S[k] = s0[k * 64];
    }
    for (int s = 0; s < HCH; ++s) {
        const int g = ci.c * HCH + s, t = dir ? ci.T - 1 - g : g;
        const size_t r = (size_t)(ci.row0 + t);
        const float fv = p->HF[((size_t)dir * M + r) * 256 + h * 64 + lane];
        const float qv = p->HQ[r * 256 + h * 64 + lane];
        const float vi = p->U[r * INCP + HG_OFF + 256 + h * 64 + lane];
        float o = 0.f;
#pragma unroll
        for (int k = 0; k < 64; ++k) {
            const float fk = bcast(fv, k);
            S[k] = fk * (S[k] - vi) + vi;
            o += bcast(qv, k) * S[k];
        }
        p->OH[((size_t)dir * M + r) * 256 + h * 64 + lane] = o;
    }
}
__device__ __forceinline__ void gdn_passC(KP p, int item, int lane) {
    const int cs = item >> 3, dir = (item >> 2) & 1, h = item & 3;
    const ChunkInfo ci = chunk_info(cs);
    float S[64];
    {
        const float* s0 = p->GS2 + (size_t)item * 4096 + lane;
#pragma unroll
        for (int k = 0; k < 64; ++k) S[k] = s0[k * 64];
    }
    for (int s = 0; s < 64; ++s) {
        const int g = ci.c * 64 + s, t = dir ? ci.T - 1 - g : g;
        const size_t r = (size_t)(ci.row0 + t);
        const float qv = p->GQ[r * 256 + h * 64 + lane], kv = p->GK[r * 256 + h * 64 + lane], vi = p->GV[r * 256 + h * 64 + lane];
        const float a = p->GA[r * 8 + dir * 4 + h], beta = p->GBT[r * 8 + dir * 4 + h];
        float kS = 0.f;
#pragma unroll
        for (int k = 0; k < 64; ++k) kS += bcast(kv, k) * S[k];
        const float cc = beta * (vi - a * kS);
        float o = 0.f;
#pragma unroll
        for (int k = 0; k < 64; ++k) { S[k] = a * S[k] + bcast(kv, k) * cc; o += bcast(qv, k) * S[k]; }
        p->OG[((size_t)dir * M + r) * 256 + h * 64 + lane] = o;
    }
}
__device__ __forceinline__ void ph_scanC(KP p) {
    const int tix = otid();
    const int lane = tix & 63, wv = tix >> 6;
    for (int it = wv * gridDim.x + blockIdx.x; it < NHITEM; it += gridDim.x * 8) hgrn_passC(p, it, lane);
}

struct KVFrag { bf16x8 k[2][3]; bf16x4 v[4][2]; };
__device__ __forceinline__ void attn_load(KVFrag& f, const bf16* Kb, const bf16* Vt, int nk, int k0, int q, int g) {
#pragma unroll
    for (int tt = 0; tt < 2; ++tt)
#pragma unroll
        for (int s = 0; s < 3; ++s) f.k[tt][s] = *(const bf16x8*)(Kb + (size_t)(k0 + 16 * tt + q) * 96 + 32 * s + 8 * g);
#pragma unroll
    for (int vt = 0; vt < 4; ++vt)
#pragma unroll
        for (int tt = 0; tt < 2; ++tt) f.v[vt][tt] = *(const bf16x4*)(Vt + (size_t)(16 * vt + q) * nk + k0 + 16 * tt + 4 * g);
}
__device__ __forceinline__ void attn_wave(KP p, int item, int lane) {
    asm volatile("" : "+v"(lane));
    int seq, h, qb, nk, r0; const bf16 *Kb, *Vt;
    if (item < 1024) { seq = item >> 6; h = (item >> 4) & 3; qb = item & 15; nk = T_P; r0 = seq * T_P + qb * 16;
        Kb = p->KBP + (size_t)(seq * 4 + h) * T_P * 96; Vt = p->VTP + (size_t)(seq * 4 + h) * 64 * T_P; }
    else { const int j = item - 1024; seq = j >> 8; h = (j >> 6) & 3; qb = j & 63; nk = NKS; r0 = M_P + seq * T_S + qb * 16;
        Kb = p->KBS + (size_t)(seq * 4 + h) * NKS * 96; Vt = p->VTS + (size_t)(seq * 4 + h) * 64 * NKS; }
    const int q = lane & 15, g = lane >> 4;
    bf16x8 qf[3];
#pragma unroll
    for (int s = 0; s < 3; ++s) qf[s] = *(const bf16x8*)(p->QB + (size_t)(r0 + q) * 384 + h * 96 + 32 * s + 8 * g);
    f32x4 o[4];
#pragma unroll
    for (int vt = 0; vt < 4; ++vt) o[vt] = (f32x4){0.f, 0.f, 0.f, 0.f};
    float m = -1e30f, lsum = 0.f;
    const int nblk = nk >> 5;
    KVFrag cur, nxt;
    attn_load(cur, Kb, Vt, nk, 0, q, g);
    for (int kb = 0; kb < nblk; ++kb) {
        const int kn = (kb + 1 < nblk) ? kb + 1 : kb;
        attn_load(nxt, Kb, Vt, nk, kn * 32, q, g);
        f32x4 s0 = (f32x4){0.f, 0.f, 0.f, 0.f}, s1 = (f32x4){0.f, 0.f, 0.f, 0.f};
#pragma unroll
        for (int s = 0; s < 3; ++s) { s0 = __builtin_amdgcn_mfma_f32_16x16x32_bf16(cur.k[0][s], qf[s], s0, 0, 0, 0); s1 = __builtin_amdgcn_mfma_f32_16x16x32_bf16(cur.k[1][s], qf[s], s1, 0, 0, 0); }
        float ml = fmaxf(fmaxf(fmaxf(s0[0], s0[1]), fmaxf(s0[2], s0[3])), fmaxf(fmaxf(s1[0], s1[1]), fmaxf(s1[2], s1[3])));
        ml = fmaxf(ml, __builtin_bit_cast(float, __builtin_amdgcn_ds_bpermute((lane ^ 16) << 2, __builtin_bit_cast(int, ml))));
        ml = fmaxf(ml, __builtin_bit_cast(float, __builtin_amdgcn_ds_bpermute((lane ^ 32) << 2, __builtin_bit_cast(int, ml))));
        const float mn = fmaxf(m, ml);
        const float corr = __expf(m - mn);
        float pv[8];
#pragma unroll
        for (int i = 0; i < 4; ++i) { pv[i] = __expf(s0[i] - mn); pv[4 + i] = __expf(s1[i] - mn); }
        lsum = lsum * corr + ((pv[0] + pv[1]) + (pv[2] + pv[3])) + ((pv[4] + pv[5]) + (pv[6] + pv[7]));
        m = mn;
        u32x4 pw; pw.x = pg8::cvt_pk_bf16(pv[0], pv[1]); pw.y = pg8::cvt_pk_bf16(pv[2], pv[3]); pw.z = pg8::cvt_pk_bf16(pv[4], pv[5]); pw.w = pg8::cvt_pk_bf16(pv[6], pv[7]);
        const bf16x8 pf = __builtin_bit_cast(bf16x8, pw);
#pragma unroll
        for (int vt = 0; vt < 4; ++vt) {
            bf16x8 af;
            af[0] = cur.v[vt][0][0]; af[1] = cur.v[vt][0][1]; af[2] = cur.v[vt][0][2]; af[3] = cur.v[vt][0][3];
            af[4] = cur.v[vt][1][0]; af[5] = cur.v[vt][1][1]; af[6] = cur.v[vt][1][2]; af[7] = cur.v[vt][1][3];
            o[vt] = __builtin_amdgcn_mfma_f32_16x16x32_bf16(af, pf, o[vt] * corr, 0, 0, 0);
        }
        cur = nxt;
    }
    lsum += __builtin_bit_cast(float, __builtin_amdgcn_ds_bpermute((lane ^ 16) << 2, __builtin_bit_cast(int, lsum)));
    lsum += __builtin_bit_cast(float, __builtin_amdgcn_ds_bpermute((lane ^ 32) << 2, __builtin_bit_cast(int, lsum)));
    const float inv = 1.0f / lsum;
    bf16* orow = p->OCAT + (size_t)(r0 + q) * D + 512 + h * 64 + 4 * g;
#pragma unroll
    for (int vt = 0; vt < 4; ++vt) { u32x2 w; w.x = pk2(o[vt][0] * inv, o[vt][1] * inv); w.y = pk2(o[vt][2] * inv, o[vt][3] * inv); *(u32x2*)(orow + 16 * vt) = w; }
}

__device__ __forceinline__ void hyena_wave(KP p, int l, int item, int lane) {
    asm volatile("" : "+v"(lane));
    int seq, tb, cw, T, row0, set;
    if (item < 1024) { seq = item >> 6; tb = (item >> 2) & 15; cw = item & 3; T = T_P; row0 = seq * T_P; set = 0; }
    else { const int j = item - 1024; seq = j >> 8; tb = (j >> 2) & 63; cw = j & 3; T = T_S; row0 = M_P + seq * T_S; set = 1; }
    const int c = cw * 64 + lane, t0 = tb * 16;
    const float* G = p->FILT + (size_t)l * FILT_L + (set ? (size_t)2 * 256 * 256 : 0) + c;
    const float* Zp = p->Z + (size_t)row0 * 256 + c;
    float acc[16];
#pragma unroll
    for (int i = 0; i < 16; ++i) acc[i] = 0.f;
    float tap[31], z[16];
    {
        const float* gp = G + (size_t)(t0 - 15 + T) * 256;
#pragma unroll
        for (int i = 0; i < 31; ++i) tap[i] = gp[(size_t)i * 256];
#pragma unroll
        for (int j = 0; j < 16; ++j) z[j] = Zp[(size_t)j * 256];
    }
    for (int s0 = 0; s0 < T; s0 += 16) {
        const int sn = (s0 + 16 < T) ? s0 + 16 : s0;
        float tapn[31], zn[16];
        const float* gp = G + (size_t)(t0 - sn - 15 + T) * 256;
#pragma unroll
        for (int i = 0; i < 31; ++i) tapn[i] = gp[(size_t)i * 256];
#pragma unroll
        for (int j = 0; j < 16; ++j) zn[j] = Zp[(size_t)(sn + j) * 256];
#pragma unroll
        for (int i = 0; i < 16; ++i)
#pragma unroll
            for (int j = 0; j < 16; ++j) acc[i] += tap[i - j + 15] * z[j];
#pragma unroll
        for (int i = 0; i < 31; ++i) tap[i] = tapn[i];
#pragma unroll
        for (int j = 0; j < 16; ++j) z[j] = zn[j];
    }
    const float skip = p->hy_skip[l * 256 + c];
#pragma unroll
    for (int i = 0; i < 16; ++i) {
        const size_t r = (size_t)(row0 + t0 + i);
        const float zz = p->Z[r * 256 + c];
        p->OCAT[r * D + 256 + c] = (bf16)f2bf(p->X0[r * 256 + c] * (acc[i] + zz * skip));
    }
}

__device__ __forceinline__ void ph_mixB(KP p, int l) {
    const int tix = otid();
    const int lane = tix & 63, wv = tix >> 6;
    hgrn_passB(p, l, blockIdx.x * NTHREADS + tix, gridDim.x * NTHREADS);
    const int gw = wv * gridDim.x + blockIdx.x;
    for (int it = gw; it < 576 + 3072; it += gridDim.x * 8) {
        if (it < 64) gdnS_wave(p, l, 128 + (it >> 2), it & 3, lane);
        else if (it < 576) gdnS_wave(p, l, (it - 64) >> 2, it & 3, lane);
        else { const int j = it - 576;
            if (j < 512) attn_wave(p, 1024 + j, lane);
            else if (j < 1024) hyena_wave(p, l, 1024 + (j - 512), lane);
            else if (j < 2048) hyena_wave(p, l, j - 1024, lane);
            else attn_wave(p, j - 2048, lane); }
    }
}
__device__ __forceinline__ void ph_athy(KP p, int l) {
    const int tix = otid();
    const int lane = tix & 63, wv = tix >> 6;
    for (int j = wv * gridDim.x + blockIdx.x; j < 3072; j += gridDim.x * 8) {
        if (j < 512) attn_wave(p, 1024 + j, lane);
        else if (j < 1024) hyena_wave(p, l, 1024 + (j - 512), lane);
        else if (j < 2048) hyena_wave(p, l, j - 1024, lane);
        else attn_wave(p, j - 2048, lane);
    }
}

__device__ __forceinline__ void ph_headnorm(KP p, int l) {
    const int tix = otid();
    const int lane = tix & 63, wv = tix >> 6;
    for (int item = wv * gridDim.x + blockIdx.x; item < (M / 4) * 8; item += gridDim.x * 8) {
        const int r0 = (item >> 3) * 4, which = (item >> 2) & 1, h = item & 3;
        const int c = h * 64 + lane;
        const float* O = which ? p->OG : p->OH;
        const float gn = which ? p->gdn_norm[l * 64 + lane] : p->hgrn_norm[l * 256 + c];
        float o[4], gt[4];
#pragma unroll
        for (int i = 0; i < 4; ++i) {
            o[i] = O[(size_t)(r0 + i) * 256 + c] + O[((size_t)M + r0 + i) * 256 + c];
            gt[i] = which ? p->U[(size_t)(r0 + i) * INCP + GD_OFF + 768 + c] : p->U[(size_t)(r0 + i) * INCP + HG_OFF + 512 + c];
        }
#pragma unroll
        for (int i = 0; i < 4; ++i) {
            const float ss = wave_sum(o[i] * o[i], lane);
            const float rstd = 1.0f / sqrtf(ss * (1.0f / 64.f) + RMS_EPS);
            p->OCAT[(size_t)(r0 + i) * D + (which ? 768 : 0) + c] = (bf16)f2bf(o[i] * rstd * gn * siluf_(gt[i]));
        }
    }
}

#define XB_TMO      128
#define XB_XCNT(j)  (256  + 64 * (j))
#define XB_XSUB(j)  (1280 + 64 * (j))
#define XB_XGEN(j)  (2304 + 64 * (j))
#define XB_TOP      3328
#define XB_TOPGEN   3392
#define XCD_BAR_WORDS 3456
#define XB_SPIN_CAP (1u << 18)

__device__ __forceinline__ unsigned xb_ld(unsigned* p)              { return __hip_atomic_load(p, __ATOMIC_RELAXED, __HIP_MEMORY_SCOPE_AGENT); }
__device__ __forceinline__ unsigned xb_add(unsigned* p, unsigned v) { return __hip_atomic_fetch_add(p, v, __ATOMIC_RELAXED, __HIP_MEMORY_SCOPE_AGENT); }
__device__ __forceinline__ unsigned xb_xcc_id() { return (unsigned)__builtin_amdgcn_s_getreg((3 << 11) | 20) & 0xFu; }
#define XB_SPIN(cond, bar) do { unsigned _sp = 0; while (cond) { __builtin_amdgcn_s_sleep(1); \
    if ((++_sp & 255u) == 0u) { if (xb_ld(&(bar)[XB_TMO])) break; if (_sp > XB_SPIN_CAP) { atomicAdd(&(bar)[XB_TMO], 1u); break; } } } } while (0)

struct XcdBarrier {
    unsigned* bar; unsigned x;
    volatile LAS unsigned* st;
};

__device__ __forceinline__ XcdBarrier xcd_barrier_post(unsigned* bar, volatile LAS unsigned* st) {
    XcdBarrier b; b.bar = bar; b.x = xb_xcc_id(); b.st = st;
    if (threadIdx.x == 0) (void)xb_add(&bar[XB_XCNT(b.x)], 1u);
    return b;
}
__device__ __forceinline__ void xcd_barrier_complete(unsigned* bar, unsigned x, unsigned& nloc, unsigned& nx) {
    const unsigned G = gridDim.x * gridDim.y * gridDim.z;
    unsigned sum, cnt, mine, sp = 0u;
    for (;;) {
        sum = 0u; cnt = 0u; mine = 0u;
#pragma unroll
        for (unsigned j = 0; j < 16; ++j) { const unsigned c = xb_ld(&bar[XB_XCNT(j)]); sum += c; cnt += (c > 0u) ? 1u : 0u; mine = (j == x) ? c : mine; }
        if (sum == G) break;
        __builtin_amdgcn_s_sleep(1);
        if ((++sp & 255u) == 0u) { if (xb_ld(&bar[XB_TMO])) break; if (sp > XB_SPIN_CAP) { atomicAdd(&bar[XB_TMO], 1u); break; } }
    }
    nloc = mine > 0u ? mine : 1u; nx = cnt > 0u ? cnt : 1u;
}

__device__ __forceinline__ void xcd_barrier(const XcdBarrier& b) {
    asm volatile("s_waitcnt vmcnt(0)" ::: "memory");
    __syncthreads();
    if (threadIdx.x == 0) {
        unsigned* bar = b.bar;
        __builtin_amdgcn_s_waitcnt(0);
        unsigned nloc = b.st[0], nx = b.st[1];
        if (nloc == 0u) { xcd_barrier_complete(bar, b.x, nloc, nx); b.st[0] = nloc; b.st[1] = nx; }
        const unsigned old = xb_add(&bar[XB_XSUB(b.x)], 1u);
        const unsigned gen = old / nloc;
        if (old + 1u == (gen + 1u) * nloc) {
            __builtin_amdgcn_fence(__ATOMIC_RELEASE, "agent");
            asm volatile("s_waitcnt vmcnt(0)" ::: "memory");
            const unsigned og = xb_add(&bar[XB_TOP], 1u);
            const unsigned tg = og / nx;
            if (og + 1u == (tg + 1u) * nx) xb_add(&bar[XB_TOPGEN], 1u);
            else XB_SPIN(xb_ld(&bar[XB_TOPGEN]) == tg, bar);
            __builtin_amdgcn_fence(__ATOMIC_ACQUIRE, "agent");
            xb_add(&bar[XB_XGEN(b.x)], 1u);
            asm volatile("s_waitcnt vmcnt(0)" ::: "memory");
        } else {
            XB_SPIN(xb_ld(&bar[XB_XGEN(b.x)]) == gen, bar);
            __builtin_amdgcn_fence(__ATOMIC_ACQUIRE, "agent");
            asm volatile("s_waitcnt vmcnt(0)" ::: "memory");
        }
    }
    __syncthreads();
}

#ifndef REP_SETUP
#define REP_SETUP 1
#endif
#ifndef REP_NORM
#define REP_NORM 1
#endif
#ifndef REP_GU
#define REP_GU 1
#endif
#ifndef REP_GIN
#define REP_GIN 1
#endif
#ifndef REP_PREP
#define REP_PREP 1
#endif
#ifndef REP_SCANA
#define REP_SCANA 1
#endif
#ifndef REP_ATHY
#define REP_ATHY 1
#endif
#ifndef REP_SCANC
#define REP_SCANC 1
#endif
#ifndef REP_HN
#define REP_HN 1
#endif
#ifndef REP_MIXB
#define REP_MIXB 1
#endif
#ifndef REP_SYNC
#define REP_SYNC 1
#endif
#define REPEAT(n) for (int rep_ = 0; rep_ < (n); ++rep_)
__global__ void __launch_bounds__(NTHREADS, 2) fwd_megakernel(P p) {
    extern __shared__ __attribute__((aligned(16))) unsigned char lds_raw[];
    LAS unsigned char* lds = (LAS unsigned char*)lds_raw;
    const int G = gridDim.x;
    volatile LAS unsigned* MISC = (volatile LAS unsigned*)(lds + 131072);
    if (threadIdx.x < 64) MISC[threadIdx.x] = 0u;
    __syncthreads();
    (void)xcd_barrier_post(FRESH_P()->BAR, MISC + 8);
#define GRID_SYNC() REPEAT(REP_SYNC) do { XcdBarrier b_; b_.bar = FRESH_P()->BAR; b_.x = xb_xcc_id(); b_.st = (volatile LAS unsigned*)(lds + 131072) + 8; xcd_barrier(b_); } while (0)

    REPEAT(REP_SETUP) {
    ph_init(FRESH_P());
#ifndef NO_ADA
    ph_ada(FRESH_P(), (LAS float*)lds);
#endif
#ifndef NO_SMALL
    ph_small(FRESH_P());
#endif
#ifndef NO_FILT
    ph_filt(FRESH_P(), (LAS double*)lds);
#endif
#ifndef NO_WPREP
    ph_wprep(FRESH_P(), (LAS float*)lds);
#endif
    __syncthreads();
    }
    GRID_SYNC();

#pragma unroll 1
    for (int l = 0; l < DEPTH; ++l) {
#pragma unroll 1
        for (int f = 0; f < 2; ++f) {
            if (f == 1) {
                REPEAT(REP_NORM) ph_norm(FRESH_P(), l, 1);
                GRID_SYNC();
#ifndef NO_GIN
                REPEAT(REP_GIN) { KP q = FRESH_P(); pg8::Gemm g{q->H, q->WIN + (size_t)l * INCP * D, M, INCP, D}; pg8::StaticOrder S; S.init(M, INCP, G, (int)blockIdx.x);
                  EpiF32 E{q->U, INCP};
                  pg8::gemm_phase<EpiF32, pg8::StaticOrder, true, true>(lds, g, S, E); }
#endif
                GRID_SYNC();
                REPEAT(REP_PREP) ph_prep(FRESH_P(), l);
                GRID_SYNC();
                REPEAT(REP_SCANA) ph_scanA(FRESH_P(), lds);
                GRID_SYNC();
                REPEAT(REP_MIXB) ph_mixB(FRESH_P(), l);
                REPEAT(REP_ATHY - 1) ph_athy(FRESH_P(), l);
                GRID_SYNC();
                REPEAT(REP_SCANC) ph_scanC(FRESH_P());
                GRID_SYNC();
                REPEAT(REP_HN) ph_headnorm(FRESH_P(), l);
                GRID_SYNC();
#ifndef NO_GOUT
                { KP q = FRESH_P(); pg8::Gemm g{q->OCAT, q->WOUT + (size_t)l * D * D, M, D, D}; pg8::StaticOrder S; S.init(M, D, G, (int)blockIdx.x);
                  EpiResid E{q->X, q->ADA + (size_t)(l * 3) * NADA * D + 5 * D, 1.0f};
                  pg8::gemm_phase<EpiResid, pg8::StaticOrder, true, true>(lds, g, S, E);
                  wprep_idle(FRESH_P(), (LAS float*)lds, l + 1, 1, (M / 256) * (D / 256));
#ifdef REP_GOUT
                  __syncthreads(); EpiResid E0{q->X, q->ADA + (size_t)(l * 3) * NADA * D + 5 * D, 0.0f};
                  pg8::gemm_phase<EpiResid, pg8::StaticOrder, true, true>(lds, g, S, E0);
#endif
                }
#endif
                GRID_SYNC();
            }
            const int s = f == 0 ? 0 : 2;
            REPEAT(REP_NORM) ph_norm(FRESH_P(), l, s);
            GRID_SYNC();
#ifndef NO_GGU
            REPEAT(REP_GU) { KP q = FRESH_P(); pg8::Gemm g{q->H, q->WGU + (size_t)(l * 2 + f) * 2 * DFF * D, M, 2 * DFF, D}; pg8::StaticOrder S; S.init(M, 2 * DFF, G, (int)blockIdx.x);
              EpiSwiGLU E{q->ACT};
              pg8::gemm_phase<EpiSwiGLU, pg8::StaticOrder, true, true>(lds, g, S, E); }
#endif
            GRID_SYNC();
#ifndef NO_GDN
            { KP q = FRESH_P(); pg8::Gemm g{q->ACT, q->WDN + (size_t)(l * 2 + f) * D * DFF, M, D, DFF}; pg8::StaticOrder S; S.init(M, D, G, (int)blockIdx.x);
              EpiResid E{q->X, q->ADA + (size_t)(l * 3) * NADA * D + (3 * s + 2) * D, 0.5f};
              pg8::gemm_phase<EpiResid, pg8::StaticOrder, true, true>(lds, g, S, E);
              wprep_idle(FRESH_P(), (LAS float*)lds, l + 1, f == 0 ? 0 : 2, (M / 256) * (D / 256));
#ifdef REP_GDN
              __syncthreads(); EpiResid E0{q->X, q->ADA + (size_t)(l * 3) * NADA * D + (3 * s + 2) * D, 0.0f};
              pg8::gemm_phase<EpiResid, pg8::StaticOrder, true, true>(lds, g, S, E0);
#endif
            }
#endif
            GRID_SYNC();
        }
    }
}

}

extern "C" void kernel_launch(void* const* d_in, const int* in_sizes, int n_in, void* d_out, int out_size, void* d_ws, size_t ws_size, hipStream_t stream) {
    P p{};
    const float* const* in = (const float* const*)d_in;
    p.x_prompt = in[0]; p.x_sample = in[1]; p.cache_ckv = in[2]; p.cache_krope = in[3]; p.state_hgrn = in[4]; p.state_gdn = in[5]; p.c = in[6]; p.c_ctx = in[7];
    p.w_ada = in[8]; p.b_ada = in[9]; p.norm_ffn = in[10]; p.w_gu = in[11]; p.w_down = in[12]; p.norm_mix = in[13]; p.w_in = in[14]; p.w_out = in[15];
    p.hgrn_lb = in[16]; p.hgrn_norm = in[17]; p.hy_conv_w = in[18]; p.hy_conv_b = in[19]; p.hy_w1 = in[20]; p.hy_b1 = in[21]; p.hy_freq = in[22];
    p.hy_w2 = in[23]; p.hy_b2 = in[24]; p.hy_w3 = in[25]; p.hy_skip = in[26]; p.q_norm_a = in[27]; p.w_q_up = in[28]; p.kv_norm_a = in[29];
    p.w_kv_up = in[30]; p.qk_norm = in[31]; p.gdn_conv_w = in[32]; p.gdn_a_log = in[33]; p.gdn_dt_bias = in[34]; p.gdn_norm = in[35];
    float* out = (float*)d_out;
    p.X = out;
    p.o_ckv = out + (size_t)M * D;
    p.o_krope = p.o_ckv + (size_t)NB_P * DEPTH * T_P * 128;
    p.o_shg = p.o_krope + (size_t)NB_P * DEPTH * T_P * 32;
    p.o_sgd = p.o_shg + (size_t)NB_P * DEPTH * 2 * 4 * 64 * 64;
    unsigned char* w = (unsigned char*)d_ws;
    auto take = [&](size_t bytes) { unsigned char* r = w; w += (bytes + 255) & ~(size_t)255; return r; };
    p.ADA = (float*)take((size_t)DEPTH * 3 * NADA * D * 4);
    p.LB = (float*)take(DEPTH * 512 * 4);
    p.FILT = (float*)take(DEPTH * FILT_L * 4);
    p.ROPE = (float*)take(2 * 1024 * 16 * 4);
    p.WGU = (bf16*)take((size_t)DEPTH * 2 * 2 * DFF * D * 2);
    p.WDN = (bf16*)take((size_t)DEPTH * 2 * D * DFF * 2);
    p.WIN = (bf16*)take((size_t)DEPTH * INCP * D * 2);
    p.WOUT = (bf16*)take((size_t)DEPTH * D * D * 2);
    p.WQT = (bf16*)take((size_t)DEPTH * 384 * 256 * 2); p.WKVT = (bf16*)take((size_t)DEPTH * 512 * 128 * 2);
    p.H = (bf16*)take((size_t)M * D * 2);
    p.ACT = (bf16*)take((size_t)M * DFF * 2);
    p.OCAT = (bf16*)take((size_t)M * D * 2);
    p.U = (float*)take((size_t)M * INCP * 4);
    p.QB = (bf16*)take((size_t)M * 384 * 2);
    p.KBP = (bf16*)take((size_t)NB_P * 4 * T_P * 96 * 2); p.VTP = (bf16*)take((size_t)NB_P * 4 * 64 * T_P * 2);
    p.KBS = (bf16*)take((size_t)NB_S * 4 * NKS * 96 * 2); p.VTS = (bf16*)take((size_t)NB_S * 4 * 64 * NKS * 2);
    p.GQ = (float*)take((size_t)M * 256 * 4); p.GK = (float*)take((size_t)M * 256 * 4); p.GV = (float*)take((size_t)M * 256 * 4);
    p.GA = (float*)take((size_t)M * 8 * 4); p.GBT = (float*)take((size_t)M * 8 * 4);
    p.HF = (float*)take((size_t)2 * M * 256 * 4); p.HQ = (float*)take((size_t)M * 256 * 4);
    p.Z = (float*)take((size_t)M * 256 * 4); p.X0 = (float*)take((size_t)M * 256 * 4);
    p.OH = (float*)take((size_t)2 * M * 256 * 4); p.OG = (float*)take((size_t)2 * M * 256 * 4);
    p.HS = (float*)take((size_t)1536 * 4096 * 4); p.HD = (float*)take((size_t)1536 * 64 * 4);
    p.GS = (float*)take((size_t)768 * 4096 * 4); p.GP = (float*)take((size_t)768 * 4096 * 4);
    p.HS2 = (float*)take((size_t)1536 * 4096 * 4); p.GS2 = (float*)take((size_t)768 * 4096 * 4);
    p.GKB = (bf16*)take((size_t)M * 256 * 2); p.GQB = (bf16*)take((size_t)M * 256 * 2); p.GLA = (float*)take((size_t)M * 8 * 4);
    p.ATT = (bf16*)take((size_t)768 * 4096 * 2); p.WN = (bf16*)take((size_t)768 * 4096 * 2); p.QG = (bf16*)take((size_t)768 * 4096 * 2); p.KOT = (bf16*)take((size_t)768 * 4096 * 2);
    p.UB = (float*)take((size_t)768 * 4096 * 4); p.EGL = (float*)take((size_t)768 * 4);
    p.BAR = (unsigned*)take(16384);

    static int grid_blocks = 0;
    if (!grid_blocks) {
        int dev = 0, cus = 0, per_cu = 0;
        hipGetDevice(&dev);
        hipDeviceGetAttribute(&cus, hipDeviceAttributeMultiprocessorCount, dev);
        hipFuncSetAttribute((const void*)fwd_megakernel, hipFuncAttributeMaxDynamicSharedMemorySize, LDS_BYTES);
        hipOccupancyMaxActiveBlocksPerMultiprocessor(&per_cu, (const void*)fwd_megakernel, NTHREADS, LDS_BYTES);
        if (per_cu < 1) { fprintf(stderr, "kernel_launch: occupancy query reports %d blocks per CU\n", per_cu); per_cu = 1; }
        if (per_cu > 1) per_cu = 1;
        grid_blocks = cus * per_cu;
    }
    (void)hipMemsetAsync(p.BAR, 0, 16384, stream);
    void* args[] = {&p};
    hipError_t e = hipLaunchCooperativeKernel((const void*)fwd_megakernel, dim3(grid_blocks), dim3(NTHREADS), args, LDS_BYTES, stream);
    if (e != hipSuccess) fprintf(stderr, "cooperative launch failed: %s (grid %d)\n", hipGetErrorString(e), grid_blocks);
}
```

```cpp
#define REP_SCANC 2
#include <hip/hip_runtime.h>
#include <hip/hip_cooperative_groups.h>
#include <stdint.h>
#include <math.h>
#include <cstdio>
#include <type_traits>
namespace cg = cooperative_groups;

namespace pg8 {
#define PG8_LAS __attribute__((address_space(3)))
typedef unsigned short bf16_t;
typedef short bf16x8 __attribute__((ext_vector_type(8)));
typedef float f32x4 __attribute__((ext_vector_type(4)));
typedef unsigned u32x4 __attribute__((ext_vector_type(4)));
constexpr int BM = 256, BK = 64, HALF = 128, HTB = HALF * BK * 2  , STAGE_BYTES = 8 * HTB, NXCD = 8, WGM = 8;

__host__ __device__ __forceinline__ int lds_byte(int r, int c) { const int st = (r >> 4) * 2 + (c >> 5), rr = r & 15, cc = c & 31, ob = rr * 64 + cc * 2; return st * 1024 + (ob ^ (((ob >> 9) & 1) << 5)); }
__host__ __device__ __forceinline__ void stage_rc(int b, int& R, int& C) { const int st = b / 1024, sb = b % 1024, swz = sb ^ (((sb >> 9) & 1) << 5); R = (st >> 1) * 16 + swz / 64; C = (st & 1) * 32 + (swz % 64) / 2; }
__host__ __device__ __forceinline__ int perm32(int rho) { const int n = rho >> 4, i = rho & 15; return 8 * (i >> 2) + 4 * n + (i & 3); }

struct Unit { int pm, pn; };
struct Gemm { const bf16_t* A; const bf16_t* Bt; int M, N, K; };

struct StaticOrder {
    int nM, nN, nwg, G, c;
    __host__ __device__ void init(int M, int N, int G_, int c_) { nM = M / BM; nN = N / BM; nwg = nM * nN; G = G_; c = c_; }
    __host__ __device__ bool next(int i, Unit& u) const {
        const long L = (long)i * G + c; if (L >= nwg) return false;
        int wgid = (int)L; { const int q = nwg / NXCD, r = nwg % NXCD, xcd = wgid % NXCD, off = wgid / NXCD; wgid = (xcd < r ? xcd * (q + 1) : r * (q + 1) + (xcd - r) * q) + off; }
        const int nig = WGM * nN, gid = wgid / nig, fm = gid * WGM, gsz = (nM - fm) < WGM ? (nM - fm) : WGM;
        u.pm = fm + ((wgid % nig) % gsz); u.pn = (wgid % nig) / gsz; return true;
    }
    __device__ __forceinline__ void a_ready(const Unit&) const {}
    __device__ __forceinline__ void done(const Unit&) const {}
};

__device__ __forceinline__ unsigned cvt_pk_bf16(float lo, float hi) { unsigned r; asm volatile("v_cvt_pk_bf16_f32 %0, %1, %2" : "=v"(r) : "v"(lo), "v"(hi)); return r; }

template <class Epi, class Sched, bool ALIGN_EPI = false, bool SP2 = false>
__device__ __forceinline__ void gemm_phase(PG8_LAS unsigned char* lds, const Gemm g, const Sched& S, const Epi& E) {
    int tid_ = threadIdx.x; asm volatile("" : "+v"(tid_));
    const int tid = tid_, wid = __builtin_amdgcn_readfirstlane(tid >> 6), lane = tid & 63, wr = wid >> 2, wc = wid & 3, fr = lane & 15, fq = lane >> 4;
    const int K = g.K, nt = K / BK;
    unsigned voffA[2], voffB[2];
#pragma unroll
    for (int i = 0; i < 2; ++i) { int R, C; stage_rc(tid * 16 + i * 8192, R, C); const int Rb = Epi::PERM ? ((R & ~31) + perm32(R & 31)) : R;
        voffA[i] = (unsigned)(R * K + C) * 2u; voffB[i] = (unsigned)(Rb * K + C) * 2u; }
    const size_t kstep = (size_t)(BK * 2);
    const size_t hstep = (size_t)HALF * K * 2;
    const size_t tstep = 2 * hstep;
    const unsigned ldsw = (unsigned)wid * 1024u;
    const int aoff = lds_byte(wr * 64 + fr, fq * 8), boff = lds_byte(wc * 32 + fr, fq * 8);
#define PG8_SA(b, h) (((b) * 2 + (h)) * HTB)
#define PG8_SB(b, h) ((4 + (b) * 2 + (h)) * HTB)
#define PG8_STAGE(bufoff, gbase, voff) do { _Pragma("unroll") for (int _i = 0; _i < 2; ++_i) \
        __builtin_amdgcn_global_load_lds((const unsigned*)((const char*)(gbase) + (voff)[_i]), (PG8_LAS unsigned*)(lds + (bufoff) + ldsw + _i * 8192), 16, 0, 0); } while (0)
#define PG8_LDA(dst, b, h) do { _Pragma("unroll") for (int m = 0; m < 4; ++m) _Pragma("unroll") for (int k = 0; k < 2; ++k) dst[m][k] = *(const PG8_LAS bf16x8*)(lds + PG8_SA(b, h) + aoff + m * 2048 + k * 1024); } while (0)
#define PG8_LDB(dst, b, h) do { _Pragma("unroll") for (int n = 0; n < 2; ++n) _Pragma("unroll") for (int k = 0; k < 2; ++k) dst[n][k] = *(const PG8_LAS bf16x8*)(lds + PG8_SB(b, h) + boff + n * 2048 + k * 1024); } while (0)
#define PG8_MMA(ai, bj, At, Bt) do { __builtin_amdgcn_s_setprio(1); _Pragma("unroll") for (int m = 0; m < 4; ++m) _Pragma("unroll") for (int n = 0; n < 2; ++n) _Pragma("unroll") for (int k = 0; k < 2; ++k) \
        acc[ai][bj][m][n] = __builtin_amdgcn_mfma_f32_16x16x32_bf16(Bt[n][k], At[m][k], acc[ai][bj][m][n], 0, 0, 0); __builtin_amdgcn_s_setprio(0); } while (0)
#define PG8_WAIT_V(n) asm volatile("s_waitcnt vmcnt(" #n ")" ::: "memory")
#define PG8_WAIT_L(n) asm volatile("s_waitcnt lgkmcnt(" #n ")" ::: "memory")
#define PG8_BAR __builtin_amdgcn_s_barrier()
#define PG8_SCHED __builtin_amdgcn_sched_barrier(0)
    Unit cur, nxt; int ui = 0;
    if (!S.next(0, cur)) return;
    f32x4 acc[2][2][4][2];
#pragma unroll
    for (int a = 0; a < 2; ++a)
#pragma unroll
        for (int b = 0; b < 2; ++b)
#pragma unroll
            for (int m = 0; m < 4; ++m)
#pragma unroll
                for (int n = 0; n < 2; ++n) acc[a][b][m][n] = (f32x4){0.f, 0.f, 0.f, 0.f};
    bf16x8 At[4][2], B0[2][2], B1[2][2];
    const char* cA = (const char*)g.A + (size_t)cur.pm * tstep; const char* cB = (const char*)g.Bt + (size_t)cur.pn * tstep;
    S.a_ready(cur);
    if constexpr (SP2) {
        PG8_STAGE(PG8_SB(0, 0), cB, voffB); PG8_STAGE(PG8_SB(0, 1), cB + hstep, voffB); PG8_STAGE(PG8_SA(0, 0), cA, voffA); PG8_STAGE(PG8_SA(0, 1), cA + hstep, voffA);
        if (wr == 1) PG8_BAR;
        PG8_WAIT_V(2); PG8_BAR;
        PG8_STAGE(PG8_SB(1, 0), cB + kstep, voffB); PG8_STAGE(PG8_SA(1, 0), cA + kstep, voffA); PG8_STAGE(PG8_SB(1, 1), cB + hstep + kstep, voffB);
        PG8_WAIT_V(6); PG8_BAR;
    } else {
        PG8_STAGE(PG8_SB(0, 0), cB, voffB); PG8_STAGE(PG8_SA(0, 0), cA, voffA); PG8_STAGE(PG8_SB(0, 1), cB + hstep, voffB); PG8_STAGE(PG8_SA(0, 1), cA + hstep, voffA);
        if (wr == 1) PG8_BAR;
        PG8_WAIT_V(4); PG8_BAR;
        PG8_STAGE(PG8_SB(1, 0), cB + kstep, voffB); PG8_STAGE(PG8_SA(1, 0), cA + kstep, voffA); PG8_STAGE(PG8_SB(1, 1), cB + hstep + kstep, voffB);
        PG8_WAIT_V(6); PG8_BAR;
    }
    for (;;) {
        const bool has_next = S.next(ui + 1, nxt);
        const char* nA = has_next ? (const char*)g.A + (size_t)nxt.pm * tstep : cA; const char* nB = has_next ? (const char*)g.Bt + (size_t)nxt.pn * tstep : cB;
        for (int t = 0; t < nt; t += 2) {
            const bool last = (t == nt - 2);
            const char* a1 = cA + (size_t)(t + 1) * kstep;
            const char* a2 = last ? nA : cA + (size_t)(t + 2) * kstep; const char* b2 = last ? nB : cB + (size_t)(t + 2) * kstep;
            const char* a3 = a2 + kstep; const char* b3 = b2 + kstep;
            if (last && has_next) S.a_ready(nxt);
            if constexpr (SP2) {
            PG8_LDB(B0, 0, 0); PG8_LDB(B1, 0, 1); PG8_SCHED; PG8_LDA(At, 0, 0); PG8_STAGE(PG8_SA(1, 1), a1 + hstep, voffA);
            PG8_WAIT_V(8); PG8_WAIT_L(0); PG8_BAR; PG8_MMA(0, 0, At, B0); PG8_MMA(0, 1, At, B1); PG8_BAR; PG8_SCHED;
            PG8_LDA(At, 0, 1); PG8_STAGE(PG8_SB(0, 0), b2, voffB); PG8_STAGE(PG8_SB(0, 1), b2 + hstep, voffB); PG8_STAGE(PG8_SA(0, 0), a2, voffA);
            PG8_WAIT_V(8); PG8_WAIT_L(0); PG8_BAR; PG8_MMA(1, 0, At, B0); PG8_MMA(1, 1, At, B1); PG8_BAR; PG8_SCHED;
            PG8_LDB(B0, 1, 0); PG8_LDB(B1, 1, 1); PG8_SCHED; PG8_LDA(At, 1, 0); PG8_STAGE(PG8_SA(0, 1), a2 + hstep, voffA);
            PG8_WAIT_V(8); PG8_WAIT_L(0); PG8_BAR; PG8_MMA(0, 0, At, B0); PG8_MMA(0, 1, At, B1); PG8_BAR; PG8_SCHED;
            PG8_LDA(At, 1, 1); PG8_STAGE(PG8_SB(1, 0), b3, voffB); PG8_STAGE(PG8_SB(1, 1), b3 + hstep, voffB); PG8_STAGE(PG8_SA(1, 0), a3, voffA);
            PG8_WAIT_V(8); PG8_WAIT_L(0); PG8_BAR; PG8_MMA(1, 0, At, B0); PG8_MMA(1, 1, At, B1); PG8_BAR; PG8_SCHED;
            } else {
            PG8_LDB(B0, 0, 0); PG8_SCHED; PG8_LDA(At, 0, 0); PG8_STAGE(PG8_SA(1, 1), a1 + hstep, voffA);
            PG8_WAIT_L(8); PG8_BAR; PG8_WAIT_L(0); PG8_MMA(0, 0, At, B0); PG8_BAR; PG8_SCHED;
            PG8_LDB(B1, 0, 1); PG8_STAGE(PG8_SB(0, 0), b2, voffB);
            PG8_BAR; PG8_WAIT_L(0); PG8_MMA(0, 1, At, B1); PG8_BAR;
            PG8_LDA(At, 0, 1); PG8_STAGE(PG8_SA(0, 0), a2, voffA);
            PG8_BAR; PG8_WAIT_L(0); PG8_MMA(1, 0, At, B0); PG8_BAR; PG8_SCHED;
            PG8_STAGE(PG8_SB(0, 1), b2 + hstep, voffB);
            PG8_WAIT_V(6); PG8_BAR; PG8_MMA(1, 1, At, B1); PG8_BAR;
            PG8_LDB(B0, 1, 0); PG8_SCHED; PG8_LDA(At, 1, 0); PG8_STAGE(PG8_SA(0, 1), a2 + hstep, voffA);
            PG8_WAIT_L(8); PG8_BAR; PG8_WAIT_L(0); PG8_MMA(0, 0, At, B0); PG8_BAR; PG8_SCHED;
            PG8_LDB(B1, 1, 1); PG8_STAGE(PG8_SB(1, 0), b3, voffB);
            PG8_BAR; PG8_WAIT_L(0); PG8_MMA(0, 1, At, B1); PG8_BAR;
            PG8_LDA(At, 1, 1); PG8_STAGE(PG8_SA(1, 0), a3, voffA);
            PG8_BAR; PG8_WAIT_L(0); PG8_MMA(1, 0, At, B0); PG8_BAR; PG8_SCHED;
            PG8_STAGE(PG8_SB(1, 1), b3 + hstep, voffB);
            PG8_WAIT_V(6); PG8_BAR; PG8_MMA(1, 1, At, B1); PG8_BAR;
            }
        }
        if constexpr (ALIGN_EPI) { if (wr == 0) PG8_BAR; }
        if constexpr (!Epi::AFTER_DRAIN) { E(acc, cur, wr, wc, fr, fq); S.done(cur); }
        if (!has_next) break;
#pragma unroll
        for (int a = 0; a < 2; ++a)
#pragma unroll
            for (int b = 0; b < 2; ++b)
#pragma unroll
                for (int m = 0; m < 4; ++m)
#pragma unroll
                    for (int n = 0; n < 2; ++n) acc[a][b][m][n] = (f32x4){0.f, 0.f, 0.f, 0.f};
        cur = nxt; cA = nA; cB = nB; ++ui;
        if constexpr (ALIGN_EPI) { if (wr == 1) PG8_BAR; }
    }
    PG8_WAIT_V(0);
    if constexpr (!ALIGN_EPI) { if (wr == 0) PG8_BAR; }
    PG8_BAR;
    if constexpr (Epi::AFTER_DRAIN) { E.fused(acc, cur, wr, wc, fr, fq, lds, wid, lane); S.done(cur); }
#undef PG8_SA
#undef PG8_SB
#undef PG8_STAGE
#undef PG8_LDA
#undef PG8_LDB
#undef PG8_MMA
#undef PG8_WAIT_V
#undef PG8_WAIT_L
#undef PG8_BAR
#undef PG8_SCHED
}
}

namespace {
#define LAS __attribute__((address_space(3)))
typedef unsigned short bf16;
typedef float f32x4 __attribute__((ext_vector_type(4)));
typedef unsigned u32x4 __attribute__((ext_vector_type(4)));
typedef unsigned u32x2 __attribute__((ext_vector_type(2)));
typedef short bf16x8 __attribute__((ext_vector_type(8)));
typedef short bf16x4 __attribute__((ext_vector_type(4)));

constexpr int NTHREADS = 512;
constexpr int D = 1024, NB_P = 16, T_P = 256, NB_S = 2, T_S = 1024, DEPTH = 4, PAST = 256;
constexpr int M_P = NB_P * T_P, M_S = NB_S * T_S, M = M_P + M_S;
constexpr int DFF = 2816, NADA = 9, INC = 3504, INCP = 3584;
constexpr int HG_OFF = 0, HY_OFF = 1280, MLA_OFF = 2048, GD_OFF = 2464;
constexpr int NKS = T_S + PAST;
constexpr float RMS_EPS = 1e-6f;
constexpr int LDS_BYTES = 147456;
constexpr size_t FILT_L = 2 * (256 + 1024) * 256;

struct P {
    const float *x_prompt, *x_sample, *cache_ckv, *cache_krope, *state_hgrn, *state_gdn, *c, *c_ctx;
    const float *w_ada, *b_ada, *norm_ffn, *w_gu, *w_down, *norm_mix, *w_in, *w_out, *hgrn_lb, *hgrn_norm;
    const float *hy_conv_w, *hy_conv_b, *hy_w1, *hy_b1, *hy_freq, *hy_w2, *hy_b2, *hy_w3, *hy_skip;
    const float *q_norm_a, *w_q_up, *kv_norm_a, *w_kv_up, *qk_norm, *gdn_conv_w, *gdn_a_log, *gdn_dt_bias, *gdn_norm;
    float *X;
    float *o_ckv, *o_krope, *o_shg, *o_sgd;
    float *ADA;
    float *LB;
    float *FILT;
    float *ROPE;
    bf16 *WGU;
    bf16 *WDN;
    bf16 *WIN;
    bf16 *WOUT;
    bf16 *WQT, *WKVT;
    bf16 *H;
    bf16 *ACT;
    bf16 *OCAT;
    float *U;
    bf16 *QB;
    bf16 *KBP, *VTP;
    bf16 *KBS, *VTS;
    float *GQ, *GK, *GV;
    float *GA, *GBT;
    float *HF, *HQ;
    float *Z, *X0;
    float *OH, *OG;
    float *HS, *HD;
    float *GS, *GP;
    float *HS2, *GS2;
    bf16 *GKB, *GQB;
    float *GLA;
    bf16 *ATT, *WN, *QG, *KOT;
    float *UB, *EGL;
    unsigned *BAR;
};

typedef const __attribute__((address_space(4))) P* KP;
#define FRESH_P() ({ KP k_ = (KP)__builtin_amdgcn_kernarg_segment_ptr(); asm volatile("" : "+s"(k_)); k_; })
__device__ __forceinline__ int otid() { int t = threadIdx.x; asm volatile("" : "+v"(t)); return t; }
__device__ __forceinline__ float sigmoidf_(float x) { return 1.f / (1.f + expf(-x)); }
__device__ __forceinline__ float siluf_(float x) { return x / (1.f + expf(-x)); }
__device__ __forceinline__ unsigned f2bf(float f) { unsigned u = __builtin_bit_cast(unsigned, f); return (u + 0x7fffu + ((u >> 16) & 1u)) >> 16; }
__device__ __forceinline__ unsigned pk2(float lo, float hi) { return f2bf(lo) | (f2bf(hi) << 16); }

__device__ __forceinline__ void row_info(int r, int& ci, int& T, int& row0, int& t, int& b) {
    if (r < M_P) { b = r >> 8; t = r & 255; T = T_P; row0 = b << 8; ci = 0; }
    else { const int rr = r - M_P; b = rr >> 10; t = rr & 1023; T = T_S; row0 = M_P + (b << 10); ci = 1 + b; }
}
__device__ __forceinline__ int panel_ci(int pm) { return pm < 16 ? 0 : 1 + ((pm - 16) >> 2); }

__device__ __forceinline__ float wave_sum(float v, int lane) {
#pragma unroll
    for (int o = 1; o < 64; o <<= 1) v += __builtin_bit_cast(float, __builtin_amdgcn_ds_bpermute((lane ^ o) << 2, __builtin_bit_cast(int, v)));
    return v;
}
__device__ __forceinline__ float bcast(float v, int k) { return __builtin_bit_cast(float, __builtin_amdgcn_readlane(__builtin_bit_cast(int, v), k)); }

struct EpiSwiGLU {
    static constexpr bool PERM = true, AFTER_DRAIN = false;
    bf16* O;
    __device__ __forceinline__ void operator()(const f32x4 (&acc)[2][2][4][2], const pg8::Unit& u, int wr, int wc, int fr, int fq) const {
        const int row0 = u.pm * 256 + wr * 64 + fr, col0 = u.pn * 128 + wc * 32 + 8 * fq;
#pragma unroll
        for (int ai = 0; ai < 2; ++ai)
#pragma unroll
            for (int m = 0; m < 4; ++m) {
                bf16* rowp = O + (size_t)(row0 + ai * 128 + m * 16) * DFF + col0;
                float v[8];
#pragma unroll
                for (int n = 0; n < 2; ++n)
#pragma unroll
                    for (int i = 0; i < 4; ++i) { const float g = acc[ai][0][m][n][i], up = acc[ai][1][m][n][i];
                        v[4 * n + i] = g * __builtin_amdgcn_rcpf(1.f + __expf(-g)) * up; }
                u32x4 w; w.x = pg8::cvt_pk_bf16(v[0], v[1]); w.y = pg8::cvt_pk_bf16(v[2], v[3]); w.z = pg8::cvt_pk_bf16(v[4], v[5]); w.w = pg8::cvt_pk_bf16(v[6], v[7]);
                *(u32x4*)rowp = w;
            }
    }
};
struct EpiF32 {
    static constexpr bool PERM = false, AFTER_DRAIN = false;
    float* C; int ldc;
    __device__ __forceinline__ void operator()(const f32x4 (&acc)[2][2][4][2], const pg8::Unit& u, int wr, int wc, int fr, int fq) const {
        const int row0 = u.pm * 256 + wr * 64 + fr, col0 = u.pn * 256 + wc * 32 + 4 * fq;
#pragma unroll
        for (int ai = 0; ai < 2; ++ai)
#pragma unroll
            for (int m = 0; m < 4; ++m) { float* rowp = C + (size_t)(row0 + ai * 128 + m * 16) * ldc + col0;
#pragma unroll
                for (int bj = 0; bj < 2; ++bj)
#pragma unroll
                    for (int n = 0; n < 2; ++n) *(f32x4*)(rowp + bj * 128 + n * 16) = acc[ai][bj][m][n]; }
    }
};
struct EpiResid {
    static constexpr bool PERM = false, AFTER_DRAIN = false;
    float* X; const float* gate; float coef;
    __device__ __forceinline__ void operator()(const f32x4 (&acc)[2][2][4][2], const pg8::Unit& u, int wr, int wc, int fr, int fq) const {
        const int row0 = u.pm * 256 + wr * 64 + fr, col0 = u.pn * 256 + wc * 32 + 4 * fq;
        const float* g = gate + (size_t)panel_ci(u.pm) * NADA * D + col0;
        f32x4 gv[2][2];
#pragma unroll
        for (int bj = 0; bj < 2; ++bj)
#pragma unroll
            for (int n = 0; n < 2; ++n) gv[bj][n] = *(const f32x4*)(g + bj * 128 + n * 16) * coef;
#pragma unroll
        for (int ai = 0; ai < 2; ++ai) {
            f32x4 xv[4][2][2];
#pragma unroll
            for (int m = 0; m < 4; ++m)
#pragma unroll
                for (int bj = 0; bj < 2; ++bj)
#pragma unroll
                    for (int n = 0; n < 2; ++n) xv[m][bj][n] = *(const f32x4*)(X + (size_t)(row0 + ai * 128 + m * 16) * D + col0 + bj * 128 + n * 16);
#pragma unroll
            for (int m = 0; m < 4; ++m)
#pragma unroll
                for (int bj = 0; bj < 2; ++bj)
#pragma unroll
                    for (int n = 0; n < 2; ++n) *(f32x4*)(X + (size_t)(row0 + ai * 128 + m * 16) * D + col0 + bj * 128 + n * 16) = xv[m][bj][n] + gv[bj][n] * acc[ai][bj][m][n];
        }
    }
};

__device__ __forceinline__ void ph_init(KP p) {
    const int tix = otid();
    const int n4 = M * D / 4, np4 = M_P * D / 4;
    for (int i = blockIdx.x * NTHREADS + tix; i < n4; i += gridDim.x * NTHREADS) {
        const float4 v = (i < np4) ? ((const float4*)p->x_prompt)[i] : ((const float4*)p->x_sample)[i - np4];
        ((float4*)p->X)[i] = v;
    }
}

__device__ __forceinline__ void ph_ada(KP p, LAS float* sc  ) {
    const int tix = otid();
    const int lane = tix & 63, wv = tix >> 6;
    for (int i = tix; i < 3 * 1024; i += NTHREADS) {
        const int ci = i >> 10, k = i & 1023;
        const float v = (ci == 0) ? p->c_ctx[k] : p->c[(ci - 1) * 1024 + k];
        sc[i] = siluf_(v);
    }
    __syncthreads();
    LAS float* part = sc + 3 * 1024;
    const int NJ = NADA * D, NG = DEPTH * (NJ / 64);
    const int trips = (NG + gridDim.x - 1) / gridDim.x;
    for (int it = 0; it < trips; ++it) {
        const int item = it * gridDim.x + blockIdx.x; const bool act = item < NG;
        const int l = act ? item / (NJ / 64) : 0, j = (act ? item % (NJ / 64) : 0) * 64 + lane;
        float a0 = 0.f, a1 = 0.f, a2 = 0.f;
        if (act) {
            const float* w = p->w_ada + (size_t)l * D * NJ + (size_t)(wv * 128) * NJ + j;
#pragma unroll 16
            for (int k = 0; k < 128; ++k) { const float wvv = w[(size_t)k * NJ]; const int kk = wv * 128 + k; a0 += sc[kk] * wvv; a1 += sc[1024 + kk] * wvv; a2 += sc[2048 + kk] * wvv; }
        }
        part[(wv * 3 + 0) * 64 + lane] = a0; part[(wv * 3 + 1) * 64 + lane] = a1; part[(wv * 3 + 2) * 64 + lane] = a2;
        __syncthreads();
        if (act && wv < 3) {
            float s = p->b_ada[l * NJ + j];
#pragma unroll
            for (int w8 = 0; w8 < 8; ++w8) s += part[(w8 * 3 + wv) * 64 + lane];
            p->ADA[(size_t)(l * 3 + wv) * NJ + j] = s;
        }
        __syncthreads();
    }
}

__device__ __forceinline__ void ph_small(KP p) {
    const int tix = otid();
    const int gt = blockIdx.x * NTHREADS + tix, gn = gridDim.x * NTHREADS;
    for (int i = gt; i < 512; i += gn) {
        float v[4], mx = -1e30f;
        for (int l = 0; l < 4; ++l) { v[l] = p->hgrn_lb[l * 512 + i]; mx = fmaxf(mx, v[l]); }
        float s = 0.f;
        for (int l = 0; l < 4; ++l) { v[l] = expf(v[l] - mx); s += v[l]; }
        float cum = 0.f;
        for (int l = 0; l < 4; ++l) { if (l > 0) cum += v[l] / s; p->LB[l * 512 + i] = cum; }
    }
    for (int i = gt; i < 1024 * 16; i += gn) {
        const int t = i >> 4, j = i & 15;
        const int row = t >> 6, col = t & 63;
        const double inv = pow(10000.0, -(double)(j & 7) / 8.0);
        const double ang = (double)((j < 8) ? row : col) * inv;
        p->ROPE[i] = (float)cos(ang);
        p->ROPE[1024 * 16 + i] = (float)sin(ang);
    }
}

__device__ __forceinline__ void ph_filt(KP p, LAS double* scr  ) {
    const int tix = otid();
    const int lane = tix & 63, wv = tix >> 6;
    LAS double* ze = scr + wv * 168; LAS double* h1 = ze + 40; LAS double* h2 = h1 + 64;
    const int NIT = DEPTH * 1280, gw = blockIdx.x * 8 + wv, NGW = gridDim.x * 8;
    const int trips = (NIT + NGW - 1) / NGW;
    for (int it = 0; it < trips; ++it) {
        const int item = it * NGW + gw; const bool act = item < NIT;
        const int l = act ? item / 1280 : 0, q = act ? item % 1280 : 0;
        const int set = (q < 256) ? 0 : 1, pos = set ? q - 256 : q, L = set ? 1024 : 256;
        const double t = (double)pos / (double)(L - 1);
        if (lane == 0) ze[0] = t;
        if (lane < 16) {
            const double band = 1e-4 + (double)lane * ((15.0 - 1e-4) / 15.0);
            const double ang = (2.0 * 3.14159265358979323846 / (double)L) * (double)pos * band;
            ze[1 + lane] = cos(ang);
            ze[17 + lane] = -sin(ang);
        }
        __syncthreads();
        const double fr = (double)p->hy_freq[l * 64 + lane];
        {
            double a = (double)p->hy_b1[l * 64 + lane];
            for (int i = 0; i < 33; ++i) a += ze[i] * (double)p->hy_w1[(l * 33 + i) * 64 + lane];
            h1[lane] = sin(fr * a);
        }
        __syncthreads();
        {
            double a = (double)p->hy_b2[l * 64 + lane];
            for (int i = 0; i < 64; ++i) a += h1[i] * (double)p->hy_w2[(l * 64 + i) * 64 + lane];
            h2[lane] = sin(fr * a);
        }
        __syncthreads();
        if (act) {
            float* base = p->FILT + (size_t)l * FILT_L + (set ? (size_t)2 * 256 * 256 : 0);
            const double max_decay = log(1e-2) / 0.3, min_decay = log(1e-2) / 1.5;
            for (int n = lane; n < 512; n += 64) {
                double a = 0.0;
                for (int i = 0; i < 64; ++i) a += h2[i] * (double)p->hy_w3[(size_t)(l * 64 + i) * 512 + n];
                const int c = n & 255;
                const double delta = min_decay + (double)c * ((max_decay - min_decay) / 255.0);
                const double win = exp(-t * fabs(delta));
                if (n < 256) base[(size_t)(L + pos) * 256 + c] = (float)(a * win);
                else if (pos > 0) base[(size_t)(L - pos) * 256 + c] = (float)(a * win);
            }
        }
        __syncthreads();
    }
}

__device__ __forceinline__ void transpose_item(const float* W, int K, int N, bf16* WT, int dst_row, LAS float* scr, int k0, int n0, int lane) {
    const int nn = n0 + (lane & 31);
#pragma unroll 8
    for (int i = 0; i < 32; ++i) { const int kk = 2 * i + (lane >> 5); scr[kk * 33 + (lane & 31)] = (nn < N) ? W[(size_t)(k0 + kk) * N + nn] : 0.f; }
    asm volatile("s_waitcnt lgkmcnt(0)" ::: "memory");
    const int c = lane & 7;
#pragma unroll
    for (int j = 0; j < 4; ++j) { const int n = (lane >> 3) + 8 * j; const LAS float* s = scr + (8 * c) * 33 + n;
        u32x4 o; o.x = pk2(s[0 * 33], s[1 * 33]); o.y = pk2(s[2 * 33], s[3 * 33]); o.z = pk2(s[4 * 33], s[5 * 33]); o.w = pk2(s[6 * 33], s[7 * 33]);
        *(u32x4*)(WT + (size_t)(dst_row + n) * K + k0 + 8 * c) = o; }
    asm volatile("s_waitcnt lgkmcnt(0)" ::: "memory");
}
constexpr int WP_I_GU = 16 * 176, WP_I_DN = 44 * 32, WP_I_IN = 16 * 112, WP_I_OUT = 16 * 32, WP_I_Q = 4 * 12, WP_I_KV = 2 * 16;
constexpr int WP_I_L = 2 * WP_I_GU + 2 * WP_I_DN + WP_I_IN + WP_I_OUT + WP_I_Q + WP_I_KV;
__device__ __forceinline__ void wprep_range(KP p, LAS float* scr_all, int l, int first, int count, int wblock, int nwblocks) {
    const int tix = otid();
    const int lane = tix & 63, wv = tix >> 6;
    LAS float* scr = scr_all + wv * (64 * 33);
    for (int it = first + wblock * 8 + wv; it < first + count; it += nwblocks * 8) {
        int r = it;
        if (r < 2 * WP_I_GU) { const int f = r / WP_I_GU, rr = r % WP_I_GU, kb = rr / 176, nb = rr % 176, n0 = nb * 32;
            const int j = n0 < DFF ? n0 : n0 - DFF; const int dst = 256 * (j >> 7) + (n0 < DFF ? 0 : 128) + (j & 127);
            transpose_item(p->w_gu + (size_t)(l * 2 + f) * D * 2 * DFF, D, 2 * DFF, p->WGU + (size_t)(l * 2 + f) * 2 * DFF * D, dst, scr, kb * 64, n0, lane); continue; }
        r -= 2 * WP_I_GU;
        if (r < 2 * WP_I_DN) { const int f = r / WP_I_DN, rr = r % WP_I_DN, kb = rr / 32, nb = rr % 32;
            transpose_item(p->w_down + (size_t)(l * 2 + f) * DFF * D, DFF, D, p->WDN + (size_t)(l * 2 + f) * D * DFF, nb * 32, scr, kb * 64, nb * 32, lane); continue; }
        r -= 2 * WP_I_DN;
        if (r < WP_I_IN) { const int kb = r / 112, nb = r % 112;
            transpose_item(p->w_in + (size_t)l * D * INC, D, INC, p->WIN + (size_t)l * INCP * D, nb * 32, scr, kb * 64, nb * 32, lane); continue; }
        r -= WP_I_IN;
        if (r < WP_I_OUT) { const int kb = r / 32, nb = r % 32;
            transpose_item(p->w_out + (size_t)l * D * D, D, D, p->WOUT + (size_t)l * D * D, nb * 32, scr, kb * 64, nb * 32, lane); continue; }
        r -= WP_I_OUT;
        if (r < WP_I_Q) { const int kb = r / 12, nb = r % 12;
            transpose_item(p->w_q_up + (size_t)l * 256 * 384, 256, 384, p->WQT + (size_t)l * 384 * 256, nb * 32, scr, kb * 64, nb * 32, lane); continue; }
        r -= WP_I_Q;
        { const int kb = r / 16, nb = r % 16;
            transpose_item(p->w_kv_up + (size_t)l * 128 * 512, 128, 512, p->WKVT + (size_t)l * 512 * 128, nb * 32, scr, kb * 64, nb * 32, lane); }
    }
}
__device__ __forceinline__ void ph_wprep(KP p, LAS float* scr_all) {
    wprep_range(p, scr_all, 0, 0, WP_I_L, blockIdx.x, gridDim.x);
}
__device__ __forceinline__ void wprep_idle(KP p, LAS float* scr_all, int l_next, int third, int nunits) {
    if (l_next >= DEPTH) return;
    const int G = gridDim.x;
    const int first = (WP_I_L * third) / 3, count = (WP_I_L * (third + 1)) / 3 - first;
    if (G > nunits) { if ((int)blockIdx.x >= nunits) wprep_range(p, scr_all, l_next, first, count, blockIdx.x - nunits, G - nunits); }
    else { __syncthreads(); wprep_range(p, scr_all, l_next, first, count, blockIdx.x, G); }
}

__device__ __forceinline__ void ph_norm(KP p, int l, int s) {
    const int tix = otid();
    const int lane = tix & 63, wv = tix >> 6;
    const float* g = (s == 1) ? p->norm_mix + l * D : p->norm_ffn + (size_t)(l * 2 + (s == 2 ? 1 : 0)) * D;
    for (int r = blockIdx.x * 8 + wv; r < M; r += gridDim.x * 8) {
        int ci, T, row0, t, b; row_info(r, ci, T, row0, t, b);
        const float* ada = p->ADA + (size_t)(l * 3 + ci) * NADA * D;
        const float* shift = ada + (3 * s + 0) * D;
        const float* scale = ada + (3 * s + 1) * D;
        const float4* xr = (const float4*)(p->X + (size_t)r * D);
        float4 v[4]; float ss = 0.f;
#pragma unroll
        for (int j = 0; j < 4; ++j) { v[j] = xr[lane + 64 * j]; ss += v[j].x * v[j].x + v[j].y * v[j].y + v[j].z * v[j].z + v[j].w * v[j].w; }
        ss = wave_sum(ss, lane);
        const float rstd = 1.0f / sqrtf(ss * (1.0f / D) + RMS_EPS);
        u32x2* hr = (u32x2*)(p->H + (size_t)r * D);
#pragma unroll
        for (int j = 0; j < 4; ++j) {
            const int c4 = lane + 64 * j;
            const float4 gg = ((const float4*)g)[c4], sh = ((const float4*)shift)[c4], scl = ((const float4*)scale)[c4];
            const float ox = v[j].x * rstd * gg.x * (1.f + scl.x) + sh.x;
            const float oy = v[j].y * rstd * gg.y * (1.f + scl.y) + sh.y;
            const float oz = v[j].z * rstd * gg.z * (1.f + scl.z) + sh.z;
            const float ow = v[j].w * rstd * gg.w * (1.f + scl.w) + sh.w;
            u32x2 o; o.x = pk2(ox, oy); o.y = pk2(oz, ow);
            hr[c4] = o;
        }
    }
}

__device__ __forceinline__ float red16(float v, int lane) {
#pragma unroll
    for (int o = 1; o < 16; o <<= 1) v += __builtin_bit_cast(float, __builtin_amdgcn_ds_bpermute((lane ^ o) << 2, __builtin_bit_cast(int, v)));
    return v;
}
__device__ __forceinline__ float red_g(float v, int lane) {
    v += __builtin_bit_cast(float, __builtin_amdgcn_ds_bpermute((lane ^ 16) << 2, __builtin_bit_cast(int, v)));
    v += __builtin_bit_cast(float, __builtin_amdgcn_ds_bpermute((lane ^ 32) << 2, __builtin_bit_cast(int, v)));
    return v;
}
__device__ __forceinline__ bf16x8 pack8(const float (&v)[8]) {
    u32x4 w; w.x = pg8::cvt_pk_bf16(v[0], v[1]); w.y = pg8::cvt_pk_bf16(v[2], v[3]); w.z = pg8::cvt_pk_bf16(v[4], v[5]); w.w = pg8::cvt_pk_bf16(v[6], v[7]);
    return __builtin_bit_cast(bf16x8, w);
}
__device__ __forceinline__ void mla_wave(KP p, int l, int group, int part, int lane) {
    asm volatile("" : "+v"(lane));
    const int tq = lane & 15, g = lane >> 4;
    const bool isctx = group >= 384;
    int tok0 = 0, b = 0, t0 = 0;
    bool sample = false;
    if (!isctx) { tok0 = group * 16; sample = tok0 >= M_P; if (sample) { b = (tok0 - M_P) >> 10; t0 = (tok0 - M_P) & 1023; } else { b = tok0 >> 8; t0 = tok0 & 255; } }
    else { const int j = group - 384; b = j >> 4; t0 = (j & 15) * 16; }
    const float qscale = 0.10206207261596577f;
    const bool rope = sample && !isctx;
    float cs[4], sn[4];
#pragma unroll
    for (int i = 0; i < 4; ++i) { const int t = rope ? t0 + 4 * g + i : 0; cs[i] = p->ROPE[t * 16 + tq]; sn[i] = p->ROPE[1024 * 16 + t * 16 + tq]; }
    if (part < 4) {
        const int h = part;
        const float* u = p->U + (size_t)(tok0 + tq) * INCP + MLA_OFF;
        bf16x8 aq[8];
        {
            float x[8][8]; float ss = 0.f;
#pragma unroll
            for (int s = 0; s < 8; ++s) { const f32x4 a = *(const f32x4*)(u + 32 * s + 8 * g), c = *(const f32x4*)(u + 32 * s + 8 * g + 4);
#pragma unroll
                for (int j = 0; j < 4; ++j) { x[s][j] = a[j]; x[s][4 + j] = c[j]; ss += a[j] * a[j] + c[j] * c[j]; } }
            ss = red_g(ss, lane);
            const float rstd = 1.0f / sqrtf(ss * (1.0f / 256.f) + RMS_EPS);
#pragma unroll
            for (int s = 0; s < 8; ++s) { const float* gn = p->q_norm_a + l * 256 + 32 * s + 8 * g; float v[8];
#pragma unroll
                for (int j = 0; j < 8; ++j) v[j] = x[s][j] * rstd * gn[j];
                aq[s] = pack8(v); }
        }
        const float* qn0 = p->qk_norm + (size_t)(l * 2 + 0) * 96;
        const bf16* Wq = p->WQT + (size_t)l * 384 * 256;
        f32x4 c[6];
#pragma unroll
        for (int tile = 0; tile < 6; ++tile) { c[tile] = (f32x4){0.f, 0.f, 0.f, 0.f};
            const bf16* wr = Wq + (size_t)(h * 96 + 16 * tile + tq) * 256 + 8 * g;
#pragma unroll
            for (int s = 0; s < 8; ++s) c[tile] = __builtin_amdgcn_mfma_f32_16x16x32_bf16(aq[s], *(const bf16x8*)(wr + 32 * s), c[tile], 0, 0, 0); }
#pragma unroll
        for (int i = 0; i < 4; ++i) {
            float ss = 0.f;
#pragma unroll
            for (int tile = 0; tile < 6; ++tile) ss += c[tile][i] * c[tile][i];
            ss = red16(ss, lane);
            const float rstd = 1.0f / sqrtf(ss * (1.0f / 96.f) + RMS_EPS);
            float v[6];
#pragma unroll
            for (int tile = 0; tile < 6; ++tile) v[tile] = c[tile][i] * rstd * qn0[16 * tile + tq];
            if (rope) { const float x1 = v[4], x2 = v[5]; v[4] = x1 * cs[i] - x2 * sn[i]; v[5] = x2 * cs[i] + x1 * sn[i]; }
            bf16* qo = p->QB + (size_t)(tok0 + 4 * g + i) * 384 + h * 96 + tq;
#pragma unroll
            for (int tile = 0; tile < 6; ++tile) qo[16 * tile] = (bf16)f2bf(v[tile] * qscale);
        }
    } else {
        const int h = part - 4;
        bf16x8 akv[4];
        if (!isctx) {
            const float* u = p->U + (size_t)(tok0 + tq) * INCP + MLA_OFF;
            float x[4][8]; float ss = 0.f;
#pragma unroll
            for (int s = 0; s < 4; ++s) { const f32x4 a = *(const f32x4*)(u + 256 + 32 * s + 8 * g), c = *(const f32x4*)(u + 256 + 32 * s + 8 * g + 4);
#pragma unroll
                for (int j = 0; j < 4; ++j) { x[s][j] = a[j]; x[s][4 + j] = c[j]; ss += a[j] * a[j] + c[j] * c[j]; } }
            ss = red_g(ss, lane);
            const float rstd = 1.0f / sqrtf(ss * (1.0f / 128.f) + RMS_EPS);
            float* oc = p->o_ckv + ((size_t)(b * DEPTH + l) * T_P + t0 + tq) * 128;
#pragma unroll
            for (int s = 0; s < 4; ++s) { const float* gn = p->kv_norm_a + l * 128 + 32 * s + 8 * g; float v[8];
#pragma unroll
                for (int j = 0; j < 8; ++j) v[j] = x[s][j] * rstd * gn[j];
                akv[s] = pack8(v);
                if (!sample && h == 0) { *(f32x4*)(oc + 32 * s + 8 * g) = (f32x4){v[0], v[1], v[2], v[3]}; *(f32x4*)(oc + 32 * s + 8 * g + 4) = (f32x4){v[4], v[5], v[6], v[7]}; } }
        } else {
            const float* cp = p->cache_ckv + ((size_t)(b * DEPTH + l) * PAST + t0 + tq) * 128;
#pragma unroll
            for (int s = 0; s < 4; ++s) { const f32x4 a = *(const f32x4*)(cp + 32 * s + 8 * g), c = *(const f32x4*)(cp + 32 * s + 8 * g + 4);
                const float v[8] = {a[0], a[1], a[2], a[3], c[0], c[1], c[2], c[3]}; akv[s] = pack8(v); }
        }
        float kr[2][4];
#pragma unroll
        for (int i = 0; i < 4; ++i)
#pragma unroll
            for (int tt = 0; tt < 2; ++tt) {
                const int tk = 4 * g + i;
                kr[tt][i] = isctx ? p->cache_krope[((size_t)(b * DEPTH + l) * PAST + t0 + tk) * 32 + 16 * tt + tq]
                                  : p->U[(size_t)(tok0 + tk) * INCP + MLA_OFF + 384 + 16 * tt + tq];
            }
        if (!isctx && !sample && h == 0) {
#pragma unroll
            for (int i = 0; i < 4; ++i)
#pragma unroll
                for (int tt = 0; tt < 2; ++tt) p->o_krope[((size_t)(b * DEPTH + l) * T_P + t0 + 4 * g + i) * 32 + 16 * tt + tq] = kr[tt][i];
        }
        const float* qn1 = p->qk_norm + (size_t)(l * 2 + 1) * 96;
        const bf16* Wkv = p->WKVT + (size_t)l * 512 * 128;
        const bool smp = isctx || sample;
        const int nk = smp ? NKS : T_P, key0 = (isctx ? T_S + t0 : t0) + 4 * g;
        bf16* Kbase = smp ? p->KBS + (size_t)(b * 4) * NKS * 96 : p->KBP + (size_t)(b * 4) * T_P * 96;
        bf16* Vbase = smp ? p->VTS + (size_t)(b * 4) * 64 * NKS : p->VTP + (size_t)(b * 4) * 64 * T_P;
        f32x4 c[8];
#pragma unroll
        for (int tile = 0; tile < 8; ++tile) { c[tile] = (f32x4){0.f, 0.f, 0.f, 0.f};
            const bf16* wr = Wkv + (size_t)(h * 128 + 16 * tile + tq) * 128 + 8 * g;
#pragma unroll
            for (int s = 0; s < 4; ++s) c[tile] = __builtin_amdgcn_mfma_f32_16x16x32_bf16(akv[s], *(const bf16x8*)(wr + 32 * s), c[tile], 0, 0, 0); }
#pragma unroll
        for (int i = 0; i < 4; ++i) {
            float ss = kr[0][i] * kr[0][i] + kr[1][i] * kr[1][i];
#pragma unroll
            for (int tile = 0; tile < 4; ++tile) ss += c[tile][i] * c[tile][i];
            ss = red16(ss, lane);
            const float rstd = 1.0f / sqrtf(ss * (1.0f / 96.f) + RMS_EPS);
            float v[6];
#pragma unroll
            for (int tile = 0; tile < 4; ++tile) v[tile] = c[tile][i] * rstd * qn1[16 * tile + tq];
            v[4] = kr[0][i] * rstd * qn1[64 + tq]; v[5] = kr[1][i] * rstd * qn1[80 + tq];
            if (rope) { const float x1 = v[4], x2 = v[5]; v[4] = x1 * cs[i] - x2 * sn[i]; v[5] = x2 * cs[i] + x1 * sn[i]; }
            bf16* ko = Kbase + ((size_t)h * nk + key0 + i) * 96 + tq;
#pragma unroll
            for (int tile = 0; tile < 6; ++tile) ko[16 * tile] = (bf16)f2bf(v[tile]);
        }
#pragma unroll
        for (int tile = 4; tile < 8; ++tile) {
            u32x2 w; w.x = pk2(c[tile][0], c[tile][1]); w.y = pk2(c[tile][2], c[tile][3]);
            *(u32x2*)(Vbase + ((size_t)h * 64 + 16 * (tile - 4) + tq) * nk + key0) = w;
        }
    }
}

__device__ __forceinline__ void tok_wave(KP p, int l, int run, int kind, int cg, int lane) {
    asm volatile("" : "+v"(lane));
    const int r0 = run * 16;
    int ci, T, row0, t0, b; row_info(r0, ci, T, row0, t0, b);
    const bool first = (t0 == 0), last = (t0 + 16 == T);
    if (kind == 0) {
        const float* u = p->U + (size_t)r0 * INCP + GD_OFF + cg * 64 + lane;
        const float* cw = p->gdn_conv_w + (size_t)l * 3 * 768 + cg * 64 + lane;
        float uq[18], uk[18];
#pragma unroll
        for (int i = 0; i < 18; ++i) { const bool ok = !((i == 0 && first) || (i == 17 && last));
            uq[i] = ok ? u[(ptrdiff_t)(i - 1) * INCP] : 0.f; uk[i] = ok ? u[(ptrdiff_t)(i - 1) * INCP + 256] : 0.f; }
        const float q0 = cw[0], q1 = cw[768], q2 = cw[1536], k0 = cw[256], k1 = cw[768 + 256], k2 = cw[1536 + 256];
#pragma unroll
        for (int i = 0; i < 16; ++i) {
            const float vq = siluf_(q0 * uq[i] + q1 * uq[i + 1] + q2 * uq[i + 2]);
            const float vk = siluf_(k0 * uk[i] + k1 * uk[i + 1] + k2 * uk[i + 2]);
            const float sq = wave_sum(vq * vq, lane), sk = wave_sum(vk * vk, lane);
            p->GQ[(size_t)(r0 + i) * 256 + cg * 64 + lane] = vq * (1.0f / sqrtf(sq + 1e-6f)) * 0.125f;
            const float qn_ = vq * (1.0f / sqrtf(sq + 1e-6f)) * 0.125f, kn_ = vk * (1.0f / sqrtf(sk + 1e-6f));
            p->GK[(size_t)(r0 + i) * 256 + cg * 64 + lane] = kn_;
            p->GQB[(size_t)(r0 + i) * 256 + cg * 64 + lane] = (bf16)f2bf(qn_);
            p->GKB[(size_t)(r0 + i) * 256 + cg * 64 + lane] = (bf16)f2bf(kn_);
        }
    } else if (kind == 1) {
        const float* u = p->U + (size_t)r0 * INCP + GD_OFF + 512 + cg * 64 + lane;
        const float* cw = p->gdn_conv_w + (size_t)l * 3 * 768 + 512 + cg * 64 + lane;
        float uv[18];
#pragma unroll
        for (int i = 0; i < 18; ++i) { const bool ok = !((i == 0 && first) || (i == 17 && last)); uv[i] = ok ? u[(ptrdiff_t)(i - 1) * INCP] : 0.f; }
        const float w0 = cw[0], w1 = cw[768], w2 = cw[1536];
#pragma unroll
        for (int i = 0; i < 16; ++i) p->GV[(size_t)(r0 + i) * 256 + cg * 64 + lane] = siluf_(w0 * uv[i] + w1 * uv[i + 1] + w2 * uv[i + 2]);
        if (cg == 0 && lane < 8) {
            const float dtb = p->gdn_dt_bias[l * 8 + lane], na = -expf(p->gdn_a_log[l * 8 + lane]);
            float xa[16], xb[16];
#pragma unroll
            for (int i = 0; i < 16; ++i) { const float* ua = p->U + (size_t)(r0 + i) * INCP + GD_OFF + 1024 + lane; xa[i] = ua[0]; xb[i] = ua[8]; }
#pragma unroll
            for (int i = 0; i < 16; ++i) {
                const float x = xa[i] + dtb;
                const float sp = (x > 20.f) ? x : log1pf(expf(x));
                p->GA[(size_t)(r0 + i) * 8 + lane] = expf(na * sp);
                p->GLA[(size_t)(r0 + i) * 8 + lane] = na * sp;
                p->GBT[(size_t)(r0 + i) * 8 + lane] = sigmoidf_(xb[i]);
            }
        }
    } else if (kind == 2) {
        const int c = cg * 64 + lane;
        const float* u = p->U + (size_t)r0 * INCP + HY_OFF + c;
        const float* cw = p->hy_conv_w + (size_t)l * 3 * 768 + c;
        const float* cb = p->hy_conv_b + (size_t)l * 768 + c;
        float u0[18], u1[18], u2[18];
#pragma unroll
        for (int i = 0; i < 18; ++i) { const bool ok = !((i == 0 && first) || (i == 17 && last));
            u0[i] = ok ? u[(ptrdiff_t)(i - 1) * INCP] : 0.f; u1[i] = ok ? u[(ptrdiff_t)(i - 1) * INCP + 256] : 0.f; u2[i] = ok ? u[(ptrdiff_t)(i - 1) * INCP + 512] : 0.f; }
        const float a0 = cw[0], a1 = cw[768], a2 = cw[1536], b0 = cw[256], b1 = cw[768 + 256], b2 = cw[1536 + 256], c0 = cw[512], c1 = cw[768 + 512], c2 = cw[1536 + 512];
        const float ba = cb[0], bb = cb[256], bc = cb[512];
#pragma unroll
        for (int i = 0; i < 16; ++i) {
            const float x0 = a0 * u0[i] + a1 * u0[i + 1] + a2 * u0[i + 2] + ba;
            const float x1 = b0 * u1[i] + b1 * u1[i + 1] + b2 * u1[i + 2] + bb;
            const float vv = c0 * u2[i] + c1 * u2[i + 1] + c2 * u2[i + 2] + bc;
            p->X0[(size_t)(r0 + i) * 256 + c] = x0;
            p->Z[(size_t)(r0 + i) * 256 + c] = x1 * vv;
        }
    } else {
        const int c = cg * 64 + lane;
        const float* u = p->U + (size_t)r0 * INCP + HG_OFF + c;
        const float lb0 = p->LB[(l * 2 + 0) * 256 + c], lb1 = p->LB[(l * 2 + 1) * 256 + c];
        float q[16], zf[16], zb[16];
#pragma unroll
        for (int i = 0; i < 16; ++i) { q[i] = u[(size_t)i * INCP]; zf[i] = u[(size_t)i * INCP + 768]; zb[i] = u[(size_t)i * INCP + 1024]; }
#pragma unroll
        for (int i = 0; i < 16; ++i) {
            p->HQ[(size_t)(r0 + i) * 256 + c] = q[i] * 0.125f;
            p->HF[(size_t)(r0 + i) * 256 + c] = lb0 + (1.f - lb0) * sigmoidf_(zf[i]);
            p->HF[((size_t)M + r0 + i) * 256 + c] = lb1 + (1.f - lb1) * sigmoidf_(zb[i]);
        }
    }
}
__device__ __forceinline__ void ph_prep(KP p, int l) {
    const int tix = otid();
    const int lane = tix & 63, wv = tix >> 6;
    const int gw = wv * gridDim.x + blockIdx.x, NW = gridDim.x * 8;
    for (int it = gw; it < 3200 + 6144; it += NW) {
        if (it < 3072) mla_wave(p, l, it >> 3, it & 7, lane);
        else if (it < 3200) { const int j = it - 3072; mla_wave(p, l, 384 + (j >> 2), 4 + (j & 3), lane); }
        else { const int j = it - 3200; tok_wave(p, l, j >> 4, (j >> 2) & 3, j & 3, lane); }
    }
}

constexpr int NCS = 96, NITEM = NCS * 8;
constexpr int HCH = 32, NHCS = 192, NHITEM = NHCS * 8;
struct ChunkInfo { int seq, c, nch, T, row0; bool prompt; };
__device__ __forceinline__ ChunkInfo chunk_info(int cs) {
    ChunkInfo ci;
    if (cs < 64) { ci.seq = cs >> 2; ci.c = cs & 3; ci.nch = 4; ci.T = T_P; ci.row0 = ci.seq * T_P; ci.prompt = true; }
    else { const int j = cs - 64; ci.seq = 16 + (j >> 4); ci.c = j & 15; ci.nch = 16; ci.T = T_S; ci.row0 = M_P + (j >> 4) * T_S; ci.prompt = false; }
    return ci;
}
__device__ __forceinline__ int first_cs(int seq) { return seq < 16 ? seq * 4 : 64 + (seq - 16) * 16; }
__device__ __forceinline__ ChunkInfo hchunk_info(int cs) {
    ChunkInfo ci;
    if (cs < 128) { ci.seq = cs >> 3; ci.c = cs & 7; ci.nch = 8; ci.T = T_P; ci.row0 = ci.seq * T_P; ci.prompt = true; }
    else { const int j = cs - 128; ci.seq = 16 + (j >> 5); ci.c = j & 31; ci.nch = 32; ci.T = T_S; ci.row0 = M_P + (j >> 5) * T_S; ci.prompt = false; }
    return ci;
}
__device__ __forceinline__ int first_hcs(int seq) { return seq < 16 ? seq * 8 : 128 + (seq - 16) * 32; }

__device__ __forceinline__ void hgrn_passA(KP p, int item, int lane) {
    asm volatile("" : "+v"(lane));
    const int cs = item >> 3, dir = (item >> 2) & 1, h = item & 3;
    const ChunkInfo ci = hchunk_info(cs);
    float S[64];
#pragma unroll
    for (int v = 0; v < 64; ++v) S[v] = 0.f;
    float suf = 1.f;
    for (int s = HCH - 1; s >= 0; --s) {
        const int g = ci.c * HCH + s, t = dir ? ci.T - 1 - g : g;
        const size_t r = (size_t)(ci.row0 + t);
        const float f = p->HF[((size_t)dir * M + r) * 256 + h * 64 + lane];
        const float vv = p->U[r * INCP + HG_OFF + 256 + h * 64 + lane];
        const float w = (1.f - f) * suf;
#pragma unroll
        for (int v = 0; v < 64; ++v) S[v] += w * bcast(vv, v);
        suf *= f;
    }
    p->HD[(size_t)item * 64 + lane] = suf;
    f32x4* so = (f32x4*)(p->HS + (size_t)item * 4096 + lane * 64);
#pragma unroll
    for (int v = 0; v < 16; ++v) so[v] = (f32x4){S[4 * v], S[4 * v + 1], S[4 * v + 2], S[4 * v + 3]};
}
__device__ __forceinline__ void gdn_passA(KP p, int item, int half, int lane) {
    const int cs = item >> 3, dir = (item >> 2) & 1, h = item & 3;
    const ChunkInfo ci = chunk_info(cs);
    float S[64];
#pragma unroll
    for (int k = 0; k < 64; ++k) S[k] = (half && k == lane) ? 1.f : 0.f;
    for (int s = 0; s < 64; ++s) {
        const int g = ci.c * 64 + s, t = dir ? ci.T - 1 - g : g;
        const size_t r = (size_t)(ci.row0 + t);
        const float kv = p->GK[r * 256 + h * 64 + lane];
        const float vi = half ? 0.f : p->GV[r * 256 + h * 64 + lane];
        const float a = p->GA[r * 8 + dir * 4 + h], beta = p->GBT[r * 8 + dir * 4 + h];
        float kS = 0.f;
#pragma unroll
        for (int k = 0; k < 64; ++k) kS += bcast(kv, k) * S[k];
        const float cc = beta * (vi - a * kS);
#pragma unroll
        for (int k = 0; k < 64; ++k) S[k] = a * S[k] + bcast(kv, k) * cc;
    }
    float* so = (half ? p->GP : p->GS) + (size_t)item * 4096 + lane;
#pragma unroll
    for (int k = 0; k < 64; ++k) so[k * 64] = S[k];
}
template <int K0, int N, class F> __device__ __forceinline__ void sfor(F&& f) { if constexpr (K0 < N) { f(std::integral_constant<int, K0>{}); sfor<K0 + 1, N>(f); } }
__device__ __forceinline__ float perm_f(float v, int srclane) { return __builtin_bit_cast(float, __builtin_amdgcn_ds_bpermute(srclane << 2, __builtin_bit_cast(int, v))); }
__device__ __forceinline__ float rdl(float v, int k) { return __builtin_bit_cast(float, __builtin_amdgcn_readlane(__builtin_bit_cast(int, v), k)); }
__device__ __forceinline__ int gdn_row(const ChunkInfo& ci, int dir, int i) { const int g = ci.c * 64 + i; return ci.row0 + (dir ? ci.T - 1 - g : g); }

__device__ __forceinline__ void gdnL_wave(KP p, int item, int which, int lane, LAS float* lm  ) {
    asm volatile("" : "+v"(lane));
    const int cs = item >> 3, dir = (item >> 2) & 1, h = item & 3;
    const ChunkInfo ci = chunk_info(cs);
    const int tq = lane & 15, g = lane >> 4;
    const int rl = gdn_row(ci, dir, lane);
    float G = p->GLA[(size_t)rl * 8 + dir * 4 + h];
    const float beta = p->GBT[(size_t)rl * 8 + dir * 4 + h];
#pragma unroll
    for (int o = 1; o < 64; o <<= 1) { const float t = perm_f(G, lane >= o ? lane - o : lane); if (lane >= o) G += t; }
    const float Glast = rdl(G, 63);
    const float eG = __expf(G);
    {
        bf16x8 kf[4][2], qf[4][2];
#pragma unroll
        for (int tt = 0; tt < 4; ++tt) { const size_t r = (size_t)gdn_row(ci, dir, 16 * tt + tq);
#pragma unroll
            for (int s = 0; s < 2; ++s) { kf[tt][s] = *(const bf16x8*)(p->GKB + r * 256 + h * 64 + 32 * s + 8 * g); qf[tt][s] = *(const bf16x8*)(p->GQB + r * 256 + h * 64 + 32 * s + 8 * g); } }
        bf16* att = p->ATT + (size_t)item * 4096;
#pragma unroll
        for (int rt = 0; rt < 4; ++rt)
#pragma unroll
            for (int ct = 0; ct <= rt; ++ct) {
                f32x4 kk = (f32x4){0.f, 0.f, 0.f, 0.f}, qk = (f32x4){0.f, 0.f, 0.f, 0.f};
#pragma unroll
                for (int s = 0; s < 2; ++s) { kk = __builtin_amdgcn_mfma_f32_16x16x32_bf16(kf[rt][s], kf[ct][s], kk, 0, 0, 0); qk = __builtin_amdgcn_mfma_f32_16x16x32_bf16(qf[rt][s], kf[ct][s], qk, 0, 0, 0); }
                const int j = 16 * ct + tq; const float Gj = perm_f(G, j);
#pragma unroll
                for (int r = 0; r < 4; ++r) { const int i = 16 * rt + 4 * g + r;
                    const float Gi = perm_f(G, i), bi = perm_f(beta, i);
                    const float dec = (j <= i) ? __expf(Gi - Gj) : 0.f;
                    lm[i * 64 + j] = (j < i) ? bi * kk[r] * dec : 0.f;
                    if (which == 0) att[i * 64 + j] = (bf16)f2bf(qk[r] * dec); }
            }
    }
    asm volatile("s_waitcnt lgkmcnt(0)" ::: "memory");
    {
        float X[64];
        const float* src = (which ? p->GK : p->GV) + h * 64 + lane;
        const float sc = which ? eG : 1.0f;
        const float bsc = beta * sc;
        sfor<0, 64>([&](auto ic) { constexpr int I = decltype(ic)::value; X[I] = rdl(bsc, I) * src[(size_t)gdn_row(ci, dir, I) * 256]; });
        sfor<1, 64>([&](auto ic) { constexpr int I = decltype(ic)::value;
            float a = X[I];
            sfor<0, (I + 3) / 4>([&](auto mc) { constexpr int M4 = decltype(mc)::value;
                const f32x4 l4 = *(const LAS f32x4*)(lm + I * 64 + 4 * M4);
                if constexpr (4 * M4 + 0 < I) a -= l4[0] * X[4 * M4 + 0];
                if constexpr (4 * M4 + 1 < I) a -= l4[1] * X[4 * M4 + 1];
                if constexpr (4 * M4 + 2 < I) a -= l4[2] * X[4 * M4 + 2];
                if constexpr (4 * M4 + 3 < I) a -= l4[3] * X[4 * M4 + 3]; });
            X[I] = a; });
        if (which == 0) { float* ub = p->UB + (size_t)item * 4096 + lane;
            sfor<0, 64>([&](auto ic) { constexpr int I = decltype(ic)::value; ub[I * 64] = X[I]; }); }
        else { bf16* wn = p->WN + (size_t)item * 4096 + lane;
            sfor<0, 64>([&](auto ic) { constexpr int I = decltype(ic)::value; wn[I * 64] = (bf16)f2bf(-X[I]); }); }
    }
    {
        bf16* qg = p->QG + (size_t)item * 4096 + lane;
        LAS bf16* kt = (LAS bf16*)lm;
        const float eo = __expf(Glast - G);
        if (which == 0) {
#pragma unroll 1
            for (int ib = 0; ib < 64; ib += 16) {
                float gq[16];
#pragma unroll
                for (int i = 0; i < 16; ++i) { const size_t r = (size_t)gdn_row(ci, dir, ib + i); gq[i] = p->GQ[r * 256 + h * 64 + lane]; }
#pragma unroll
                for (int i = 0; i < 16; ++i) qg[(ib + i) * 64] = (bf16)f2bf(gq[i] * rdl(eG, ib + i));
            }
        } else {
#pragma unroll 1
            for (int ib = 0; ib < 64; ib += 16) {
                float gk[16];
#pragma unroll
                for (int i = 0; i < 16; ++i) { const size_t r = (size_t)gdn_row(ci, dir, ib + i); gk[i] = p->GK[r * 256 + h * 64 + lane]; }
#pragma unroll
                for (int i = 0; i < 16; ++i) kt[lane * 64 + ib + i] = (bf16)f2bf(gk[i] * rdl(eo, ib + i));
            }
            asm volatile("s_waitcnt lgkmcnt(0)" ::: "memory");
            u32x4* ko = (u32x4*)(p->KOT + (size_t)item * 4096);
#pragma unroll
            for (int it = 0; it < 8; ++it) ko[it * 64 + lane] = ((const LAS u32x4*)lm)[it * 64 + lane];
            if (lane == 0) p->EGL[item] = __expf(Glast);
        }
        asm volatile("s_waitcnt lgkmcnt(0)" ::: "memory");
    }
}

__device__ __forceinline__ bf16x8 frag2(const bf16* p0) {
    const bf16x4 a = *(const bf16x4*)p0, b = *(const bf16x4*)(p0 + 16);
    bf16x8 f; f[0] = a[0]; f[1] = a[1]; f[2] = a[2]; f[3] = a[3]; f[4] = b[0]; f[5] = b[1]; f[6] = b[2]; f[7] = b[3]; return f;
}
__device__ __forceinline__ bf16x8 packC(const f32x4& t0, const f32x4& t1) { const float v[8] = {t0[0], t0[1], t0[2], t0[3], t1[0], t1[1], t1[2], t1[3]}; return pack8(v); }

struct GdnS1 { bf16x8 w[8]; f32x4 u[4]; };
__device__ __forceinline__ bf16x8 frag2o(const bf16* base  , int off) {
    const bf16x4 a = *(const bf16x4*)(base + off), b = *(const bf16x4*)(base + off + 16);
    bf16x8 f; f[0] = a[0]; f[1] = a[1]; f[2] = a[2]; f[3] = a[3]; f[4] = b[0]; f[5] = b[1]; f[6] = b[2]; f[7] = b[3]; return f;
}
__device__ __forceinline__ void gdnS_load1(GdnS1& o, KP p, size_t item, int lo, int uo) {
    const bf16* Wn = p->WN + item * 4096;
    const float* Ub = p->UB + item * 4096;
#pragma unroll
    for (int jt = 0; jt < 4; ++jt) { o.w[2 * jt] = frag2o(Wn, lo + (16 * jt) * 64); o.w[2 * jt + 1] = frag2o(Wn, lo + (16 * jt) * 64 + 32);
#pragma unroll
        for (int r = 0; r < 4; ++r) o.u[jt][r] = Ub[uo + (16 * jt + r) * 64]; }
}
__device__ __forceinline__ void gdnS_wave(KP p, int l, int sdh, int ct, int lane) {
    asm volatile("" : "+v"(lane));
    const int tq = lane & 15, g = lane >> 4;
    const int lo = tq * 64 + 4 * g, uo = (4 * g) * 64 + 16 * ct + tq;
    const int seq = sdh >> 3, dir = (sdh >> 2) & 1, h = sdh & 3;
    const bool prompt = seq < 16; const int nch = prompt ? 4 : 16, cs0 = first_cs(seq);
    f32x4 s[4];
    {
        const float* s0 = p->state_gdn + ((size_t)(((prompt ? 0 : seq - 16) * DEPTH + l) * 2 + dir) * 4 + h) * 4096 + 16 * ct + tq;
#pragma unroll
        for (int rt = 0; rt < 4; ++rt)
#pragma unroll
            for (int r = 0; r < 4; ++r) s[rt][r] = prompt ? 0.f : s0[(16 * rt + 4 * g + r) * 64];
    }
    for (int c = 0; c < nch; ++c) {
        const int cs = cs0 + c; const size_t item = (size_t)(cs * 2 + dir) * 4 + h;
        const ChunkInfo ci = chunk_info(cs);
        GdnS1 cur;
        gdnS_load1(cur, p, item, lo, uo);
        const bf16* Qg = p->QG + item * 4096;
        const bf16* At = p->ATT + item * 4096;
        const bf16* Kt = p->KOT + item * 4096;
        bf16x8 qf[8], af[6], kf[8];
#pragma unroll
        for (int it = 0; it < 4; ++it) { qf[2 * it] = frag2o(Qg, lo + (16 * it) * 64); qf[2 * it + 1] = frag2o(Qg, lo + (16 * it) * 64 + 32); }
        af[0] = frag2o(At, lo + (16 * 0) * 64); af[1] = frag2o(At, lo + (16 * 1) * 64);
        af[2] = frag2o(At, lo + (16 * 2) * 64); af[3] = frag2o(At, lo + (16 * 2) * 64 + 32);
        af[4] = frag2o(At, lo + (16 * 3) * 64); af[5] = frag2o(At, lo + (16 * 3) * 64 + 32);
        const float egl = p->EGL[item];
        const bf16x8 bS0 = packC(s[0], s[1]), bS1 = packC(s[2], s[3]);
        f32x4 vn[4];
#pragma unroll
        for (int jt = 0; jt < 4; ++jt) {
            vn[jt] = __builtin_amdgcn_mfma_f32_16x16x32_bf16(cur.w[2 * jt], bS0, cur.u[jt], 0, 0, 0);
            vn[jt] = __builtin_amdgcn_mfma_f32_16x16x32_bf16(cur.w[2 * jt + 1], bS1, vn[jt], 0, 0, 0);
        }
#pragma unroll
        for (int it = 0; it < 4; ++it) { kf[2 * it] = frag2o(Kt, lo + (16 * it) * 64); kf[2 * it + 1] = frag2o(Kt, lo + (16 * it) * 64 + 32); }
        const bf16x8 bV0 = packC(vn[0], vn[1]), bV1 = packC(vn[2], vn[3]);
        af[0][4] = 0; af[0][5] = 0; af[0][6] = 0; af[0][7] = 0;
        af[3][4] = 0; af[3][5] = 0; af[3][6] = 0; af[3][7] = 0;
        f32x4 o[4];
#pragma unroll
        for (int it = 0; it < 4; ++it) {
            o[it] = __builtin_amdgcn_mfma_f32_16x16x32_bf16(qf[2 * it], bS0, (f32x4){0.f, 0.f, 0.f, 0.f}, 0, 0, 0);
            o[it] = __builtin_amdgcn_mfma_f32_16x16x32_bf16(qf[2 * it + 1], bS1, o[it], 0, 0, 0);
        }
        o[0] = __builtin_amdgcn_mfma_f32_16x16x32_bf16(af[0], bV0, o[0], 0, 0, 0);
        o[1] = __builtin_amdgcn_mfma_f32_16x16x32_bf16(af[1], bV0, o[1], 0, 0, 0);
        o[2] = __builtin_amdgcn_mfma_f32_16x16x32_bf16(af[2], bV0, o[2], 0, 0, 0);
        o[2] = __builtin_amdgcn_mfma_f32_16x16x32_bf16(af[3], bV1, o[2], 0, 0, 0);
        o[3] = __builtin_amdgcn_mfma_f32_16x16x32_bf16(af[4], bV0, o[3], 0, 0, 0);
        o[3] = __builtin_amdgcn_mfma_f32_16x16x32_bf16(af[5], bV1, o[3], 0, 0, 0);
        if (c + 1 < nch || prompt) {
#pragma unroll
            for (int dt = 0; dt < 4; ++dt) {
                f32x4 a = s[dt] * egl;
                a = __builtin_amdgcn_mfma_f32_16x16x32_bf16(kf[2 * dt], bV0, a, 0, 0, 0);
                a = __builtin_amdgcn_mfma_f32_16x16x32_bf16(kf[2 * dt + 1], bV1, a, 0, 0, 0);
                s[dt] = a;
            }
        }
#pragma unroll
        for (int it = 0; it < 4; ++it)
#pragma unroll
            for (int r = 0; r < 4; ++r) { const size_t row = (size_t)gdn_row(ci, dir, 16 * it + 4 * g + r);
                p->OG[((size_t)dir * M + row) * 256 + h * 64 + 16 * ct + tq] = o[it][r]; }
    }
    if (prompt) {
        float* so = p->o_sgd + ((size_t)((seq * DEPTH + l) * 2 + dir) * 4 + h) * 4096 + 16 * ct + tq;
#pragma unroll
        for (int rt = 0; rt < 4; ++rt)
#pragma unroll
            for (int r = 0; r < 4; ++r) so[(16 * rt + 4 * g + r) * 64] = s[rt][r];
    }
}

__device__ __forceinline__ void ph_scanA(KP p, LAS unsigned char* lds) {
    const int tix = otid();
    const int lane = tix & 63, wv = tix >> 6;
    LAS float* lm = (LAS float*)(lds + wv * 16384);
    const int gw = wv * gridDim.x + blockIdx.x;
    const int NW = gridDim.x * 8, NIT = 2 * NITEM + NHITEM;
#pragma unroll 1
    for (int rnd = 0, it = gw; it < NIT; ++rnd) {
        if (it < 2 * NITEM) gdnL_wave(p, it >> 1, it & 1, lane, lm);
        else hgrn_passA(p, it - 2 * NITEM, lane);
        it = (rnd == 0) ? NW + (NW - 1 - gw) : it + NW;
    }
}

template <int NCH>
__device__ __forceinline__ float hgrn_passB_elem(KP p, int cs0, int dir, int h, int k, int kvx, float s) {
    float loc[NCH], dd[NCH];
#pragma unroll
    for (int c = 0; c < NCH; ++c) { const size_t item = (size_t)((cs0 + c) * 2 + dir) * 4 + h; loc[c] = p->HS[item * 4096 + kvx]; dd[c] = p->HD[item * 64 + k]; }
#pragma unroll
    for (int c = 0; c < NCH; ++c) { const size_t item = (size_t)((cs0 + c) * 2 + dir) * 4 + h; p->HS2[item * 4096 + kvx] = s; s = dd[c] * s + loc[c]; }
    return s;
}
__device__ __forceinline__ void hgrn_passB(KP p, int l, int gt, int gn) {
    for (int e = gt; e < 18 * 8 * 4096; e += gn) {
        const int sdh = e >> 12, kvx = e & 4095, k = kvx >> 6;
        const int seq = sdh >> 3, dir = (sdh >> 2) & 1, h = sdh & 3;
        if (seq < 16) {
            const float s = hgrn_passB_elem<8>(p, first_hcs(seq), dir, h, k, kvx, 0.f);
            p->o_shg[((size_t)((seq * DEPTH + l) * 2 + dir) * 4 + h) * 4096 + kvx] = s;
        } else {
            const float s0 = p->state_hgrn[((size_t)(((seq - 16) * DEPTH + l) * 2 + dir) * 4 + h) * 4096 + kvx];
            (void)hgrn_passB_elem<32>(p, first_hcs(seq), dir, h, k, kvx, s0);
        }
    }
}
__device__ __forceinline__ void split8(const float (&x)[8], bf16x8& hi, bf16x8& lo) {
    float h[8], r[8];
#pragma unroll
    for (int j = 0; j < 8; ++j) { h[j] = __builtin_bit_cast(float, f2bf(x[j]) << 16); r[j] = x[j] - h[j]; }
    hi = pack8(h); lo = pack8(r);
}
__device__ __forceinline__ void gdn_passB_wave(KP p, int l, int sdh, int ct, int lane) {
    const int tq = lane & 15, g = lane >> 4;
    const int seq = sdh >> 3, dir = (sdh >> 2) & 1, h = sdh & 3;
    const bool prompt = seq < 16; const int nch = prompt ? 4 : 16, cs0 = first_cs(seq);
    f32x4 s[4];
    {
        const float* s0 = p->state_gdn + ((size_t)(((prompt ? 0 : seq - 16) * DEPTH + l) * 2 + dir) * 4 + h) * 4096 + 16 * ct + tq;
#pragma unroll
        for (int rt = 0; rt < 4; ++rt)
#pragma unroll
            for (int r = 0; r < 4; ++r) s[rt][r] = prompt ? 0.f : s0[(16 * rt + 4 * g + r) * 64];
    }
    for (int c = 0; c < nch; ++c) {
        const size_t item = (size_t)((cs0 + c) * 2 + dir) * 4 + h;
        const float* Ls = p->GS + item * 4096 + 16 * ct + tq;
        float* Ss = p->GS2 + item * 4096 + 16 * ct + tq;
        const float* Pm = p->GP + item * 4096;
        const bool need = (c + 1 < nch) || prompt;
        f32x4 acc[4];
#pragma unroll
        for (int rt = 0; rt < 4; ++rt)
#pragma unroll
            for (int r = 0; r < 4; ++r) { const int row = 16 * rt + 4 * g + r; acc[rt][r] = Ls[row * 64]; Ss[row * 64] = s[rt][r]; }
        if (need) {
            bf16x8 bh[2], bl[2];
#pragma unroll
            for (int ks = 0; ks < 2; ++ks) { const float x[8] = {s[2 * ks][0], s[2 * ks][1], s[2 * ks][2], s[2 * ks][3], s[2 * ks + 1][0], s[2 * ks + 1][1], s[2 * ks + 1][2], s[2 * ks + 1][3]};
                split8(x, bh[ks], bl[ks]); }
#pragma unroll
            for (int rt = 0; rt < 4; ++rt)
#pragma unroll
                for (int ks = 0; ks < 2; ++ks) {
                    const float* pr = Pm + (16 * rt + tq) * 64 + 32 * ks + 4 * g;
                    const f32x4 a0 = *(const f32x4*)pr, a1 = *(const f32x4*)(pr + 16);
                    const float x[8] = {a0[0], a0[1], a0[2], a0[3], a1[0], a1[1], a1[2], a1[3]};
                    bf16x8 ah, al; split8(x, ah, al);
                    acc[rt] = __builtin_amdgcn_mfma_f32_16x16x32_bf16(ah, bh[ks], acc[rt], 0, 0, 0);
                    acc[rt] = __builtin_amdgcn_mfma_f32_16x16x32_bf16(ah, bl[ks], acc[rt], 0, 0, 0);
                    acc[rt] = __builtin_amdgcn_mfma_f32_16x16x32_bf16(al, bh[ks], acc[rt], 0, 0, 0);
                }
#pragma unroll
            for (int rt = 0; rt < 4; ++rt) s[rt] = acc[rt];
        }
    }
    if (prompt) {
        float* so = p->o_sgd + ((size_t)((seq * DEPTH + l) * 2 + dir) * 4 + h) * 4096 + 16 * ct + tq;
#pragma unroll
        for (int rt = 0; rt < 4; ++rt)
#pragma unroll
            for (int r = 0; r < 4; ++r) so[(16 * rt + 4 * g + r) * 64] = s[rt][r];
    }
}

__device__ __forceinline__ void hgrn_passC(KP p, int item, int lane) {
    asm volatile("" : "+v"(lane));
    const int cs = item >> 3, dir = (item >> 2) & 1, h = item & 3;
    const ChunkInfo ci = hchunk_info(cs);
    float S[64];
    {
        const float* s0 = p->HS2 + (size_t)item * 4096 + lane;
#pragma unroll
        for (int k = 0; k < 64; ++k) S[k] = s0[k * 64];
    }
    auto rowof = [&](int s) { const int g = ci.c * HCH + s; return (size_t)(ci.row0 + (dir ? ci.T - 1 - g : g)); };
    size_t r = rowof(0);
    float fv = p->HF[((size_t)dir * M + r) * 256 + h * 64 + lane], qv = p->HQ[r * 256 + h * 64 + lane], vi = p->U[r * INCP + HG_OFF + 256 + h * 64 + lane];
    for (int s = 0; s < HCH; ++s) {
        const size_t rn = rowof(s + 1 < HCH ? s + 1 : s);
        const float fn = p->HF[((size_t)dir * M + rn) * 256 + h * 64 + lane], qn = p->HQ[rn * 256 + h * 64 + lane], vn = p->U[rn * INCP + HG_OFF + 256 + h * 64 + lane];
        float o = 0.f;
#pragma unroll
        for (int k = 0; k < 64; ++k) {
            const float fk = bcast(fv, k);
            S[k] = fk * (S[k] - vi) + vi;
            o += bcast(qv, k) * S[k];
        }
        p->OH[((size_t)dir * M + r) * 256 + h * 64 + lane] = o;
        r = rn; fv = fn; qv = qn; vi = vn;
    }
}
__device__ __forceinline__ void gdn_passC(KP p, int item, int lane) {
    const int cs = item >> 3, dir = (item >> 2) & 1, h = item & 3;
    const ChunkInfo ci = chunk_info(cs);
    float S[64];
    {
        const float* s0 = p->GS2 + (size_t)item * 4096 + lane;
#pragma unroll
        for (int k = 0; k < 64; ++k) S[k] = s0[k * 64];
    }
    for (int s = 0; s < 64; ++s) {
        const int g = ci.c * 64 + s, t = dir ? ci.T - 1 - g : g;
        const size_t r = (size_t)(ci.row0 + t);
        const float qv = p->GQ[r * 256 + h * 64 + lane], kv = p->GK[r * 256 + h * 64 + lane], vi = p->GV[r * 256 + h * 64 + lane];
        const float a = p->GA[r * 8 + dir * 4 + h], beta = p->GBT[r * 8 + dir * 4 + h];
        float kS = 0.f;
#pragma unroll
        for (int k = 0; k < 64; ++k) kS += bcast(kv, k) * S[k];
        const float cc = beta * (vi - a * kS);
        float o = 0.f;
#pragma unroll
        for (int k = 0; k < 64; ++k) { S[k] = a * S[k] + bcast(kv, k) * cc; o += bcast(qv, k) * S[k]; }
        p->OG[((size_t)dir * M + r) * 256 + h * 64 + lane] = o;
    }
}
__device__ __forceinline__ void ph_scanC(KP p) {
    const int tix = otid();
    const int lane = tix & 63, wv = tix >> 6;
    for (int it = wv * gridDim.x + blockIdx.x; it < NHITEM; it += gridDim.x * 8) hgrn_passC(p, it, lane);
}

struct KVFrag { bf16x8 k[2][3]; bf16x4 v[4][2]; };
__device__ __forceinline__ void attn_load(KVFrag& f, const bf16* Kb, const bf16* Vt, int nk, int k0, int q, int g) {
#pragma unroll
    for (int tt = 0; tt < 2; ++tt)
#pragma unroll
        for (int s = 0; s < 3; ++s) f.k[tt][s] = *(const bf16x8*)(Kb + (size_t)(k0 + 16 * tt + q) * 96 + 32 * s + 8 * g);
#pragma unroll
    for (int vt = 0; vt < 4; ++vt)
#pragma unroll
        for (int tt = 0; tt < 2; ++tt) f.v[vt][tt] = *(const bf16x4*)(Vt + (size_t)(16 * vt + q) * nk + k0 + 16 * tt + 4 * g);
}
__device__ __forceinline__ void attn_wave(KP p, int item, int lane) {
    asm volatile("" : "+v"(lane));
    int seq, h, qb, nk, r0; const bf16 *Kb, *Vt;
    if (item < 1024) { seq = item >> 6; h = (item >> 4) & 3; qb = item & 15; nk = T_P; r0 = seq * T_P + qb * 16;
        Kb = p->KBP + (size_t)(seq * 4 + h) * T_P * 96; Vt = p->VTP + (size_t)(seq * 4 + h) * 64 * T_P; }
    else { const int j = item - 1024; seq = j >> 8; h = (j >> 6) & 3; qb = j & 63; nk = NKS; r0 = M_P + seq * T_S + qb * 16;
        Kb = p->KBS + (size_t)(seq * 4 + h) * NKS * 96; Vt = p->VTS + (size_t)(seq * 4 + h) * 64 * NKS; }
    const int q = lane & 15, g = lane >> 4;
    bf16x8 qf[3];
#pragma unroll
    for (int s = 0; s < 3; ++s) qf[s] = *(const bf16x8*)(p->QB + (size_t)(r0 + q) * 384 + h * 96 + 32 * s + 8 * g);
    f32x4 o[4];
#pragma unroll
    for (int vt = 0; vt < 4; ++vt) o[vt] = (f32x4){0.f, 0.f, 0.f, 0.f};
    float m = -1e30f, lsum = 0.f;
    const int nblk = nk >> 5;
    KVFrag cur, nxt;
    attn_load(cur, Kb, Vt, nk, 0, q, g);
    for (int kb = 0; kb < nblk; ++kb) {
        const int kn = (kb + 1 < nblk) ? kb + 1 : kb;
        attn_load(nxt, Kb, Vt, nk, kn * 32, q, g);
        f32x4 s0 = (f32x4){0.f, 0.f, 0.f, 0.f}, s1 = (f32x4){0.f, 0.f, 0.f, 0.f};
#pragma unroll
        for (int s = 0; s < 3; ++s) { s0 = __builtin_amdgcn_mfma_f32_16x16x32_bf16(cur.k[0][s], qf[s], s0, 0, 0, 0); s1 = __builtin_amdgcn_mfma_f32_16x16x32_bf16(cur.k[1][s], qf[s], s1, 0, 0, 0); }
        float ml = fmaxf(fmaxf(fmaxf(s0[0], s0[1]), fmaxf(s0[2], s0[3])), fmaxf(fmaxf(s1[0], s1[1]), fmaxf(s1[2], s1[3])));
        ml = fmaxf(ml, __builtin_bit_cast(float, __builtin_amdgcn_ds_bpermute((lane ^ 16) << 2, __builtin_bit_cast(int, ml))));
        ml = fmaxf(ml, __builtin_bit_cast(float, __builtin_amdgcn_ds_bpermute((lane ^ 32) << 2, __builtin_bit_cast(int, ml))));
        const float mn = fmaxf(m, ml);
        const float corr = __expf(m - mn);
        float pv[8];
#pragma unroll
        for (int i = 0; i < 4; ++i) { pv[i] = __expf(s0[i] - mn); pv[4 + i] = __expf(s1[i] - mn); }
        lsum = lsum * corr + ((pv[0] + pv[1]) + (pv[2] + pv[3])) + ((pv[4] + pv[5]) + (pv[6] + pv[7]));
        m = mn;
        u32x4 pw; pw.x = pg8::cvt_pk_bf16(pv[0], pv[1]); pw.y = pg8::cvt_pk_bf16(pv[2], pv[3]); pw.z = pg8::cvt_pk_bf16(pv[4], pv[5]); pw.w = pg8::cvt_pk_bf16(pv[6], pv[7]);
        const bf16x8 pf = __builtin_bit_cast(bf16x8, pw);
#pragma unroll
        for (int vt = 0; vt < 4; ++vt) {
            bf16x8 af;
            af[0] = cur.v[vt][0][0]; af[1] = cur.v[vt][0][1]; af[2] = cur.v[vt][0][2]; af[3] = cur.v[vt][0][3];
            af[4] = cur.v[vt][1][0]; af[5] = cur.v[vt][1][1]; af[6] = cur.v[vt][1][2]; af[7] = cur.v[vt][1][3];
            o[vt] = __builtin_amdgcn_mfma_f32_16x16x32_bf16(af, pf, o[vt] * corr, 0, 0, 0);
        }
        cur = nxt;
    }
    lsum += __builtin_bit_cast(float, __builtin_amdgcn_ds_bpermute((lane ^ 16) << 2, __builtin_bit_cast(int, lsum)));
    lsum += __builtin_bit_cast(float, __builtin_amdgcn_ds_bpermute((lane ^ 32) << 2, __builtin_bit_cast(int, lsum)));
    const float inv = 1.0f / lsum;
    bf16* orow = p->OCAT + (size_t)(r0 + q) * D + 512 + h * 64 + 4 * g;
#pragma unroll
    for (int vt = 0; vt < 4; ++vt) { u32x2 w; w.x = pk2(o[vt][0] * inv, o[vt][1] * inv); w.y = pk2(o[vt][2] * inv, o[vt][3] * inv); *(u32x2*)(orow + 16 * vt) = w; }
}

__device__ __forceinline__ void hyena_wave(KP p, int l, int item, int lane) {
    asm volatile("" : "+v"(lane));
    int seq, tb, cw, T, row0, set;
    if (item < 1024) { seq = item >> 6; tb = (item >> 2) & 15; cw = item & 3; T = T_P; row0 = seq * T_P; set = 0; }
    else { const int j = item - 1024; seq = j >> 8; tb = (j >> 2) & 63; cw = j & 3; T = T_S; row0 = M_P + seq * T_S; set = 1; }
    const int c = cw * 64 + lane, t0 = tb * 16;
    const float* G = p->FILT + (size_t)l * FILT_L + (set ? (size_t)2 * 256 * 256 : 0) + c;
    const float* Zp = p->Z + (size_t)row0 * 256 + c;
    float acc[16];
#pragma unroll
    for (int i = 0; i < 16; ++i) acc[i] = 0.f;
    float tap[31], z[16];
    {
        const float* gp = G + (size_t)(t0 - 15 + T) * 256;
#pragma unroll
        for (int i = 0; i < 31; ++i) tap[i] = gp[(size_t)i * 256];
#pragma unroll
        for (int j = 0; j < 16; ++j) z[j] = Zp[(size_t)j * 256];
    }
    for (int s0 = 0; s0 < T; s0 += 16) {
        const int sn = (s0 + 16 < T) ? s0 + 16 : s0;
        float tapn[31], zn[16];
        const float* gp = G + (size_t)(t0 - sn - 15 + T) * 256;
#pragma unroll
        for (int i = 0; i < 31; ++i) tapn[i] = gp[(size_t)i * 256];
#pragma unroll
        for (int j = 0; j < 16; ++j) zn[j] = Zp[(size_t)(sn + j) * 256];
#pragma unroll
        for (int i = 0; i < 16; ++i)
#pragma unroll
            for (int j = 0; j < 16; ++j) acc[i] += tap[i - j + 15] * z[j];
#pragma unroll
        for (int i = 0; i < 31; ++i) tap[i] = tapn[i];
#pragma unroll
        for (int j = 0; j < 16; ++j) z[j] = zn[j];
    }
    const float skip = p->hy_skip[l * 256 + c];
#pragma unroll
    for (int i = 0; i < 16; ++i) {
        const size_t r = (size_t)(row0 + t0 + i);
        const float zz = p->Z[r * 256 + c];
        p->OCAT[r * D + 256 + c] = (bf16)f2bf(p->X0[r * 256 + c] * (acc[i] + zz * skip));
    }
}

__device__ __forceinline__ void ph_mixB(KP p, int l) {
    const int tix = otid();
    const int lane = tix & 63, wv = tix >> 6;
    hgrn_passB(p, l, blockIdx.x * NTHREADS + tix, gridDim.x * NTHREADS);
    const int gw = wv * gridDim.x + blockIdx.x;
    for (int it = gw; it < 576 + 3072; it += gridDim.x * 8) {
        if (it < 64) gdnS_wave(p, l, 128 + (it >> 2), it & 3, lane);
        else if (it < 576) gdnS_wave(p, l, (it - 64) >> 2, it & 3, lane);
        else { const int j = it - 576;
            if (j < 512) attn_wave(p, 1024 + j, lane);
            else if (j < 1024) { __builtin_amdgcn_s_setprio(2); hyena_wave(p, l, 1024 + (j - 512), lane); __builtin_amdgcn_s_setprio(0); }
            else if (j < 2048) { __builtin_amdgcn_s_setprio(1); hyena_wave(p, l, j - 1024, lane); __builtin_amdgcn_s_setprio(0); }
            else attn_wave(p, j - 2048, lane); }
    }
}
__device__ __forceinline__ void ph_athy(KP p, int l) {
    const int tix = otid();
    const int lane = tix & 63, wv = tix >> 6;
    for (int j = wv * gridDim.x + blockIdx.x; j < 3072; j += gridDim.x * 8) {
        if (j < 512) attn_wave(p, 1024 + j, lane);
        else if (j < 1024) hyena_wave(p, l, 1024 + (j - 512), lane);
        else if (j < 2048) hyena_wave(p, l, j - 1024, lane);
        else attn_wave(p, j - 2048, lane);
    }
}

__device__ __forceinline__ void ph_headnorm(KP p, int l) {
    const int tix = otid();
    const int lane = tix & 63, wv = tix >> 6;
    for (int item = wv * gridDim.x + blockIdx.x; item < (M / 4) * 8; item += gridDim.x * 8) {
        const int r0 = (item >> 3) * 4, which = (item >> 2) & 1, h = item & 3;
        const int c = h * 64 + lane;
        const float* O = which ? p->OG : p->OH;
        const float gn = which ? p->gdn_norm[l * 64 + lane] : p->hgrn_norm[l * 256 + c];
        float o[4], gt[4];
#pragma unroll
        for (int i = 0; i < 4; ++i) {
            o[i] = O[(size_t)(r0 + i) * 256 + c] + O[((size_t)M + r0 + i) * 256 + c];
            gt[i] = which ? p->U[(size_t)(r0 + i) * INCP + GD_OFF + 768 + c] : p->U[(size_t)(r0 + i) * INCP + HG_OFF + 512 + c];
        }
#pragma unroll
        for (int i = 0; i < 4; ++i) {
            const float ss = wave_sum(o[i] * o[i], lane);
            const float rstd = 1.0f / sqrtf(ss * (1.0f / 64.f) + RMS_EPS);
            p->OCAT[(size_t)(r0 + i) * D + (which ? 768 : 0) + c] = (bf16)f2bf(o[i] * rstd * gn * siluf_(gt[i]));
        }
    }
}

#define XB_TMO      128
#define XB_XCNT(j)  (256  + 64 * (j))
#define XB_XSUB(j)  (1280 + 64 * (j))
#define XB_XGEN(j)  (2304 + 64 * (j))
#define XB_TOP      3328
#define XB_TOPGEN   3392
#define XCD_BAR_WORDS 3456
#define XB_SPIN_CAP (1u << 18)

__device__ __forceinline__ unsigned xb_ld(unsigned* p)              { return __hip_atomic_load(p, __ATOMIC_RELAXED, __HIP_MEMORY_SCOPE_AGENT); }
__device__ __forceinline__ unsigned xb_add(unsigned* p, unsigned v) { return __hip_atomic_fetch_add(p, v, __ATOMIC_RELAXED, __HIP_MEMORY_SCOPE_AGENT); }
__device__ __forceinline__ unsigned xb_xcc_id() { return (unsigned)__builtin_amdgcn_s_getreg((3 << 11) | 20) & 0xFu; }
#define XB_SPIN(cond, bar) do { unsigned _sp = 0; while (cond) { __builtin_amdgcn_s_sleep(1); \
    if ((++_sp & 255u) == 0u) { if (xb_ld(&(bar)[XB_TMO])) break; if (_sp > XB_SPIN_CAP) { atomicAdd(&(bar)[XB_TMO], 1u); break; } } } } while (0)

struct XcdBarrier {
    unsigned* bar; unsigned x;
    volatile LAS unsigned* st;
};

__device__ __forceinline__ XcdBarrier xcd_barrier_post(unsigned* bar, volatile LAS unsigned* st) {
    XcdBarrier b; b.bar = bar; b.x = xb_xcc_id(); b.st = st;
    if (threadIdx.x == 0) (void)xb_add(&bar[XB_XCNT(b.x)], 1u);
    return b;
}
__device__ __forceinline__ void xcd_barrier_complete(unsigned* bar, unsigned x, unsigned& nloc, unsigned& nx) {
    const unsigned G = gridDim.x * gridDim.y * gridDim.z;
    unsigned sum, cnt, mine, sp = 0u;
    for (;;) {
        sum = 0u; cnt = 0u; mine = 0u;
#pragma unroll
        for (unsigned j = 0; j < 16; ++j) { const unsigned c = xb_ld(&bar[XB_XCNT(j)]); sum += c; cnt += (c > 0u) ? 1u : 0u; mine = (j == x) ? c : mine; }
        if (sum == G) break;
        __builtin_amdgcn_s_sleep(1);
        if ((++sp & 255u) == 0u) { if (xb_ld(&bar[XB_TMO])) break; if (sp > XB_SPIN_CAP) { atomicAdd(&bar[XB_TMO], 1u); break; } }
    }
    nloc = mine > 0u ? mine : 1u; nx = cnt > 0u ? cnt : 1u;
}

__device__ __forceinline__ void xcd_barrier(const XcdBarrier& b) {
    asm volatile("s_waitcnt vmcnt(0)" ::: "memory");
    __syncthreads();
    if (threadIdx.x == 0) {
        unsigned* bar = b.bar;
        __builtin_amdgcn_s_waitcnt(0);
        unsigned nloc = b.st[0], nx = b.st[1];
        if (nloc == 0u) { xcd_barrier_complete(bar, b.x, nloc, nx); b.st[0] = nloc; b.st[1] = nx; }
        const unsigned old = xb_add(&bar[XB_XSUB(b.x)], 1u);
        const unsigned gen = old / nloc;
        if (old + 1u == (gen + 1u) * nloc) {
            __builtin_amdgcn_fence(__ATOMIC_RELEASE, "agent");
            asm volatile("s_waitcnt vmcnt(0)" ::: "memory");
            const unsigned og = xb_add(&bar[XB_TOP], 1u);
            const unsigned tg = og / nx;
            if (og + 1u == (tg + 1u) * nx) xb_add(&bar[XB_TOPGEN], 1u);
            else XB_SPIN(xb_ld(&bar[XB_TOPGEN]) == tg, bar);
            __builtin_amdgcn_fence(__ATOMIC_ACQUIRE, "agent");
            xb_add(&bar[XB_XGEN(b.x)], 1u);
            asm volatile("s_waitcnt vmcnt(0)" ::: "memory");
        } else {
            XB_SPIN(xb_ld(&bar[XB_XGEN(b.x)]) == gen, bar);
            __builtin_amdgcn_fence(__ATOMIC_ACQUIRE, "agent");
            asm volatile("s_waitcnt vmcnt(0)" ::: "memory");
        }
    }
    __syncthreads();
}

#ifndef REP_SETUP
#define REP_SETUP 1
#endif
#ifndef REP_NORM
#define REP_NORM 1
#endif
#ifndef REP_GU
#define REP_GU 1
#endif
#ifndef REP_GIN
#define REP_GIN 1
#endif
#ifndef REP_PREP
#define REP_PREP 1
#endif
#ifndef REP_SCANA
#define REP_SCANA 1
#endif
#ifndef REP_ATHY
#define REP_ATHY 1
#endif
#ifndef REP_SCANC
#define REP_SCANC 1
#endif
#ifndef REP_HN
#define REP_HN 1
#endif
#ifndef REP_MIXB
#define REP_MIXB 1
#endif
#ifndef REP_SYNC
#define REP_SYNC 1
#endif
#define REPEAT(n) for (int rep_ = 0; rep_ < (n); ++rep_)
__global__ void __launch_bounds__(NTHREADS, 2) fwd_megakernel(P p) {
    extern __shared__ __attribute__((aligned(16))) unsigned char lds_raw[];
    LAS unsigned char* lds = (LAS unsigned char*)lds_raw;
    const int G = gridDim.x;
    volatile LAS unsigned* MISC = (volatile LAS unsigned*)(lds + 131072);
    if (threadIdx.x < 64) MISC[threadIdx.x] = 0u;
    __syncthreads();
    (void)xcd_barrier_post(FRESH_P()->BAR, MISC + 8);
#define GRID_SYNC() REPEAT(REP_SYNC) do { XcdBarrier b_; b_.bar = FRESH_P()->BAR; b_.x = xb_xcc_id(); b_.st = (volatile LAS unsigned*)(lds + 131072) + 8; xcd_barrier(b_); } while (0)

    REPEAT(REP_SETUP) {
    ph_init(FRESH_P());
#ifndef NO_ADA
    ph_ada(FRESH_P(), (LAS float*)lds);
#endif
#ifndef NO_SMALL
    ph_small(FRESH_P());
#endif
#ifndef NO_FILT
    ph_filt(FRESH_P(), (LAS double*)lds);
#endif
#ifndef NO_WPREP
    ph_wprep(FRESH_P(), (LAS float*)lds);
#endif
    __syncthreads();
    }
    GRID_SYNC();

#pragma unroll 1
    for (int l = 0; l < DEPTH; ++l) {
#pragma unroll 1
        for (int f = 0; f < 2; ++f) {
            if (f == 1) {
                REPEAT(REP_NORM) ph_norm(FRESH_P(), l, 1);
                GRID_SYNC();
#ifndef NO_GIN
                REPEAT(REP_GIN) { KP q = FRESH_P(); pg8::Gemm g{q->H, q->WIN + (size_t)l * INCP * D, M, INCP, D}; pg8::StaticOrder S; S.init(M, INCP, G, (int)blockIdx.x);
                  EpiF32 E{q->U, INCP};
                  pg8::gemm_phase<EpiF32, pg8::StaticOrder, true, true>(lds, g, S, E); }
#endif
                GRID_SYNC();
                REPEAT(REP_PREP) ph_prep(FRESH_P(), l);
                GRID_SYNC();
                REPEAT(REP_SCANA) ph_scanA(FRESH_P(), lds);
                GRID_SYNC();
                REPEAT(REP_MIXB) ph_mixB(FRESH_P(), l);
                REPEAT(REP_ATHY - 1) ph_athy(FRESH_P(), l);
                GRID_SYNC();
                REPEAT(REP_SCANC) ph_scanC(FRESH_P());
                GRID_SYNC();
                REPEAT(REP_HN) ph_headnorm(FRESH_P(), l);
                GRID_SYNC();
#ifndef NO_GOUT
                { KP q = FRESH_P(); pg8::Gemm g{q->OCAT, q->WOUT + (size_t)l * D * D, M, D, D}; pg8::StaticOrder S; S.init(M, D, G, (int)blockIdx.x);
                  EpiResid E{q->X, q->ADA + (size_t)(l * 3) * NADA * D + 5 * D, 1.0f};
                  pg8::gemm_phase<EpiResid, pg8::StaticOrder, true, true>(lds, g, S, E);
                  wprep_idle(FRESH_P(), (LAS float*)lds, l + 1, 1, (M / 256) * (D / 256));
#ifdef REP_GOUT
                  __syncthreads(); EpiResid E0{q->X, q->ADA + (size_t)(l * 3) * NADA * D + 5 * D, 0.0f};
                  pg8::gemm_phase<EpiResid, pg8::StaticOrder, true, true>(lds, g, S, E0);
#endif
                }
#endif
                GRID_SYNC();
            }
            const int s = f == 0 ? 0 : 2;
            REPEAT(REP_NORM) ph_norm(FRESH_P(), l, s);
            GRID_SYNC();
#ifndef NO_GGU
            REPEAT(REP_GU) { KP q = FRESH_P(); pg8::Gemm g{q->H, q->WGU + (size_t)(l * 2 + f) * 2 * DFF * D, M, 2 * DFF, D}; pg8::StaticOrder S; S.init(M, 2 * DFF, G, (int)blockIdx.x);
              EpiSwiGLU E{q->ACT};
              pg8::gemm_phase<EpiSwiGLU, pg8::StaticOrder, true, true>(lds, g, S, E); }
#endif
            GRID_SYNC();
#ifndef NO_GDN
            { KP q = FRESH_P(); pg8::Gemm g{q->ACT, q->WDN + (size_t)(l * 2 + f) * D * DFF, M, D, DFF}; pg8::StaticOrder S; S.init(M, D, G, (int)blockIdx.x);
              EpiResid E{q->X, q->ADA + (size_t)(l * 3) * NADA * D + (3 * s + 2) * D, 0.5f};
              pg8::gemm_phase<EpiResid, pg8::StaticOrder, true, true>(lds, g, S, E);
              wprep_idle(FRESH_P(), (LAS float*)lds, l + 1, f == 0 ? 0 : 2, (M / 256) * (D / 256));
#ifdef REP_GDN
              __syncthreads(); EpiResid E0{q->X, q->ADA + (size_t)(l * 3) * NADA * D + (3 * s + 2) * D, 0.0f};
              pg8::gemm_phase<EpiResid, pg8::StaticOrder, true, true>(lds, g, S, E0);
#endif
            }
#endif
            GRID_SYNC();
        }
    }
}

}

extern "C" void kernel_launch(void* const* d_in, const int* in_sizes, int n_in, void* d_out, int out_size, void* d_ws, size_t ws_size, hipStream_t stream) {
    P p{};
    const float* const* in = (const float* const*)d_in;
    p.x_prompt = in[0]; p.x_sample = in[1]; p.cache_ckv = in[2]; p.cache_krope = in[3]; p.state_hgrn = in[4]; p.state_gdn = in[5]; p.c = in[6]; p.c_ctx = in[7];
    p.w_ada = in[8]; p.b_ada = in[9]; p.norm_ffn = in[10]; p.w_gu = in[11]; p.w_down = in[12]; p.norm_mix = in[13]; p.w_in = in[14]; p.w_out = in[15];
    p.hgrn_lb = in[16]; p.hgrn_norm = in[17]; p.hy_conv_w = in[18]; p.hy_conv_b = in[19]; p.hy_w1 = in[20]; p.hy_b1 = in[21]; p.hy_freq = in[22];
    p.hy_w2 = in[23]; p.hy_b2 = in[24]; p.hy_w3 = in[25]; p.hy_skip = in[26]; p.q_norm_a = in[27]; p.w_q_up = in[28]; p.kv_norm_a = in[29];
    p.w_kv_up = in[30]; p.qk_norm = in[31]; p.gdn_conv_w = in[32]; p.gdn_a_log = in[33]; p.gdn_dt_bias = in[34]; p.gdn_norm = in[35];
    float* out = (float*)d_out;
    p.X = out;
    p.o_ckv = out + (size_t)M * D;
    p.o_krope = p.o_ckv + (size_t)NB_P * DEPTH * T_P * 128;
    p.o_shg = p.o_krope + (size_t)NB_P * DEPTH * T_P * 32;
    p.o_sgd = p.o_shg + (size_t)NB_P * DEPTH * 2 * 4 * 64 * 64;
    unsigned char* w = (unsigned char*)d_ws;
    auto take = [&](size_t bytes) { unsigned char* r = w; w += (bytes + 255) & ~(size_t)255; return r; };
    p.ADA = (float*)take((size_t)DEPTH * 3 * NADA * D * 4);
    p.LB = (float*)take(DEPTH * 512 * 4);
    p.FILT = (float*)take(DEPTH * FILT_L * 4);
    p.ROPE = (float*)take(2 * 1024 * 16 * 4);
    p.WGU = (bf16*)take((size_t)DEPTH * 2 * 2 * DFF * D * 2);
    p.WDN = (bf16*)take((size_t)DEPTH * 2 * D * DFF * 2);
    p.WIN = (bf16*)take((size_t)DEPTH * INCP * D * 2);
    p.WOUT = (bf16*)take((size_t)DEPTH * D * D * 2);
    p.WQT = (bf16*)take((size_t)DEPTH * 384 * 256 * 2); p.WKVT = (bf16*)take((size_t)DEPTH * 512 * 128 * 2);
    p.H = (bf16*)take((size_t)M * D * 2);
    p.ACT = (bf16*)take((size_t)M * DFF * 2);
    p.OCAT = (bf16*)take((size_t)M * D * 2);
    p.U = (float*)take((size_t)M * INCP * 4);
    p.QB = (bf16*)take((size_t)M * 384 * 2);
    p.KBP = (bf16*)take((size_t)NB_P * 4 * T_P * 96 * 2); p.VTP = (bf16*)take((size_t)NB_P * 4 * 64 * T_P * 2);
    p.KBS = (bf16*)take((size_t)NB_S * 4 * NKS * 96 * 2); p.VTS = (bf16*)take((size_t)NB_S * 4 * 64 * NKS * 2);
    p.GQ = (float*)take((size_t)M * 256 * 4); p.GK = (float*)take((size_t)M * 256 * 4); p.GV = (float*)take((size_t)M * 256 * 4);
    p.GA = (float*)take((size_t)M * 8 * 4); p.GBT = (float*)take((size_t)M * 8 * 4);
    p.HF = (float*)take((size_t)2 * M * 256 * 4); p.HQ = (float*)take((size_t)M * 256 * 4);
    p.Z = (float*)take((size_t)M * 256 * 4); p.X0 = (float*)take((size_t)M * 256 * 4);
    p.OH = (float*)take((size_t)2 * M * 256 * 4); p.OG = (float*)take((size_t)2 * M * 256 * 4);
    p.HS = (float*)take((size_t)1536 * 4096 * 4); p.HD = (float*)take((size_t)1536 * 64 * 4);
    p.GS = (float*)take((size_t)768 * 4096 * 4); p.GP = (float*)take((size_t)768 * 4096 * 4);
    p.HS2 = (float*)take((size_t)1536 * 4096 * 4); p.GS2 = (float*)take((size_t)768 * 4096 * 4);
    p.GKB = (bf16*)take((size_t)M * 256 * 2); p.GQB = (bf16*)take((size_t)M * 256 * 2); p.GLA = (float*)take((size_t)M * 8 * 4);
    p.ATT = (bf16*)take((size_t)768 * 4096 * 2); p.WN = (bf16*)take((size_t)768 * 4096 * 2); p.QG = (bf16*)take((size_t)768 * 4096 * 2); p.KOT = (bf16*)take((size_t)768 * 4096 * 2);
    p.UB = (float*)take((size_t)768 * 4096 * 4); p.EGL = (float*)take((size_t)768 * 4);
    p.BAR = (unsigned*)take(16384);

    static int grid_blocks = 0;
    if (!grid_blocks) {
        int dev = 0, cus = 0, per_cu = 0;
        hipGetDevice(&dev);
        hipDeviceGetAttribute(&cus, hipDeviceAttributeMultiprocessorCount, dev);
        hipFuncSetAttribute((const void*)fwd_megakernel, hipFuncAttributeMaxDynamicSharedMemorySize, LDS_BYTES);
        hipOccupancyMaxActiveBlocksPerMultiprocessor(&per_cu, (const void*)fwd_megakernel, NTHREADS, LDS_BYTES);
        if (per_cu < 1) { fprintf(stderr, "kernel_launch: occupancy query reports %d blocks per CU\n", per_cu); per_cu = 1; }
        if (per_cu > 1) per_cu = 1;
        grid_blocks = cus * per_cu;
    }
    (void)hipMemsetAsync(p.BAR, 0, 16384, stream);
    void* args[] = {&p};
    hipError_t e = hipLaunchCooperativeKernel((const void*)fwd_megakernel, dim3(grid_blocks), dim3(NTHREADS), args, LDS_BYTES, stream);
    if (e != hipSuccess) fprintf(stderr, "cooperative launch failed: %s (grid %d)\n", hipGetErrorString(e), grid_blocks);
}
```

```cpp
#include <hip/hip_runtime.h>
#include <hip/hip_cooperative_groups.h>
#include <stdint.h>
#include <math.h>
#include <cstdio>
#include <type_traits>
namespace cg = cooperative_groups;

namespace pg8 {
#define PG8_LAS __attribute__((address_space(3)))
typedef unsigned short bf16_t;
typedef short bf16x8 __attribute__((ext_vector_type(8)));
typedef float f32x4 __attribute__((ext_vector_type(4)));
typedef unsigned u32x4 __attribute__((ext_vector_type(4)));
constexpr int BM = 256, BK = 64, HALF = 128, HTB = HALF * BK * 2  , STAGE_BYTES = 8 * HTB, NXCD = 8, WGM = 8;

__host__ __device__ __forceinline__ int lds_byte(int r, int c) { const int st = (r >> 4) * 2 + (c >> 5), rr = r & 15, cc = c & 31, ob = rr * 64 + cc * 2; return st * 1024 + (ob ^ (((ob >> 9) & 1) << 5)); }
__host__ __device__ __forceinline__ void stage_rc(int b, int& R, int& C) { const int st = b / 1024, sb = b % 1024, swz = sb ^ (((sb >> 9) & 1) << 5); R = (st >> 1) * 16 + swz / 64; C = (st & 1) * 32 + (swz % 64) / 2; }
__host__ __device__ __forceinline__ int perm32(int rho) { const int n = rho >> 4, i = rho & 15; return 8 * (i >> 2) + 4 * n + (i & 3); }

struct Unit { int pm, pn; };
struct Gemm { const bf16_t* A; const bf16_t* Bt; int M, N, K; };

struct StaticOrder {
    int nM, nN, nwg, G, c;
    __host__ __device__ void init(int M, int N, int G_, int c_) { nM = M / BM; nN = N / BM; nwg = nM * nN; G = G_; c = c_; }
    __host__ __device__ bool next(int i, Unit& u) const {
        const long L = (long)i * G + c; if (L >= nwg) return false;
        int wgid = (int)L; { const int q = nwg / NXCD, r = nwg % NXCD, xcd = wgid % NXCD, off = wgid / NXCD; wgid = (xcd < r ? xcd * (q + 1) : r * (q + 1) + (xcd - r) * q) + off; }
        const int nig = WGM * nN, gid = wgid / nig, fm = gid * WGM, gsz = (nM - fm) < WGM ? (nM - fm) : WGM;
        u.pm = fm + ((wgid % nig) % gsz); u.pn = (wgid % nig) / gsz; return true;
    }
    __device__ __forceinline__ void a_ready(const Unit&) const {}
    __device__ __forceinline__ void done(const Unit&) const {}
};

__device__ __forceinline__ unsigned cvt_pk_bf16(float lo, float hi) { unsigned r; asm volatile("v_cvt_pk_bf16_f32 %0, %1, %2" : "=v"(r) : "v"(lo), "v"(hi)); return r; }

template <class Epi, class Sched, bool ALIGN_EPI = false, bool SP2 = false>
__device__ __forceinline__ void gemm_phase(PG8_LAS unsigned char* lds, const Gemm g, const Sched& S, const Epi& E) {
    int tid_ = threadIdx.x; asm volatile("" : "+v"(tid_));
    const int tid = tid_, wid = __builtin_amdgcn_readfirstlane(tid >> 6), lane = tid & 63, wr = wid >> 2, wc = wid & 3, fr = lane & 15, fq = lane >> 4;
    const int K = g.K, nt = K / BK;
    unsigned voffA[2], voffB[2];
#pragma unroll
    for (int i = 0; i < 2; ++i) { int R, C; stage_rc(tid * 16 + i * 8192, R, C); const int Rb = Epi::PERM ? ((R & ~31) + perm32(R & 31)) : R;
        voffA[i] = (unsigned)(R * K + C) * 2u; voffB[i] = (unsigned)(Rb * K + C) * 2u; }
    const size_t kstep = (size_t)(BK * 2);
    const size_t hstep = (size_t)HALF * K * 2;
    const size_t tstep = 2 * hstep;
    const unsigned ldsw = (unsigned)wid * 1024u;
    const int aoff = lds_byte(wr * 64 + fr, fq * 8), boff = lds_byte(wc * 32 + fr, fq * 8);
#define PG8_SA(b, h) (((b) * 2 + (h)) * HTB)
#define PG8_SB(b, h) ((4 + (b) * 2 + (h)) * HTB)
#define PG8_STAGE(bufoff, gbase, voff) do { _Pragma("unroll") for (int _i = 0; _i < 2; ++_i) \
        __builtin_amdgcn_global_load_lds((const unsigned*)((const char*)(gbase) + (voff)[_i]), (PG8_LAS unsigned*)(lds + (bufoff) + ldsw + _i * 8192), 16, 0, 0); } while (0)
#define PG8_LDA(dst, b, h) do { _Pragma("unroll") for (int m = 0; m < 4; ++m) _Pragma("unroll") for (int k = 0; k < 2; ++k) dst[m][k] = *(const PG8_LAS bf16x8*)(lds + PG8_SA(b, h) + aoff + m * 2048 + k * 1024); } while (0)
#define PG8_LDB(dst, b, h) do { _Pragma("unroll") for (int n = 0; n < 2; ++n) _Pragma("unroll") for (int k = 0; k < 2; ++k) dst[n][k] = *(const PG8_LAS bf16x8*)(lds + PG8_SB(b, h) + boff + n * 2048 + k * 1024); } while (0)
#define PG8_MMA(ai, bj, At, Bt) do { __builtin_amdgcn_s_setprio(1); _Pragma("unroll") for (int m = 0; m < 4; ++m) _Pragma("unroll") for (int n = 0; n < 2; ++n) _Pragma("unroll") for (int k = 0; k < 2; ++k) \
        acc[ai][bj][m][n] = __builtin_amdgcn_mfma_f32_16x16x32_bf16(Bt[n][k], At[m][k], acc[ai][bj][m][n], 0, 0, 0); __builtin_amdgcn_s_setprio(0); } while (0)
#define PG8_WAIT_V(n) asm volatile("s_waitcnt vmcnt(" #n ")" ::: "memory")
#define PG8_WAIT_L(n) asm volatile("s_waitcnt lgkmcnt(" #n ")" ::: "memory")
#define PG8_BAR __builtin_amdgcn_s_barrier()
#define PG8_SCHED __builtin_amdgcn_sched_barrier(0)
    Unit cur, nxt; int ui = 0;
    if (!S.next(0, cur)) return;
    f32x4 acc[2][2][4][2];
#pragma unroll
    for (int a = 0; a < 2; ++a)
#pragma unroll
        for (int b = 0; b < 2; ++b)
#pragma unroll
            for (int m = 0; m < 4; ++m)
#pragma unroll
                for (int n = 0; n < 2; ++n) acc[a][b][m][n] = (f32x4){0.f, 0.f, 0.f, 0.f};
    bf16x8 At[4][2], B0[2][2], B1[2][2];
    const char* cA = (const char*)g.A + (size_t)cur.pm * tstep; const char* cB = (const char*)g.Bt + (size_t)cur.pn * tstep;
    S.a_ready(cur);
    if constexpr (SP2) {
        PG8_STAGE(PG8_SB(0, 0), cB, voffB); PG8_STAGE(PG8_SB(0, 1), cB + hstep, voffB); PG8_STAGE(PG8_SA(0, 0), cA, voffA); PG8_STAGE(PG8_SA(0, 1), cA + hstep, voffA);
        if (wr == 1) PG8_BAR;
        PG8_WAIT_V(2); PG8_BAR;
        PG8_STAGE(PG8_SB(1, 0), cB + kstep, voffB); PG8_STAGE(PG8_SA(1, 0), cA + kstep, voffA); PG8_STAGE(PG8_SB(1, 1), cB + hstep + kstep, voffB);
        PG8_WAIT_V(6); PG8_BAR;
    } else {
        PG8_STAGE(PG8_SB(0, 0), cB, voffB); PG8_STAGE(PG8_SA(0, 0), cA, voffA); PG8_STAGE(PG8_SB(0, 1), cB + hstep, voffB); PG8_STAGE(PG8_SA(0, 1), cA + hstep, voffA);
        if (wr == 1) PG8_BAR;
        PG8_WAIT_V(4); PG8_BAR;
        PG8_STAGE(PG8_SB(1, 0), cB + kstep, voffB); PG8_STAGE(PG8_SA(1, 0), cA + kstep, voffA); PG8_STAGE(PG8_SB(1, 1), cB + hstep + kstep, voffB);
        PG8_WAIT_V(6); PG8_BAR;
    }
    for (;;) {
        const bool has_next = S.next(ui + 1, nxt);
        const char* nA = has_next ? (const char*)g.A + (size_t)nxt.pm * tstep : cA; const char* nB = has_next ? (const char*)g.Bt + (size_t)nxt.pn * tstep : cB;
        for (int t = 0; t < nt; t += 2) {
            const bool last = (t == nt - 2);
            const char* a1 = cA + (size_t)(t + 1) * kstep;
            const char* a2 = last ? nA : cA + (size_t)(t + 2) * kstep; const char* b2 = last ? nB : cB + (size_t)(t + 2) * kstep;
            const char* a3 = a2 + kstep; const char* b3 = b2 + kstep;
            if (last && has_next) S.a_ready(nxt);
            if constexpr (SP2) {
            PG8_LDB(B0, 0, 0); PG8_LDB(B1, 0, 1); PG8_SCHED; PG8_LDA(At, 0, 0); PG8_STAGE(PG8_SA(1, 1), a1 + hstep, voffA);
            PG8_WAIT_V(8); PG8_WAIT_L(0); PG8_BAR; PG8_MMA(0, 0, At, B0); PG8_MMA(0, 1, At, B1); PG8_BAR; PG8_SCHED;
            PG8_LDA(At, 0, 1); PG8_STAGE(PG8_SB(0, 0), b2, voffB); PG8_STAGE(PG8_SB(0, 1), b2 + hstep, voffB); PG8_STAGE(PG8_SA(0, 0), a2, voffA);
            PG8_WAIT_V(8); PG8_WAIT_L(0); PG8_BAR; PG8_MMA(1, 0, At, B0); PG8_MMA(1, 1, At, B1); PG8_BAR; PG8_SCHED;
            PG8_LDB(B0, 1, 0); PG8_LDB(B1, 1, 1); PG8_SCHED; PG8_LDA(At, 1, 0); PG8_STAGE(PG8_SA(0, 1), a2 + hstep, voffA);
            PG8_WAIT_V(8); PG8_WAIT_L(0); PG8_BAR; PG8_MMA(0, 0, At, B0); PG8_MMA(0, 1, At, B1); PG8_BAR; PG8_SCHED;
            PG8_LDA(At, 1, 1); PG8_STAGE(PG8_SB(1, 0), b3, voffB); PG8_STAGE(PG8_SB(1, 1), b3 + hstep, voffB); PG8_STAGE(PG8_SA(1, 0), a3, voffA);
            PG8_WAIT_V(8); PG8_WAIT_L(0); PG8_BAR; PG8_MMA(1, 0, At, B0); PG8_MMA(1, 1, At, B1); PG8_BAR; PG8_SCHED;
            } else {
            PG8_LDB(B0, 0, 0); PG8_SCHED; PG8_LDA(At, 0, 0); PG8_STAGE(PG8_SA(1, 1), a1 + hstep, voffA);
            PG8_WAIT_L(8); PG8_BAR; PG8_WAIT_L(0); PG8_MMA(0, 0, At, B0); PG8_BAR; PG8_SCHED;
            PG8_LDB(B1, 0, 1); PG8_STAGE(PG8_SB(0, 0), b2, voffB);
            PG8_BAR; PG8_WAIT_L(0); PG8_MMA(0, 1, At, B1); PG8_BAR;
            PG8_LDA(At, 0, 1); PG8_STAGE(PG8_SA(0, 0), a2, voffA);
            PG8_BAR; PG8_WAIT_L(0); PG8_MMA(1, 0, At, B0); PG8_BAR; PG8_SCHED;
            PG8_STAGE(PG8_SB(0, 1), b2 + hstep, voffB);
            PG8_WAIT_V(6); PG8_BAR; PG8_MMA(1, 1, At, B1); PG8_BAR;
            PG8_LDB(B0, 1, 0); PG8_SCHED; PG8_LDA(At, 1, 0); PG8_STAGE(PG8_SA(0, 1), a2 + hstep, voffA);
            PG8_WAIT_L(8); PG8_BAR; PG8_WAIT_L(0); PG8_MMA(0, 0, At, B0); PG8_BAR; PG8_SCHED;
            PG8_LDB(B1, 1, 1); PG8_STAGE(PG8_SB(1, 0), b3, voffB);
            PG8_BAR; PG8_WAIT_L(0); PG8_MMA(0, 1, At, B1); PG8_BAR;
            PG8_LDA(At, 1, 1); PG8_STAGE(PG8_SA(1, 0), a3, voffA);
            PG8_BAR; PG8_WAIT_L(0); PG8_MMA(1, 0, At, B0); PG8_BAR; PG8_SCHED;
            PG8_STAGE(PG8_SB(1, 1), b3 + hstep, voffB);
            PG8_WAIT_V(6); PG8_BAR; PG8_MMA(1, 1, At, B1); PG8_BAR;
            }
        }
        if constexpr (ALIGN_EPI) { if (wr == 0) PG8_BAR; }
        if constexpr (!Epi::AFTER_DRAIN) { E(acc, cur, wr, wc, fr, fq); S.done(cur); }
        if (!has_next) break;
#pragma unroll
        for (int a = 0; a < 2; ++a)
#pragma unroll
            for (int b = 0; b < 2; ++b)
#pragma unroll
                for (int m = 0; m < 4; ++m)
#pragma unroll
                    for (int n = 0; n < 2; ++n) acc[a][b][m][n] = (f32x4){0.f, 0.f, 0.f, 0.f};
        cur = nxt; cA = nA; cB = nB; ++ui;
        if constexpr (ALIGN_EPI) { if (wr == 1) PG8_BAR; }
    }
    PG8_WAIT_V(0);
    if constexpr (!ALIGN_EPI) { if (wr == 0) PG8_BAR; }
    PG8_BAR;
    if constexpr (Epi::AFTER_DRAIN) { E.fused(acc, cur, wr, wc, fr, fq, lds, wid, lane); S.done(cur); }
#undef PG8_SA
#undef PG8_SB
#undef PG8_STAGE
#undef PG8_LDA
#undef PG8_LDB
#undef PG8_MMA
#undef PG8_WAIT_V
#undef PG8_WAIT_L
#undef PG8_BAR
#undef PG8_SCHED
}
}

namespace {
#define LAS __attribute__((address_space(3)))
typedef unsigned short bf16;
typedef float f32x4 __attribute__((ext_vector_type(4)));
typedef unsigned u32x4 __attribute__((ext_vector_type(4)));
typedef unsigned u32x2 __attribute__((ext_vector_type(2)));
typedef short bf16x8 __attribute__((ext_vector_type(8)));
typedef short bf16x4 __attribute__((ext_vector_type(4)));

constexpr int NTHREADS = 512;
constexpr int D = 1024, NB_P = 16, T_P = 256, NB_S = 2, T_S = 1024, DEPTH = 4, PAST = 256;
constexpr int M_P = NB_P * T_P, M_S = NB_S * T_S, M = M_P + M_S;
constexpr int DFF = 2816, NADA = 9, INC = 3504, INCP = 3584;
constexpr int HG_OFF = 0, HY_OFF = 1280, MLA_OFF = 2048, GD_OFF = 2464;
constexpr int NKS = T_S + PAST;
constexpr float RMS_EPS = 1e-6f;
constexpr int LDS_BYTES = 147456;
constexpr size_t FILT_L = 2 * (256 + 1024) * 256;

struct P {
    const float *x_prompt, *x_sample, *cache_ckv, *cache_krope, *state_hgrn, *state_gdn, *c, *c_ctx;
    const float *w_ada, *b_ada, *norm_ffn, *w_gu, *w_down, *norm_mix, *w_in, *w_out, *hgrn_lb, *hgrn_norm;
    const float *hy_conv_w, *hy_conv_b, *hy_w1, *hy_b1, *hy_freq, *hy_w2, *hy_b2, *hy_w3, *hy_skip;
    const float *q_norm_a, *w_q_up, *kv_norm_a, *w_kv_up, *qk_norm, *gdn_conv_w, *gdn_a_log, *gdn_dt_bias, *gdn_norm;
    float *X;
    float *o_ckv, *o_krope, *o_shg, *o_sgd;
    float *ADA;
    float *LB;
    float *FILT;
    float *ROPE;
    bf16 *WGU;
    bf16 *WDN;
    bf16 *WIN;
    bf16 *WOUT;
    bf16 *WQT, *WKVT;
    bf16 *H;
    bf16 *ACT;
    bf16 *OCAT;
    float *U;
    bf16 *QB;
    bf16 *KBP, *VTP;
    bf16 *KBS, *VTS;
    float *GQ, *GK, *GV;
    float *GA, *GBT;
    float *HF, *HQ;
    float *Z, *X0;
    float *OH, *OG;
    float *HS, *HD;
    float *GS, *GP;
    float *HS2, *GS2;
    bf16 *GKB, *GQB;
    float *GLA;
    bf16 *ATT, *WN, *QG, *KOT;
    float *UB, *EGL;
    unsigned *BAR;
};

typedef const __attribute__((address_space(4))) P* KP;
#define FRESH_P() ({ KP k_ = (KP)__builtin_amdgcn_kernarg_segment_ptr(); asm volatile("" : "+s"(k_)); k_; })
__device__ __forceinline__ int otid() { int t = threadIdx.x; asm volatile("" : "+v"(t)); return t; }
__device__ __forceinline__ float sigmoidf_(float x) { return 1.f / (1.f + expf(-x)); }
__device__ __forceinline__ float siluf_(float x) { return x / (1.f + expf(-x)); }
__device__ __forceinline__ unsigned f2bf(float f) { unsigned u = __builtin_bit_cast(unsigned, f); return (u + 0x7fffu + ((u >> 16) & 1u)) >> 16; }
__device__ __forceinline__ unsigned pk2(float lo, float hi) { return f2bf(lo) | (f2bf(hi) << 16); }

__device__ __forceinline__ void row_info(int r, int& ci, int& T, int& row0, int& t, int& b) {
    if (r < M_P) { b = r >> 8; t = r & 255; T = T_P; row0 = b << 8; ci = 0; }
    else { const int rr = r - M_P; b = rr >> 10; t = rr & 1023; T = T_S; row0 = M_P + (b << 10); ci = 1 + b; }
}
__device__ __forceinline__ int panel_ci(int pm) { return pm < 16 ? 0 : 1 + ((pm - 16) >> 2); }

__device__ __forceinline__ float wave_sum(float v, int lane) {
#pragma unroll
    for (int o = 1; o < 64; o <<= 1) v += __builtin_bit_cast(float, __builtin_amdgcn_ds_bpermute((lane ^ o) << 2, __builtin_bit_cast(int, v)));
    return v;
}
__device__ __forceinline__ float bcast(float v, int k) { return __builtin_bit_cast(float, __builtin_amdgcn_readlane(__builtin_bit_cast(int, v), k)); }

struct EpiSwiGLU {
    static constexpr bool PERM = true, AFTER_DRAIN = false;
    bf16* O;
    __device__ __forceinline__ void operator()(const f32x4 (&acc)[2][2][4][2], const pg8::Unit& u, int wr, int wc, int fr, int fq) const {
        const int row0 = u.pm * 256 + wr * 64 + fr, col0 = u.pn * 128 + wc * 32 + 8 * fq;
#pragma unroll
        for (int ai = 0; ai < 2; ++ai)
#pragma unroll
            for (int m = 0; m < 4; ++m) {
                bf16* rowp = O + (size_t)(row0 + ai * 128 + m * 16) * DFF + col0;
                float v[8];
#pragma unroll
                for (int n = 0; n < 2; ++n)
#pragma unroll
                    for (int i = 0; i < 4; ++i) { const float g = acc[ai][0][m][n][i], up = acc[ai][1][m][n][i];
                        v[4 * n + i] = g * __builtin_amdgcn_rcpf(1.f + __expf(-g)) * up; }
                u32x4 w; w.x = pg8::cvt_pk_bf16(v[0], v[1]); w.y = pg8::cvt_pk_bf16(v[2], v[3]); w.z = pg8::cvt_pk_bf16(v[4], v[5]); w.w = pg8::cvt_pk_bf16(v[6], v[7]);
                *(u32x4*)rowp = w;
            }
    }
};
struct EpiF32 {
    static constexpr bool PERM = false, AFTER_DRAIN = false;
    float* C; int ldc;
    __device__ __forceinline__ void operator()(const f32x4 (&acc)[2][2][4][2], const pg8::Unit& u, int wr, int wc, int fr, int fq) const {
        const int row0 = u.pm * 256 + wr * 64 + fr, col0 = u.pn * 256 + wc * 32 + 4 * fq;
#pragma unroll
        for (int ai = 0; ai < 2; ++ai)
#pragma unroll
            for (int m = 0; m < 4; ++m) { float* rowp = C + (size_t)(row0 + ai * 128 + m * 16) * ldc + col0;
#pragma unroll
                for (int bj = 0; bj < 2; ++bj)
#pragma unroll
                    for (int n = 0; n < 2; ++n) *(f32x4*)(rowp + bj * 128 + n * 16) = acc[ai][bj][m][n]; }
    }
};
struct EpiResid {
    static constexpr bool PERM = false, AFTER_DRAIN = false;
    float* X; const float* gate; float coef;
    __device__ __forceinline__ void operator()(const f32x4 (&acc)[2][2][4][2], const pg8::Unit& u, int wr, int wc, int fr, int fq) const {
        const int row0 = u.pm * 256 + wr * 64 + fr, col0 = u.pn * 256 + wc * 32 + 4 * fq;
        const float* g = gate + (size_t)panel_ci(u.pm) * NADA * D + col0;
        f32x4 gv[2][2];
#pragma unroll
        for (int bj = 0; bj < 2; ++bj)
#pragma unroll
            for (int n = 0; n < 2; ++n) gv[bj][n] = *(const f32x4*)(g + bj * 128 + n * 16) * coef;
#pragma unroll
        for (int ai = 0; ai < 2; ++ai) {
            f32x4 xv[4][2][2];
#pragma unroll
            for (int m = 0; m < 4; ++m)
#pragma unroll
                for (int bj = 0; bj < 2; ++bj)
#pragma unroll
                    for (int n = 0; n < 2; ++n) xv[m][bj][n] = *(const f32x4*)(X + (size_t)(row0 + ai * 128 + m * 16) * D + col0 + bj * 128 + n * 16);
#pragma unroll
            for (int m = 0; m < 4; ++m)
#pragma unroll
                for (int bj = 0; bj < 2; ++bj)
#pragma unroll
                    for (int n = 0; n < 2; ++n) *(f32x4*)(X + (size_t)(row0 + ai * 128 + m * 16) * D + col0 + bj * 128 + n * 16) = xv[m][bj][n] + gv[bj][n] * acc[ai][bj][m][n];
        }
    }
};

__device__ __forceinline__ void ph_init(KP p) {
    const int tix = otid();
    const int n4 = M * D / 4, np4 = M_P * D / 4;
    for (int i = blockIdx.x * NTHREADS + tix; i < n4; i += gridDim.x * NTHREADS) {
        const float4 v = (i < np4) ? ((const float4*)p->x_prompt)[i] : ((const float4*)p->x_sample)[i - np4];
        ((float4*)p->X)[i] = v;
    }
}

__device__ __forceinline__ void ph_ada(KP p, LAS float* sc  ) {
    const int tix = otid();
    const int lane = tix & 63, wv = tix >> 6;
    for (int i = tix; i < 3 * 1024; i += NTHREADS) {
        const int ci = i >> 10, k = i & 1023;
        const float v = (ci == 0) ? p->c_ctx[k] : p->c[(ci - 1) * 1024 + k];
        sc[i] = siluf_(v);
    }
    __syncthreads();
    LAS float* part = sc + 3 * 1024;
    const int NJ = NADA * D, NG = DEPTH * (NJ / 64);
    const int trips = (NG + gridDim.x - 1) / gridDim.x;
    for (int it = 0; it < trips; ++it) {
        const int item = it * gridDim.x + blockIdx.x; const bool act = item < NG;
        const int l = act ? item / (NJ / 64) : 0, j = (act ? item % (NJ / 64) : 0) * 64 + lane;
        float a0 = 0.f, a1 = 0.f, a2 = 0.f;
        if (act) {
            const float* w = p->w_ada + (size_t)l * D * NJ + (size_t)(wv * 128) * NJ + j;
#pragma unroll 16
            for (int k = 0; k < 128; ++k) { const float wvv = w[(size_t)k * NJ]; const int kk = wv * 128 + k; a0 += sc[kk] * wvv; a1 += sc[1024 + kk] * wvv; a2 += sc[2048 + kk] * wvv; }
        }
        part[(wv * 3 + 0) * 64 + lane] = a0; part[(wv * 3 + 1) * 64 + lane] = a1; part[(wv * 3 + 2) * 64 + lane] = a2;
        __syncthreads();
        if (act && wv < 3) {
            float s = p->b_ada[l * NJ + j];
#pragma unroll
            for (int w8 = 0; w8 < 8; ++w8) s += part[(w8 * 3 + wv) * 64 + lane];
            p->ADA[(size_t)(l * 3 + wv) * NJ + j] = s;
        }
        __syncthreads();
    }
}

__device__ __forceinline__ void ph_small(KP p) {
    const int tix = otid();
    const int gt = blockIdx.x * NTHREADS + tix, gn = gridDim.x * NTHREADS;
    for (int i = gt; i < 512; i += gn) {
        float v[4], mx = -1e30f;
        for (int l = 0; l < 4; ++l) { v[l] = p->hgrn_lb[l * 512 + i]; mx = fmaxf(mx, v[l]); }
        float s = 0.f;
        for (int l = 0; l < 4; ++l) { v[l] = expf(v[l] - mx); s += v[l]; }
        float cum = 0.f;
        for (int l = 0; l < 4; ++l) { if (l > 0) cum += v[l] / s; p->LB[l * 512 + i] = cum; }
    }
    for (int i = gt; i < 1024 * 16; i += gn) {
        const int t = i >> 4, j = i & 15;
        const int row = t >> 6, col = t & 63;
        const double inv = pow(10000.0, -(double)(j & 7) / 8.0);
        const double ang = (double)((j < 8) ? row : col) * inv;
        p->ROPE[i] = (float)cos(ang);
        p->ROPE[1024 * 16 + i] = (float)sin(ang);
    }
}

__device__ __forceinline__ void ph_filt(KP p, LAS double* scr  ) {
    const int tix = otid();
    const int lane = tix & 63, wv = tix >> 6;
    LAS double* ze = scr + wv * 168; LAS double* h1 = ze + 40; LAS double* h2 = h1 + 64;
    const int NIT = DEPTH * 1280, gw = blockIdx.x * 8 + wv, NGW = gridDim.x * 8;
    const int trips = (NIT + NGW - 1) / NGW;
    for (int it = 0; it < trips; ++it) {
        const int item = it * NGW + gw; const bool act = item < NIT;
        const int l = act ? item / 1280 : 0, q = act ? item % 1280 : 0;
        const int set = (q < 256) ? 0 : 1, pos = set ? q - 256 : q, L = set ? 1024 : 256;
        const double t = (double)pos / (double)(L - 1);
        if (lane == 0) ze[0] = t;
        if (lane < 16) {
            const double band = 1e-4 + (double)lane * ((15.0 - 1e-4) / 15.0);
            const double ang = (2.0 * 3.14159265358979323846 / (double)L) * (double)pos * band;
            ze[1 + lane] = cos(ang);
            ze[17 + lane] = -sin(ang);
        }
        __syncthreads();
        const double fr = (double)p->hy_freq[l * 64 + lane];
        {
            double a = (double)p->hy_b1[l * 64 + lane];
            for (int i = 0; i < 33; ++i) a += ze[i] * (double)p->hy_w1[(l * 33 + i) * 64 + lane];
            h1[lane] = sin(fr * a);
        }
        __syncthreads();
        {
            double a = (double)p->hy_b2[l * 64 + lane];
            for (int i = 0; i < 64; ++i) a += h1[i] * (double)p->hy_w2[(l * 64 + i) * 64 + lane];
            h2[lane] = sin(fr * a);
        }
        __syncthreads();
        if (act) {
            float* base = p->FILT + (size_t)l * FILT_L + (set ? (size_t)2 * 256 * 256 : 0);
            const double max_decay = log(1e-2) / 0.3, min_decay = log(1e-2) / 1.5;
            for (int n = lane; n < 512; n += 64) {
                double a = 0.0;
                for (int i = 0; i < 64; ++i) a += h2[i] * (double)p->hy_w3[(size_t)(l * 64 + i) * 512 + n];
                const int c = n & 255;
                const double delta = min_decay + (double)c * ((max_decay - min_decay) / 255.0);
                const double win = exp(-t * fabs(delta));
                if (n < 256) base[(size_t)(L + pos) * 256 + c] = (float)(a * win);
                else if (pos > 0) base[(size_t)(L - pos) * 256 + c] = (float)(a * win);
            }
        }
        __syncthreads();
    }
}

__device__ __forceinline__ void transpose_item(const float* W, int K, int N, bf16* WT, int dst_row, LAS float* scr, int k0, int n0, int lane) {
    const int nn = n0 + (lane & 31);
#pragma unroll 8
    for (int i = 0; i < 32; ++i) { const int kk = 2 * i + (lane >> 5); scr[kk * 33 + (lane & 31)] = (nn < N) ? W[(size_t)(k0 + kk) * N + nn] : 0.f; }
    asm volatile("s_waitcnt lgkmcnt(0)" ::: "memory");
    const int c = lane & 7;
#pragma unroll
    for (int j = 0; j < 4; ++j) { const int n = (lane >> 3) + 8 * j; const LAS float* s = scr + (8 * c) * 33 + n;
        u32x4 o; o.x = pk2(s[0 * 33], s[1 * 33]); o.y = pk2(s[2 * 33], s[3 * 33]); o.z = pk2(s[4 * 33], s[5 * 33]); o.w = pk2(s[6 * 33], s[7 * 33]);
        *(u32x4*)(WT + (size_t)(dst_row + n) * K + k0 + 8 * c) = o; }
    asm volatile("s_waitcnt lgkmcnt(0)" ::: "memory");
}
constexpr int WP_I_GU = 16 * 176, WP_I_DN = 44 * 32, WP_I_IN = 16 * 112, WP_I_OUT = 16 * 32, WP_I_Q = 4 * 12, WP_I_KV = 2 * 16;
constexpr int WP_I_L = 2 * WP_I_GU + 2 * WP_I_DN + WP_I_IN + WP_I_OUT + WP_I_Q + WP_I_KV;
__device__ __forceinline__ void wprep_range(KP p, LAS float* scr_all, int l, int first, int count, int wblock, int nwblocks) {
    const int tix = otid();
    const int lane = tix & 63, wv = tix >> 6;
    LAS float* scr = scr_all + wv * (64 * 33);
    for (int it = first + wblock * 8 + wv; it < first + count; it += nwblocks * 8) {
        int r = it;
        if (r < 2 * WP_I_GU) { const int f = r / WP_I_GU, rr = r % WP_I_GU, kb = rr / 176, nb = rr % 176, n0 = nb * 32;
            const int j = n0 < DFF ? n0 : n0 - DFF; const int dst = 256 * (j >> 7) + (n0 < DFF ? 0 : 128) + (j & 127);
            transpose_item(p->w_gu + (size_t)(l * 2 + f) * D * 2 * DFF, D, 2 * DFF, p->WGU + (size_t)(l * 2 + f) * 2 * DFF * D, dst, scr, kb * 64, n0, lane); continue; }
        r -= 2 * WP_I_GU;
        if (r < 2 * WP_I_DN) { const int f = r / WP_I_DN, rr = r % WP_I_DN, kb = rr / 32, nb = rr % 32;
            transpose_item(p->w_down + (size_t)(l * 2 + f) * DFF * D, DFF, D, p->WDN + (size_t)(l * 2 + f) * D * DFF, nb * 32, scr, kb * 64, nb * 32, lane); continue; }
        r -= 2 * WP_I_DN;
        if (r < WP_I_IN) { const int kb = r / 112, nb = r % 112;
            transpose_item(p->w_in + (size_t)l * D * INC, D, INC, p->WIN + (size_t)l * INCP * D, nb * 32, scr, kb * 64, nb * 32, lane); continue; }
        r -= WP_I_IN;
        if (r < WP_I_OUT) { const int kb = r / 32, nb = r % 32;
            transpose_item(p->w_out + (size_t)l * D * D, D, D, p->WOUT + (size_t)l * D * D, nb * 32, scr, kb * 64, nb * 32, lane); continue; }
        r -= WP_I_OUT;
        if (r < WP_I_Q) { const int kb = r / 12, nb = r % 12;
            transpose_item(p->w_q_up + (size_t)l * 256 * 384, 256, 384, p->WQT + (size_t)l * 384 * 256, nb * 32, scr, kb * 64, nb * 32, lane); continue; }
        r -= WP_I_Q;
        { const int kb = r / 16, nb = r % 16;
            transpose_item(p->w_kv_up + (size_t)l * 128 * 512, 128, 512, p->WKVT + (size_t)l * 512 * 128, nb * 32, scr, kb * 64, nb * 32, lane); }
    }
}
__device__ __forceinline__ void ph_wprep(KP p, LAS float* scr_all) {
    wprep_range(p, scr_all, 0, 0, WP_I_L, blockIdx.x, gridDim.x);
}
__device__ __forceinline__ void wprep_idle(KP p, LAS float* scr_all, int l_next, int third, int nunits) {
    if (l_next >= DEPTH) return;
    const int G = gridDim.x;
    const int first = (WP_I_L * third) / 3, count = (WP_I_L * (third + 1)) / 3 - first;
    if (G > nunits) { if ((int)blockIdx.x >= nunits) wprep_range(p, scr_all, l_next, first, count, blockIdx.x - nunits, G - nunits); }
    else { __syncthreads(); wprep_range(p, scr_all, l_next, first, count, blockIdx.x, G); }
}

__device__ __forceinline__ void ph_norm(KP p, int l, int s) {
    const int tix = otid();
    const int lane = tix & 63, wv = tix >> 6;
    const float* g = (s == 1) ? p->norm_mix + l * D : p->norm_ffn + (size_t)(l * 2 + (s == 2 ? 1 : 0)) * D;
    for (int r = blockIdx.x * 8 + wv; r < M; r += gridDim.x * 8) {
        int ci, T, row0, t, b; row_info(r, ci, T, row0, t, b);
        const float* ada = p->ADA + (size_t)(l * 3 + ci) * NADA * D;
        const float* shift = ada + (3 * s + 0) * D;
        const float* scale = ada + (3 * s + 1) * D;
        const float4* xr = (const float4*)(p->X + (size_t)r * D);
        float4 v[4]; float ss = 0.f;
#pragma unroll
        for (int j = 0; j < 4; ++j) { v[j] = xr[lane + 64 * j]; ss += v[j].x * v[j].x + v[j].y * v[j].y + v[j].z * v[j].z + v[j].w * v[j].w; }
        ss = wave_sum(ss, lane);
        const float rstd = 1.0f / sqrtf(ss * (1.0f / D) + RMS_EPS);
        u32x2* hr = (u32x2*)(p->H + (size_t)r * D);
#pragma unroll
        for (int j = 0; j < 4; ++j) {
            const int c4 = lane + 64 * j;
            const float4 gg = ((const float4*)g)[c4], sh = ((const float4*)shift)[c4], scl = ((const float4*)scale)[c4];
            const float ox = v[j].x * rstd * gg.x * (1.f + scl.x) + sh.x;
            const float oy = v[j].y * rstd * gg.y * (1.f + scl.y) + sh.y;
            const float oz = v[j].z * rstd * gg.z * (1.f + scl.z) + sh.z;
            const float ow = v[j].w * rstd * gg.w * (1.f + scl.w) + sh.w;
            u32x2 o; o.x = pk2(ox, oy); o.y = pk2(oz, ow);
            hr[c4] = o;
        }
    }
}

__device__ __forceinline__ float red16(float v, int lane) {
#pragma unroll
    for (int o = 1; o < 16; o <<= 1) v += __builtin_bit_cast(float, __builtin_amdgcn_ds_bpermute((lane ^ o) << 2, __builtin_bit_cast(int, v)));
    return v;
}
__device__ __forceinline__ float red_g(float v, int lane) {
    v += __builtin_bit_cast(float, __builtin_amdgcn_ds_bpermute((lane ^ 16) << 2, __builtin_bit_cast(int, v)));
    v += __builtin_bit_cast(float, __builtin_amdgcn_ds_bpermute((lane ^ 32) << 2, __builtin_bit_cast(int, v)));
    return v;
}
__device__ __forceinline__ bf16x8 pack8(const float (&v)[8]) {
    u32x4 w; w.x = pg8::cvt_pk_bf16(v[0], v[1]); w.y = pg8::cvt_pk_bf16(v[2], v[3]); w.z = pg8::cvt_pk_bf16(v[4], v[5]); w.w = pg8::cvt_pk_bf16(v[6], v[7]);
    return __builtin_bit_cast(bf16x8, w);
}
__device__ __forceinline__ void mla_wave(KP p, int l, int group, int part, int lane) {
    asm volatile("" : "+v"(lane));
    const int tq = lane & 15, g = lane >> 4;
    const bool isctx = group >= 384;
    int tok0 = 0, b = 0, t0 = 0;
    bool sample = false;
    if (!isctx) { tok0 = group * 16; sample = tok0 >= M_P; if (sample) { b = (tok0 - M_P) >> 10; t0 = (tok0 - M_P) & 1023; } else { b = tok0 >> 8; t0 = tok0 & 255; } }
    else { const int j = group - 384; b = j >> 4; t0 = (j & 15) * 16; }
    const float qscale = 0.10206207261596577f;
    const bool rope = sample && !isctx;
    float cs[4], sn[4];
#pragma unroll
    for (int i = 0; i < 4; ++i) { const int t = rope ? t0 + 4 * g + i : 0; cs[i] = p->ROPE[t * 16 + tq]; sn[i] = p->ROPE[1024 * 16 + t * 16 + tq]; }
    if (part < 4) {
        const int h = part;
        const float* u = p->U + (size_t)(tok0 + tq) * INCP + MLA_OFF;
        bf16x8 aq[8];
        {
            float x[8][8]; float ss = 0.f;
#pragma unroll
            for (int s = 0; s < 8; ++s) { const f32x4 a = *(const f32x4*)(u + 32 * s + 8 * g), c = *(const f32x4*)(u + 32 * s + 8 * g + 4);
#pragma unroll
                for (int j = 0; j < 4; ++j) { x[s][j] = a[j]; x[s][4 + j] = c[j]; ss += a[j] * a[j] + c[j] * c[j]; } }
            ss = red_g(ss, lane);
            const float rstd = 1.0f / sqrtf(ss * (1.0f / 256.f) + RMS_EPS);
#pragma unroll
            for (int s = 0; s < 8; ++s) { const float* gn = p->q_norm_a + l * 256 + 32 * s + 8 * g; float v[8];
#pragma unroll
                for (int j = 0; j < 8; ++j) v[j] = x[s][j] * rstd * gn[j];
                aq[s] = pack8(v); }
        }
        const float* qn0 = p->qk_norm + (size_t)(l * 2 + 0) * 96;
        const bf16* Wq = p->WQT + (size_t)l * 384 * 256;
        f32x4 c[6];
#pragma unroll
        for (int tile = 0; tile < 6; ++tile) { c[tile] = (f32x4){0.f, 0.f, 0.f, 0.f};
            const bf16* wr = Wq + (size_t)(h * 96 + 16 * tile + tq) * 256 + 8 * g;
#pragma unroll
            for (int s = 0; s < 8; ++s) c[tile] = __builtin_amdgcn_mfma_f32_16x16x32_bf16(aq[s], *(const bf16x8*)(wr + 32 * s), c[tile], 0, 0, 0); }
#pragma unroll
        for (int i = 0; i < 4; ++i) {
            float ss = 0.f;
#pragma unroll
            for (int tile = 0; tile < 6; ++tile) ss += c[tile][i] * c[tile][i];
            ss = red16(ss, lane);
            const float rstd = 1.0f / sqrtf(ss * (1.0f / 96.f) + RMS_EPS);
            float v[6];
#pragma unroll
            for (int tile = 0; tile < 6; ++tile) v[tile] = c[tile][i] * rstd * qn0[16 * tile + tq];
            if (rope) { const float x1 = v[4], x2 = v[5]; v[4] = x1 * cs[i] - x2 * sn[i]; v[5] = x2 * cs[i] + x1 * sn[i]; }
            bf16* qo = p->QB + (size_t)(tok0 + 4 * g + i) * 384 + h * 96 + tq;
#pragma unroll
            for (int tile = 0; tile < 6; ++tile) qo[16 * tile] = (bf16)f2bf(v[tile] * qscale);
        }
    } else {
        const int h = part - 4;
        bf16x8 akv[4];
        if (!isctx) {
            const float* u = p->U + (size_t)(tok0 + tq) * INCP + MLA_OFF;
            float x[4][8]; float ss = 0.f;
#pragma unroll
            for (int s = 0; s < 4; ++s) { const f32x4 a = *(const f32x4*)(u + 256 + 32 * s + 8 * g), c = *(const f32x4*)(u + 256 + 32 * s + 8 * g + 4);
#pragma unroll
                for (int j = 0; j < 4; ++j) { x[s][j] = a[j]; x[s][4 + j] = c[j]; ss += a[j] * a[j] + c[j] * c[j]; } }
            ss = red_g(ss, lane);
            const float rstd = 1.0f / sqrtf(ss * (1.0f / 128.f) + RMS_EPS);
            float* oc = p->o_ckv + ((size_t)(b * DEPTH + l) * T_P + t0 + tq) * 128;
#pragma unroll
            for (int s = 0; s < 4; ++s) { const float* gn = p->kv_norm_a + l * 128 + 32 * s + 8 * g; float v[8];
#pragma unroll
                for (int j = 0; j < 8; ++j) v[j] = x[s][j] * rstd * gn[j];
                akv[s] = pack8(v);
                if (!sample && h == 0) { *(f32x4*)(oc + 32 * s + 8 * g) = (f32x4){v[0], v[1], v[2], v[3]}; *(f32x4*)(oc + 32 * s + 8 * g + 4) = (f32x4){v[4], v[5], v[6], v[7]}; } }
        } else {
            const float* cp = p->cache_ckv + ((size_t)(b * DEPTH + l) * PAST + t0 + tq) * 128;
#pragma unroll
            for (int s = 0; s < 4; ++s) { const f32x4 a = *(const f32x4*)(cp + 32 * s + 8 * g), c = *(const f32x4*)(cp + 32 * s + 8 * g + 4);
                const float v[8] = {a[0], a[1], a[2], a[3], c[0], c[1], c[2], c[3]}; akv[s] = pack8(v); }
        }
        float kr[2][4];
#pragma unroll
        for (int i = 0; i < 4; ++i)
#pragma unroll
            for (int tt = 0; tt < 2; ++tt) {
                const int tk = 4 * g + i;
                kr[tt][i] = isctx ? p->cache_krope[((size_t)(b * DEPTH + l) * PAST + t0 + tk) * 32 + 16 * tt + tq]
                                  : p->U[(size_t)(tok0 + tk) * INCP + MLA_OFF + 384 + 16 * tt + tq];
            }
        if (!isctx && !sample && h == 0) {
#pragma unroll
            for (int i = 0; i < 4; ++i)
#pragma unroll
                for (int tt = 0; tt < 2; ++tt) p->o_krope[((size_t)(b * DEPTH + l) * T_P + t0 + 4 * g + i) * 32 + 16 * tt + tq] = kr[tt][i];
        }
        const float* qn1 = p->qk_norm + (size_t)(l * 2 + 1) * 96;
        const bf16* Wkv = p->WKVT + (size_t)l * 512 * 128;
        const bool smp = isctx || sample;
        const int nk = smp ? NKS : T_P, key0 = (isctx ? T_S + t0 : t0) + 4 * g;
        bf16* Kbase = smp ? p->KBS + (size_t)(b * 4) * NKS * 96 : p->KBP + (size_t)(b * 4) * T_P * 96;
        bf16* Vbase = smp ? p->VTS + (size_t)(b * 4) * 64 * NKS : p->VTP + (size_t)(b * 4) * 64 * T_P;
        f32x4 c[8];
#pragma unroll
        for (int tile = 0; tile < 8; ++tile) { c[tile] = (f32x4){0.f, 0.f, 0.f, 0.f};
            const bf16* wr = Wkv + (size_t)(h * 128 + 16 * tile + tq) * 128 + 8 * g;
#pragma unroll
            for (int s = 0; s < 4; ++s) c[tile] = __builtin_amdgcn_mfma_f32_16x16x32_bf16(akv[s], *(const bf16x8*)(wr + 32 * s), c[tile], 0, 0, 0); }
#pragma unroll
        for (int i = 0; i < 4; ++i) {
            float ss = kr[0][i] * kr[0][i] + kr[1][i] * kr[1][i];
#pragma unroll
            for (int tile = 0; tile < 4; ++tile) ss += c[tile][i] * c[tile][i];
            ss = red16(ss, lane);
            const float rstd = 1.0f / sqrtf(ss * (1.0f / 96.f) + RMS_EPS);
            float v[6];
#pragma unroll
            for (int tile = 0; tile < 4; ++tile) v[tile] = c[tile][i] * rstd * qn1[16 * tile + tq];
            v[4] = kr[0][i] * rstd * qn1[64 + tq]; v[5] = kr[1][i] * rstd * qn1[80 + tq];
            if (rope) { const float x1 = v[4], x2 = v[5]; v[4] = x1 * cs[i] - x2 * sn[i]; v[5] = x2 * cs[i] + x1 * sn[i]; }
            bf16* ko = Kbase + ((size_t)h * nk + key0 + i) * 96 + tq;
#pragma unroll
            for (int tile = 0; tile < 6; ++tile) ko[16 * tile] = (bf16)f2bf(v[tile]);
        }
#pragma unroll
        for (int tile = 4; tile < 8; ++tile) {
            u32x2 w; w.x = pk2(c[tile][0], c[tile][1]); w.y = pk2(c[tile][2], c[tile][3]);
            *(u32x2*)(Vbase + ((size_t)h * 64 + 16 * (tile - 4) + tq) * nk + key0) = w;
        }
    }
}

__device__ __forceinline__ void tok_wave(KP p, int l, int run, int kind, int cg, int lane) {
    asm volatile("" : "+v"(lane));
    const int r0 = run * 16;
    int ci, T, row0, t0, b; row_info(r0, ci, T, row0, t0, b);
    const bool first = (t0 == 0), last = (t0 + 16 == T);
    if (kind == 0) {
        const float* u = p->U + (size_t)r0 * INCP + GD_OFF + cg * 64 + lane;
        const float* cw = p->gdn_conv_w + (size_t)l * 3 * 768 + cg * 64 + lane;
        float uq[18], uk[18];
#pragma unroll
        for (int i = 0; i < 18; ++i) { const bool ok = !((i == 0 && first) || (i == 17 && last));
            uq[i] = ok ? u[(ptrdiff_t)(i - 1) * INCP] : 0.f; uk[i] = ok ? u[(ptrdiff_t)(i - 1) * INCP + 256] : 0.f; }
        const float q0 = cw[0], q1 = cw[768], q2 = cw[1536], k0 = cw[256], k1 = cw[768 + 256], k2 = cw[1536 + 256];
#pragma unroll
        for (int i = 0; i < 16; ++i) {
            const float vq = siluf_(q0 * uq[i] + q1 * uq[i + 1] + q2 * uq[i + 2]);
            const float vk = siluf_(k0 * uk[i] + k1 * uk[i + 1] + k2 * uk[i + 2]);
            const float sq = wave_sum(vq * vq, lane), sk = wave_sum(vk * vk, lane);
            p->GQ[(size_t)(r0 + i) * 256 + cg * 64 + lane] = vq * (1.0f / sqrtf(sq + 1e-6f)) * 0.125f;
            const float qn_ = vq * (1.0f / sqrtf(sq + 1e-6f)) * 0.125f, kn_ = vk * (1.0f / sqrtf(sk + 1e-6f));
            p->GK[(size_t)(r0 + i) * 256 + cg * 64 + lane] = kn_;
            p->GQB[(size_t)(r0 + i) * 256 + cg * 64 + lane] = (bf16)f2bf(qn_);
            p->GKB[(size_t)(r0 + i) * 256 + cg * 64 + lane] = (bf16)f2bf(kn_);
        }
    } else if (kind == 1) {
        const float* u = p->U + (size_t)r0 * INCP + GD_OFF + 512 + cg * 64 + lane;
        const float* cw = p->gdn_conv_w + (size_t)l * 3 * 768 + 512 + cg * 64 + lane;
        float uv[18];
#pragma unroll
        for (int i = 0; i < 18; ++i) { const bool ok = !((i == 0 && first) || (i == 17 && last)); uv[i] = ok ? u[(ptrdiff_t)(i - 1) * INCP] : 0.f; }
        const float w0 = cw[0], w1 = cw[768], w2 = cw[1536];
#pragma unroll
        for (int i = 0; i < 16; ++i) p->GV[(size_t)(r0 + i) * 256 + cg * 64 + lane] = siluf_(w0 * uv[i] + w1 * uv[i + 1] + w2 * uv[i + 2]);
        if (cg == 0 && lane < 8) {
            const float dtb = p->gdn_dt_bias[l * 8 + lane], na = -expf(p->gdn_a_log[l * 8 + lane]);
            float xa[16], xb[16];
#pragma unroll
            for (int i = 0; i < 16; ++i) { const float* ua = p->U + (size_t)(r0 + i) * INCP + GD_OFF + 1024 + lane; xa[i] = ua[0]; xb[i] = ua[8]; }
#pragma unroll
            for (int i = 0; i < 16; ++i) {
                const float x = xa[i] + dtb;
                const float sp = (x > 20.f) ? x : log1pf(expf(x));
                p->GA[(size_t)(r0 + i) * 8 + lane] = expf(na * sp);
                p->GLA[(size_t)(r0 + i) * 8 + lane] = na * sp;
                p->GBT[(size_t)(r0 + i) * 8 + lane] = sigmoidf_(xb[i]);
            }
        }
    } else if (kind == 2) {
        const int c = cg * 64 + lane;
        const float* u = p->U + (size_t)r0 * INCP + HY_OFF + c;
        const float* cw = p->hy_conv_w + (size_t)l * 3 * 768 + c;
        const float* cb = p->hy_conv_b + (size_t)l * 768 + c;
        float u0[18], u1[18], u2[18];
#pragma unroll
        for (int i = 0; i < 18; ++i) { const bool ok = !((i == 0 && first) || (i == 17 && last));
            u0[i] = ok ? u[(ptrdiff_t)(i - 1) * INCP] : 0.f; u1[i] = ok ? u[(ptrdiff_t)(i - 1) * INCP + 256] : 0.f; u2[i] = ok ? u[(ptrdiff_t)(i - 1) * INCP + 512] : 0.f; }
        const float a0 = cw[0], a1 = cw[768], a2 = cw[1536], b0 = cw[256], b1 = cw[768 + 256], b2 = cw[1536 + 256], c0 = cw[512], c1 = cw[768 + 512], c2 = cw[1536 + 512];
        const float ba = cb[0], bb = cb[256], bc = cb[512];
#pragma unroll
        for (int i = 0; i < 16; ++i) {
            const float x0 = a0 * u0[i] + a1 * u0[i + 1] + a2 * u0[i + 2] + ba;
            const float x1 = b0 * u1[i] + b1 * u1[i + 1] + b2 * u1[i + 2] + bb;
            const float vv = c0 * u2[i] + c1 * u2[i + 1] + c2 * u2[i + 2] + bc;
            p->X0[(size_t)(r0 + i) * 256 + c] = x0;
            p->Z[(size_t)(r0 + i) * 256 + c] = x1 * vv;
        }
    } else {
        const int c = cg * 64 + lane;
        const float* u = p->U + (size_t)r0 * INCP + HG_OFF + c;
        const float lb0 = p->LB[(l * 2 + 0) * 256 + c], lb1 = p->LB[(l * 2 + 1) * 256 + c];
        float q[16], zf[16], zb[16];
#pragma unroll
        for (int i = 0; i < 16; ++i) { q[i] = u[(size_t)i * INCP]; zf[i] = u[(size_t)i * INCP + 768]; zb[i] = u[(size_t)i * INCP + 1024]; }
#pragma unroll
        for (int i = 0; i < 16; ++i) {
            p->HQ[(size_t)(r0 + i) * 256 + c] = q[i] * 0.125f;
            p->HF[(size_t)(r0 + i) * 256 + c] = lb0 + (1.f - lb0) * sigmoidf_(zf[i]);
            p->HF[((size_t)M + r0 + i) * 256 + c] = lb1 + (1.f - lb1) * sigmoidf_(zb[i]);
        }
    }
}
__device__ __forceinline__ void ph_prep(KP p, int l) {
    const int tix = otid();
    const int lane = tix & 63, wv = tix >> 6;
    const int gw = wv * gridDim.x + blockIdx.x, NW = gridDim.x * 8;
    for (int it = gw; it < 3200 + 6144; it += NW) {
        if (it < 3072) mla_wave(p, l, it >> 3, it & 7, lane);
        else if (it < 3200) { const int j = it - 3072; mla_wave(p, l, 384 + (j >> 2), 4 + (j & 3), lane); }
        else { const int j = it - 3200; tok_wave(p, l, j >> 4, (j >> 2) & 3, j & 3, lane); }
    }
}

constexpr int NCS = 96, NITEM = NCS * 8;
constexpr int HCH = 32, NHCS = 192, NHITEM = NHCS * 8;
struct ChunkInfo { int seq, c, nch, T, row0; bool prompt; };
__device__ __forceinline__ ChunkInfo chunk_info(int cs) {
    ChunkInfo ci;
    if (cs < 64) { ci.seq = cs >> 2; ci.c = cs & 3; ci.nch = 4; ci.T = T_P; ci.row0 = ci.seq * T_P; ci.prompt = true; }
    else { const int j = cs - 64; ci.seq = 16 + (j >> 4); ci.c = j & 15; ci.nch = 16; ci.T = T_S; ci.row0 = M_P + (j >> 4) * T_S; ci.prompt = false; }
    return ci;
}
__device__ __forceinline__ int first_cs(int seq) { return seq < 16 ? seq * 4 : 64 + (seq - 16) * 16; }
__device__ __forceinline__ ChunkInfo hchunk_info(int cs) {
    ChunkInfo ci;
    if (cs < 128) { ci.seq = cs >> 3; ci.c = cs & 7; ci.nch = 8; ci.T = T_P; ci.row0 = ci.seq * T_P; ci.prompt = true; }
    else { const int j = cs - 128; ci.seq = 16 + (j >> 5); ci.c = j & 31; ci.nch = 32; ci.T = T_S; ci.row0 = M_P + (j >> 5) * T_S; ci.prompt = false; }
    return ci;
}
__device__ __forceinline__ int first_hcs(int seq) { return seq < 16 ? seq * 8 : 128 + (seq - 16) * 32; }

__device__ __forceinline__ void hgrn_passA(KP p, int item, int lane) {
    asm volatile("" : "+v"(lane));
    const int cs = item >> 3, dir = (item >> 2) & 1, h = item & 3;
    const ChunkInfo ci = hchunk_info(cs);
    float S[64];
#pragma unroll
    for (int v = 0; v < 64; ++v) S[v] = 0.f;
    float suf = 1.f;
    for (int s = HCH - 1; s >= 0; --s) {
        const int g = ci.c * HCH + s, t = dir ? ci.T - 1 - g : g;
        const size_t r = (size_t)(ci.row0 + t);
        const float f = p->HF[((size_t)dir * M + r) * 256 + h * 64 + lane];
        const float vv = p->U[r * INCP + HG_OFF + 256 + h * 64 + lane];
        const float w = (1.f - f) * suf;
#pragma unroll
        for (int v = 0; v < 64; ++v) S[v] += w * bcast(vv, v);
        suf *= f;
    }
    p->HD[(size_t)item * 64 + lane] = suf;
    f32x4* so = (f32x4*)(p->HS + (size_t)item * 4096 + lane * 64);
#pragma unroll
    for (int v = 0; v < 16; ++v) so[v] = (f32x4){S[4 * v], S[4 * v + 1], S[4 * v + 2], S[4 * v + 3]};
}
__device__ __forceinline__ void gdn_passA(KP p, int item, int half, int lane) {
    const int cs = item >> 3, dir = (item >> 2) & 1, h = item & 3;
    const ChunkInfo ci = chunk_info(cs);
    float S[64];
#pragma unroll
    for (int k = 0; k < 64; ++k) S[k] = (half && k == lane) ? 1.f : 0.f;
    for (int s = 0; s < 64; ++s) {
        const int g = ci.c * 64 + s, t = dir ? ci.T - 1 - g : g;
        const size_t r = (size_t)(ci.row0 + t);
        const float kv = p->GK[r * 256 + h * 64 + lane];
        const float vi = half ? 0.f : p->GV[r * 256 + h * 64 + lane];
        const float a = p->GA[r * 8 + dir * 4 + h], beta = p->GBT[r * 8 + dir * 4 + h];
        float kS = 0.f;
#pragma unroll
        for (int k = 0; k < 64; ++k) kS += bcast(kv, k) * S[k];
        const float cc = beta * (vi - a * kS);
#pragma unroll
        for (int k = 0; k < 64; ++k) S[k] = a * S[k] + bcast(kv, k) * cc;
    }
    float* so = (half ? p->GP : p->GS) + (size_t)item * 4096 + lane;
#pragma unroll
    for (int k = 0; k < 64; ++k) so[k * 64] = S[k];
}
template <int K0, int N, class F> __device__ __forceinline__ void sfor(F&& f) { if constexpr (K0 < N) { f(std::integral_constant<int, K0>{}); sfor<K0 + 1, N>(f); } }
__device__ __forceinline__ float perm_f(float v, int srclane) { return __builtin_bit_cast(float, __builtin_amdgcn_ds_bpermute(srclane << 2, __builtin_bit_cast(int, v))); }
__device__ __forceinline__ float rdl(float v, int k) { return __builtin_bit_cast(float, __builtin_amdgcn_readlane(__builtin_bit_cast(int, v), k)); }
__device__ __forceinline__ int gdn_row(const ChunkInfo& ci, int dir, int i) { const int g = ci.c * 64 + i; return ci.row0 + (dir ? ci.T - 1 - g : g); }

__device__ __forceinline__ void gdnL_wave(KP p, int item, int which, int lane, LAS float* lm  ) {
    asm volatile("" : "+v"(lane));
    const int cs = item >> 3, dir = (item >> 2) & 1, h = item & 3;
    const ChunkInfo ci = chunk_info(cs);
    const int tq = lane & 15, g = lane >> 4;
    const int rl = gdn_row(ci, dir, lane);
    float G = p->GLA[(size_t)rl * 8 + dir * 4 + h];
    const float beta = p->GBT[(size_t)rl * 8 + dir * 4 + h];
#pragma unroll
    for (int o = 1; o < 64; o <<= 1) { const float t = perm_f(G, lane >= o ? lane - o : lane); if (lane >= o) G += t; }
    const float Glast = rdl(G, 63);
    const float eG = __expf(G);
    {
        bf16x8 kf[4][2], qf[4][2];
#pragma unroll
        for (int tt = 0; tt < 4; ++tt) { const size_t r = (size_t)gdn_row(ci, dir, 16 * tt + tq);
#pragma unroll
            for (int s = 0; s < 2; ++s) { kf[tt][s] = *(const bf16x8*)(p->GKB + r * 256 + h * 64 + 32 * s + 8 * g); qf[tt][s] = *(const bf16x8*)(p->GQB + r * 256 + h * 64 + 32 * s + 8 * g); } }
        bf16* att = p->ATT + (size_t)item * 4096;
#pragma unroll
        for (int rt = 0; rt < 4; ++rt)
#pragma unroll
            for (int ct = 0; ct <= rt; ++ct) {
                f32x4 kk = (f32x4){0.f, 0.f, 0.f, 0.f}, qk = (f32x4){0.f, 0.f, 0.f, 0.f};
#pragma unroll
                for (int s = 0; s < 2; ++s) { kk = __builtin_amdgcn_mfma_f32_16x16x32_bf16(kf[rt][s], kf[ct][s], kk, 0, 0, 0); qk = __builtin_amdgcn_mfma_f32_16x16x32_bf16(qf[rt][s], kf[ct][s], qk, 0, 0, 0); }
                const int j = 16 * ct + tq; const float Gj = perm_f(G, j);
#pragma unroll
                for (int r = 0; r < 4; ++r) { const int i = 16 * rt + 4 * g + r;
                    const float Gi = perm_f(G, i), bi = perm_f(beta, i);
                    const float dec = (j <= i) ? __expf(Gi - Gj) : 0.f;
                    lm[i * 64 + j] = (j < i) ? bi * kk[r] * dec : 0.f;
                    if (which == 0) att[i * 64 + j] = (bf16)f2bf(qk[r] * dec); }
            }
    }
    asm volatile("s_waitcnt lgkmcnt(0)" ::: "memory");
    {
        float X[64];
        const float* src = (which ? p->GK : p->GV) + h * 64 + lane;
        const float sc = which ? eG : 1.0f;
        const float bsc = beta * sc;
        sfor<0, 64>([&](auto ic) { constexpr int I = decltype(ic)::value; X[I] = rdl(bsc, I) * src[(size_t)gdn_row(ci, dir, I) * 256]; });
        sfor<1, 64>([&](auto ic) { constexpr int I = decltype(ic)::value;
            float a = X[I];
            sfor<0, (I + 3) / 4>([&](auto mc) { constexpr int M4 = decltype(mc)::value;
                const f32x4 l4 = *(const LAS f32x4*)(lm + I * 64 + 4 * M4);
                if constexpr (4 * M4 + 0 < I) a -= l4[0] * X[4 * M4 + 0];
                if constexpr (4 * M4 + 1 < I) a -= l4[1] * X[4 * M4 + 1];
                if constexpr (4 * M4 + 2 < I) a -= l4[2] * X[4 * M4 + 2];
                if constexpr (4 * M4 + 3 < I) a -= l4[3] * X[4 * M4 + 3]; });
            X[I] = a; });
        if (which == 0) { float* ub = p->UB + (size_t)item * 4096 + lane;
            sfor<0, 64>([&](auto ic) { constexpr int I = decltype(ic)::value; ub[I * 64] = X[I]; }); }
        else { bf16* wn = p->WN + (size_t)item * 4096 + lane;
            sfor<0, 64>([&](auto ic) { constexpr int I = decltype(ic)::value; wn[I * 64] = (bf16)f2bf(-X[I]); }); }
    }
    {
        bf16* qg = p->QG + (size_t)item * 4096 + lane;
        LAS bf16* kt = (LAS bf16*)lm;
        const float eo = __expf(Glast - G);
        if (which == 0) {
#pragma unroll 1
            for (int ib = 0; ib < 64; ib += 16) {
                float gq[16];
#pragma unroll
                for (int i = 0; i < 16; ++i) { const size_t r = (size_t)gdn_row(ci, dir, ib + i); gq[i] = p->GQ[r * 256 + h * 64 + lane]; }
#pragma unroll
                for (int i = 0; i < 16; ++i) qg[(ib + i) * 64] = (bf16)f2bf(gq[i] * rdl(eG, ib + i));
            }
        } else {
#pragma unroll 1
            for (int ib = 0; ib < 64; ib += 16) {
                float gk[16];
#pragma unroll
                for (int i = 0; i < 16; ++i) { const size_t r = (size_t)gdn_row(ci, dir, ib + i); gk[i] = p->GK[r * 256 + h * 64 + lane]; }
#pragma unroll
                for (int i = 0; i < 16; ++i) kt[lane * 64 + ib + i] = (bf16)f2bf(gk[i] * rdl(eo, ib + i));
            }
            asm volatile("s_waitcnt lgkmcnt(0)" ::: "memory");
            u32x4* ko = (u32x4*)(p->KOT + (size_t)item * 4096);
#pragma unroll
            for (int it = 0; it < 8; ++it) ko[it * 64 + lane] = ((const LAS u32x4*)lm)[it * 64 + lane];
            if (lane == 0) p->EGL[item] = __expf(Glast);
        }
        asm volatile("s_waitcnt lgkmcnt(0)" ::: "memory");
    }
}

__device__ __forceinline__ bf16x8 frag2(const bf16* p0) {
    const bf16x4 a = *(const bf16x4*)p0, b = *(const bf16x4*)(p0 + 16);
    bf16x8 f; f[0] = a[0]; f[1] = a[1]; f[2] = a[2]; f[3] = a[3]; f[4] = b[0]; f[5] = b[1]; f[6] = b[2]; f[7] = b[3]; return f;
}
__device__ __forceinline__ bf16x8 packC(const f32x4& t0, const f32x4& t1) { const float v[8] = {t0[0], t0[1], t0[2], t0[3], t1[0], t1[1], t1[2], t1[3]}; return pack8(v); }

struct GdnS1 { bf16x8 w[8]; f32x4 u[4]; };
__device__ __forceinline__ bf16x8 frag2o(const bf16* base  , int off) {
    const bf16x4 a = *(const bf16x4*)(base + off), b = *(const bf16x4*)(base + off + 16);
    bf16x8 f; f[0] = a[0]; f[1] = a[1]; f[2] = a[2]; f[3] = a[3]; f[4] = b[0]; f[5] = b[1]; f[6] = b[2]; f[7] = b[3]; return f;
}
__device__ __forceinline__ void gdnS_load1(GdnS1& o, KP p, size_t item, int lo, int uo) {
    const bf16* Wn = p->WN + item * 4096;
    const float* Ub = p->UB + item * 4096;
#pragma unroll
    for (int jt = 0; jt < 4; ++jt) { o.w[2 * jt] = frag2o(Wn, lo + (16 * jt) * 64); o.w[2 * jt + 1] = frag2o(Wn, lo + (16 * jt) * 64 + 32);
#pragma unroll
        for (int r = 0; r < 4; ++r) o.u[jt][r] = Ub[uo + (16 * jt + r) * 64]; }
}
__device__ __forceinline__ void gdnS_wave(KP p, int l, int sdh, int ct, int lane) {
    asm volatile("" : "+v"(lane));
    const int tq = lane & 15, g = lane >> 4;
    const int lo = tq * 64 + 4 * g, uo = (4 * g) * 64 + 16 * ct + tq;
    const int seq = sdh >> 3, dir = (sdh >> 2) & 1, h = sdh & 3;
    const bool prompt = seq < 16; const int nch = prompt ? 4 : 16, cs0 = first_cs(seq);
    f32x4 s[4];
    {
        const float* s0 = p->state_gdn + ((size_t)(((prompt ? 0 : seq - 16) * DEPTH + l) * 2 + dir) * 4 + h) * 4096 + 16 * ct + tq;
#pragma unroll
        for (int rt = 0; rt < 4; ++rt)
#pragma unroll
            for (int r = 0; r < 4; ++r) s[rt][r] = prompt ? 0.f : s0[(16 * rt + 4 * g + r) * 64];
    }
    for (int c = 0; c < nch; ++c) {
        const int cs = cs0 + c; const size_t item = (size_t)(cs * 2 + dir) * 4 + h;
        const ChunkInfo ci = chunk_info(cs);
        GdnS1 cur;
        gdnS_load1(cur, p, item, lo, uo);
        const bf16* Qg = p->QG + item * 4096;
        const bf16* At = p->ATT + item * 4096;
        const bf16* Kt = p->KOT + item * 4096;
        bf16x8 qf[8], af[6], kf[8];
#pragma unroll
        for (int it = 0; it < 4; ++it) { qf[2 * it] = frag2o(Qg, lo + (16 * it) * 64); qf[2 * it + 1] = frag2o(Qg, lo + (16 * it) * 64 + 32); }
        af[0] = frag2o(At, lo + (16 * 0) * 64); af[1] = frag2o(At, lo + (16 * 1) * 64);
        af[2] = frag2o(At, lo + (16 * 2) * 64); af[3] = frag2o(At, lo + (16 * 2) * 64 + 32);
        af[4] = frag2o(At, lo + (16 * 3) * 64); af[5] = frag2o(At, lo + (16 * 3) * 64 + 32);
        const float egl = p->EGL[item];
        const bf16x8 bS0 = packC(s[0], s[1]), bS1 = packC(s[2], s[3]);
        f32x4 vn[4];
#pragma unroll
        for (int jt = 0; jt < 4; ++jt) {
            vn[jt] = __builtin_amdgcn_mfma_f32_16x16x32_bf16(cur.w[2 * jt], bS0, cur.u[jt], 0, 0, 0);
            vn[jt] = __builtin_amdgcn_mfma_f32_16x16x32_bf16(cur.w[2 * jt + 1], bS1, vn[jt], 0, 0, 0);
        }
#pragma unroll
        for (int it = 0; it < 4; ++it) { kf[2 * it] = frag2o(Kt, lo + (16 * it) * 64); kf[2 * it + 1] = frag2o(Kt, lo + (16 * it) * 64 + 32); }
        const bf16x8 bV0 = packC(vn[0], vn[1]), bV1 = packC(vn[2], vn[3]);
        af[0][4] = 0; af[0][5] = 0; af[0][6] = 0; af[0][7] = 0;
        af[3][4] = 0; af[3][5] = 0; af[3][6] = 0; af[3][7] = 0;
        f32x4 o[4];
#pragma unroll
        for (int it = 0; it < 4; ++it) {
            o[it] = __builtin_amdgcn_mfma_f32_16x16x32_bf16(qf[2 * it], bS0, (f32x4){0.f, 0.f, 0.f, 0.f}, 0, 0, 0);
            o[it] = __builtin_amdgcn_mfma_f32_16x16x32_bf16(qf[2 * it + 1], bS1, o[it], 0, 0, 0);
        }
        o[0] = __builtin_amdgcn_mfma_f32_16x16x32_bf16(af[0], bV0, o[0], 0, 0, 0);
        o[1] = __builtin_amdgcn_mfma_f32_16x16x32_bf16(af[1], bV0, o[1], 0, 0, 0);
        o[2] = __builtin_amdgcn_mfma_f32_16x16x32_bf16(af[2], bV0, o[2], 0, 0, 0);
        o[2] = __builtin_amdgcn_mfma_f32_16x16x32_bf16(af[3], bV1, o[2], 0, 0, 0);
        o[3] = __builtin_amdgcn_mfma_f32_16x16x32_bf16(af[4], bV0, o[3], 0, 0, 0);
        o[3] = __builtin_amdgcn_mfma_f32_16x16x32_bf16(af[5], bV1, o[3], 0, 0, 0);
        if (c + 1 < nch || prompt) {
#pragma unroll
            for (int dt = 0; dt < 4; ++dt) {
                f32x4 a = s[dt] * egl;
                a = __builtin_amdgcn_mfma_f32_16x16x32_bf16(kf[2 * dt], bV0, a, 0, 0, 0);
                a = __builtin_amdgcn_mfma_f32_16x16x32_bf16(kf[2 * dt + 1], bV1, a, 0, 0, 0);
                s[dt] = a;
            }
        }
#pragma unroll
        for (int it = 0; it < 4; ++it)
#pragma unroll
            for (int r = 0; r < 4; ++r) { const size_t row = (size_t)gdn_row(ci, dir, 16 * it + 4 * g + r);
                p->OG[((size_t)dir * M + row) * 256 + h * 64 + 16 * ct + tq] = o[it][r]; }
    }
    if (prompt) {
        float* so = p->o_sgd + ((size_t)((seq * DEPTH + l) * 2 + dir) * 4 + h) * 4096 + 16 * ct + tq;
#pragma unroll
        for (int rt = 0; rt < 4; ++rt)
#pragma unroll
            for (int r = 0; r < 4; ++r) so[(16 * rt + 4 * g + r) * 64] = s[rt][r];
    }
}

__device__ __forceinline__ void ph_scanA(KP p, LAS unsigned char* lds) {
    const int tix = otid();
    const int lane = tix & 63, wv = tix >> 6;
    LAS float* lm = (LAS float*)(lds + wv * 16384);
    const int gw = wv * gridDim.x + blockIdx.x;
    const int NW = gridDim.x * 8, NIT = 2 * NITEM + NHITEM;
#pragma unroll 1
    for (int rnd = 0, it = gw; it < NIT; ++rnd) {
        if (it < 2 * NITEM) gdnL_wave(p, it >> 1, it & 1, lane, lm);
        else hgrn_passA(p, it - 2 * NITEM, lane);
        it = (rnd == 0) ? NW + (NW - 1 - gw) : it + NW;
    }
}

template <int NCH>
__device__ __forceinline__ float hgrn_passB_elem(KP p, int cs0, int dir, int h, int k, int kvx, float s) {
    float loc[NCH], dd[NCH];
#pragma unroll
    for (int c = 0; c < NCH; ++c) { const size_t item = (size_t)((cs0 + c) * 2 + dir) * 4 + h; loc[c] = p->HS[item * 4096 + kvx]; dd[c] = p->HD[item * 64 + k]; }
#pragma unroll
    for (int c = 0; c < NCH; ++c) { const size_t item = (size_t)((cs0 + c) * 2 + dir) * 4 + h; p->HS2[item * 4096 + kvx] = s; s = dd[c] * s + loc[c]; }
    return s;
}
__device__ __forceinline__ void hgrn_passB(KP p, int l, int gt, int gn) {
    for (int e = gt; e < 18 * 8 * 4096; e += gn) {
        const int sdh = e >> 12, kvx = e & 4095, k = kvx >> 6;
        const int seq = sdh >> 3, dir = (sdh >> 2) & 1, h = sdh & 3;
        if (seq < 16) {
            const float s = hgrn_passB_elem<8>(p, first_hcs(seq), dir, h, k, kvx, 0.f);
            p->o_shg[((size_t)((seq * DEPTH + l) * 2 + dir) * 4 + h) * 4096 + kvx] = s;
        } else {
            const float s0 = p->state_hgrn[((size_t)(((seq - 16) * DEPTH + l) * 2 + dir) * 4 + h) * 4096 + kvx];
            (void)hgrn_passB_elem<32>(p, first_hcs(seq), dir, h, k, kvx, s0);
        }
    }
}
__device__ __forceinline__ void split8(const float (&x)[8], bf16x8& hi, bf16x8& lo) {
    float h[8], r[8];
#pragma unroll
    for (int j = 0; j < 8; ++j) { h[j] = __builtin_bit_cast(float, f2bf(x[j]) << 16); r[j] = x[j] - h[j]; }
    hi = pack8(h); lo = pack8(r);
}
__device__ __forceinline__ void gdn_passB_wave(KP p, int l, int sdh, int ct, int lane) {
    const int tq = lane & 15, g = lane >> 4;
    const int seq = sdh >> 3, dir = (sdh >> 2) & 1, h = sdh & 3;
    const bool prompt = seq < 16; const int nch = prompt ? 4 : 16, cs0 = first_cs(seq);
    f32x4 s[4];
    {
        const float* s0 = p->state_gdn + ((size_t)(((prompt ? 0 : seq - 16) * DEPTH + l) * 2 + dir) * 4 + h) * 4096 + 16 * ct + tq;
#pragma unroll
        for (int rt = 0; rt < 4; ++rt)
#pragma unroll
            for (int r = 0; r < 4; ++r) s[rt][r] = prompt ? 0.f : s0[(16 * rt + 4 * g + r) * 64];
    }
    for (int c = 0; c < nch; ++c) {
        const size_t item = (size_t)((cs0 + c) * 2 + dir) * 4 + h;
        const float* Ls = p->GS + item * 4096 + 16 * ct + tq;
        float* Ss = p->GS2 + item * 4096 + 16 * ct + tq;
        const float* Pm = p->GP + item * 4096;
        const bool need = (c + 1 < nch) || prompt;
        f32x4 acc[4];
#pragma unroll
        for (int rt = 0; rt < 4; ++rt)
#pragma unroll
            for (int r = 0; r < 4; ++r) { const int row = 16 * rt + 4 * g + r; acc[rt][r] = Ls[row * 64]; Ss[row * 64] = s[rt][r]; }
        if (need) {
            bf16x8 bh[2], bl[2];
#pragma unroll
            for (int ks = 0; ks < 2; ++ks) { const float x[8] = {s[2 * ks][0], s[2 * ks][1], s[2 * ks][2], s[2 * ks][3], s[2 * ks + 1][0], s[2 * ks + 1][1], s[2 * ks + 1][2], s[2 * ks + 1][3]};
                split8(x, bh[ks], bl[ks]); }
#pragma unroll
            for (int rt = 0; rt < 4; ++rt)
#pragma unroll
                for (int ks = 0; ks < 2; ++ks) {
                    const float* pr = Pm + (16 * rt + tq) * 64 + 32 * ks + 4 * g;
                    const f32x4 a0 = *(const f32x4*)pr, a1 = *(const f32x4*)(pr + 16);
                    const float x[8] = {a0[0], a0[1], a0[2], a0[3], a1[0], a1[1], a1[2], a1[3]};
                    bf16x8 ah, al; split8(x, ah, al);
                    acc[rt] = __builtin_amdgcn_mfma_f32_16x16x32_bf16(ah, bh[ks], acc[rt], 0, 0, 0);
                    acc[rt] = __builtin_amdgcn_mfma_f32_16x16x32_bf16(ah, bl[ks], acc[rt], 0, 0, 0);
                    acc[rt] = __builtin_amdgcn_mfma_f32_16x16x32_bf16(al, bh[ks], acc[rt], 0, 0, 0);
                }
#pragma unroll
            for (int rt = 0; rt < 4; ++rt) s[rt] = acc[rt];
        }
    }
    if (prompt) {
        float* so = p->o_sgd + ((size_t)((seq * DEPTH + l) * 2 + dir) * 4 + h) * 4096 + 16 * ct + tq;
#pragma unroll
        for (int rt = 0; rt < 4; ++rt)
#pragma unroll
            for (int r = 0; r < 4; ++r) so[(16 * rt + 4 * g + r) * 64] = s[rt][r];
    }
}

__device__ __forceinline__ void hgrn_passC(KP p, int item, int lane) {
    asm volatile("" : "+v"(lane));
    const int cs = item >> 3, dir = (item >> 2) & 1, h = item & 3;
    const ChunkInfo ci = hchunk_info(cs);
    float S[64];
    {
        const float* s0 = p->HS2 + (size_t)item * 4096 + lane;
#pragma unroll
        for (int k = 0; k < 64; ++k) S[k] = s0[k * 64];
    }
    auto rowof = [&](int s) { const int g = ci.c * HCH + s; return (size_t)(ci.row0 + (dir ? ci.T - 1 - g : g)); };
    size_t r = rowof(0);
    float fv = p->HF[((size_t)dir * M + r) * 256 + h * 64 + lane], qv = p->HQ[r * 256 + h * 64 + lane], vi = p->U[r * INCP + HG_OFF + 256 + h * 64 + lane];
    for (int s = 0; s < HCH; ++s) {
        const size_t rn = rowof(s + 1 < HCH ? s + 1 : s);
        const float fn = p->HF[((size_t)dir * M + rn) * 256 + h * 64 + lane], qn = p->HQ[rn * 256 + h * 64 + lane], vn = p->U[rn * INCP + HG_OFF + 256 + h * 64 + lane];
        float o = 0.f;
#pragma unroll
        for (int k = 0; k < 64; ++k) {
            const float fk = bcast(fv, k);
            S[k] = fk * (S[k] - vi) + vi;
            o += bcast(qv, k) * S[k];
        }
        p->OH[((size_t)dir * M + r) * 256 + h * 64 + lane] = o;
        r = rn; fv = fn; qv = qn; vi = vn;
    }
}
__device__ __forceinline__ void gdn_passC(KP p, int item, int lane) {
    const int cs = item >> 3, dir = (item >> 2) & 1, h = item & 3;
    const ChunkInfo ci = chunk_info(cs);
    float S[64];
    {
        const float* s0 = p->GS2 + (size_t)item * 4096 + lane;
#pragma unroll
        for (int k = 0; k < 64; ++k) S[k] = s0[k * 64];
    }
    for (int s = 0; s < 64; ++s) {
        const int g = ci.c * 64 + s, t = dir ? ci.T - 1 - g : g;
        const size_t r = (size_t)(ci.row0 + t);
        const float qv = p->GQ[r * 256 + h * 64 + lane], kv = p->GK[r * 256 + h * 64 + lane], vi = p->GV[r * 256 + h * 64 + lane];
        const float a = p->GA[r * 8 + dir * 4 + h], beta = p->GBT[r * 8 + dir * 4 + h];
        float kS = 0.f;
#pragma unroll
        for (int k = 0; k < 64; ++k) kS += bcast(kv, k) * S[k];
        const float cc = beta * (vi - a * kS);
        float o = 0.f;
#pragma unroll
        for (int k = 0; k < 64; ++k) { S[k] = a * S[k] + bcast(kv, k) * cc; o += bcast(qv, k) * S[k]; }
        p->OG[((size_t)dir * M + r) * 256 + h * 64 + lane] = o;
    }
}
__device__ __forceinline__ void ph_scanC(KP p) {
    const int tix = otid();
    const int lane = tix & 63, wv = tix >> 6;
    for (int it = wv * gridDim.x + blockIdx.x; it < NHITEM; it += gridDim.x * 8) hgrn_passC(p, it, lane);
}

struct KVFrag { bf16x8 k[2][3]; bf16x4 v[4][2]; };
__device__ __forceinline__ void attn_load(KVFrag& f, const bf16* Kb, const bf16* Vt, int nk, int k0, int q, int g) {
#pragma unroll
    for (int tt = 0; tt < 2; ++tt)
#pragma unroll
        for (int s = 0; s < 3; ++s) f.k[tt][s] = *(const bf16x8*)(Kb + (size_t)(k0 + 16 * tt + q) * 96 + 32 * s + 8 * g);
#pragma unroll
    for (int vt = 0; vt < 4; ++vt)
#pragma unroll
        for (int tt = 0; tt < 2; ++tt) f.v[vt][tt] = *(const bf16x4*)(Vt + (size_t)(16 * vt + q) * nk + k0 + 16 * tt + 4 * g);
}
__device__ __forceinline__ void attn_wave(KP p, int item, int lane) {
    asm volatile("" : "+v"(lane));
    int seq, h, qb, nk, r0; const bf16 *Kb, *Vt;
    if (item < 1024) { seq = item >> 6; h = (item >> 4) & 3; qb = item & 15; nk = T_P; r0 = seq * T_P + qb * 16;
        Kb = p->KBP + (size_t)(seq * 4 + h) * T_P * 96; Vt = p->VTP + (size_t)(seq * 4 + h) * 64 * T_P; }
    else { const int j = item - 1024; seq = j >> 8; h = (j >> 6) & 3; qb = j & 63; nk = NKS; r0 = M_P + seq * T_S + qb * 16;
        Kb = p->KBS + (size_t)(seq * 4 + h) * NKS * 96; Vt = p->VTS + (size_t)(seq * 4 + h) * 64 * NKS; }
    const int q = lane & 15, g = lane >> 4;
    bf16x8 qf[3];
#pragma unroll
    for (int s = 0; s < 3; ++s) qf[s] = *(const bf16x8*)(p->QB + (size_t)(r0 + q) * 384 + h * 96 + 32 * s + 8 * g);
    f32x4 o[4];
#pragma unroll
    for (int vt = 0; vt < 4; ++vt) o[vt] = (f32x4){0.f, 0.f, 0.f, 0.f};
    float m = -1e30f, lsum = 0.f;
    const int nblk = nk >> 5;
    KVFrag cur, nxt;
    attn_load(cur, Kb, Vt, nk, 0, q, g);
    for (int kb = 0; kb < nblk; ++kb) {
        const int kn = (kb + 1 < nblk) ? kb + 1 : kb;
        attn_load(nxt, Kb, Vt, nk, kn * 32, q, g);
        f32x4 s0 = (f32x4){0.f, 0.f, 0.f, 0.f}, s1 = (f32x4){0.f, 0.f, 0.f, 0.f};
#pragma unroll
        for (int s = 0; s < 3; ++s) { s0 = __builtin_amdgcn_mfma_f32_16x16x32_bf16(cur.k[0][s], qf[s], s0, 0, 0, 0); s1 = __builtin_amdgcn_mfma_f32_16x16x32_bf16(cur.k[1][s], qf[s], s1, 0, 0, 0); }
        float ml = fmaxf(fmaxf(fmaxf(s0[0], s0[1]), fmaxf(s0[2], s0[3])), fmaxf(fmaxf(s1[0], s1[1]), fmaxf(s1[2], s1[3])));
        ml = fmaxf(ml, __builtin_bit_cast(float, __builtin_amdgcn_ds_bpermute((lane ^ 16) << 2, __builtin_bit_cast(int, ml))));
        ml = fmaxf(ml, __builtin_bit_cast(float, __builtin_amdgcn_ds_bpermute((lane ^ 32) << 2, __builtin_bit_cast(int, ml))));
        const float mn = fmaxf(m, ml);
        const float corr = __expf(m - mn);
        float pv[8];
#pragma unroll
        for (int i = 0; i < 4; ++i) { pv[i] = __expf(s0[i] - mn); pv[4 + i] = __expf(s1[i] - mn); }
        lsum = lsum * corr + ((pv[0] + pv[1]) + (pv[2] + pv[3])) + ((pv[4] + pv[5]) + (pv[6] + pv[7]));
        m = mn;
        u32x4 pw; pw.x = pg8::cvt_pk_bf16(pv[0], pv[1]); pw.y = pg8::cvt_pk_bf16(pv[2], pv[3]); pw.z = pg8::cvt_pk_bf16(pv[4], pv[5]); pw.w = pg8::cvt_pk_bf16(pv[6], pv[7]);
        const bf16x8 pf = __builtin_bit_cast(bf16x8, pw);
#pragma unroll
        for (int vt = 0; vt < 4; ++vt) {
            bf16x8 af;
            af[0] = cur.v[vt][0][0]; af[1] = cur.v[vt][0][1]; af[2] = cur.v[vt][0][2]; af[3] = cur.v[vt][0][3];
            af[4] = cur.v[vt][1][0]; af[5] = cur.v[vt][1][1]; af[6] = cur.v[vt][1][2]; af[7] = cur.v[vt][1][3];
            o[vt] = __builtin_amdgcn_mfma_f32_16x16x32_bf16(af, pf, o[vt] * corr, 0, 0, 0);
        }
        cur = nxt;
    }
    lsum += __builtin_bit_cast(float, __builtin_amdgcn_ds_bpermute((lane ^ 16) << 2, __builtin_bit_cast(int, lsum)));
    lsum += __builtin_bit_cast(float, __builtin_amdgcn_ds_bpermute((lane ^ 32) << 2, __builtin_bit_cast(int, lsum)));
    const float inv = 1.0f / lsum;
    bf16* orow = p->OCAT + (size_t)(r0 + q) * D + 512 + h * 64 + 4 * g;
#pragma unroll
    for (int vt = 0; vt < 4; ++vt) { u32x2 w; w.x = pk2(o[vt][0] * inv, o[vt][1] * inv); w.y = pk2(o[vt][2] * inv, o[vt][3] * inv); *(u32x2*)(orow + 16 * vt) = w; }
}

__device__ __forceinline__ void hyena_wave(KP p, int l, int item, int lane) {
    asm volatile("" : "+v"(lane));
    int seq, tb, cw, T, row0, set;
    if (item < 1024) { seq = item >> 6; tb = (item >> 2) & 15; cw = item & 3; T = T_P; row0 = seq * T_P; set = 0; }
    else { const int j = item - 1024; seq = j >> 8; tb = (j >> 2) & 63; cw = j & 3; T = T_S; row0 = M_P + seq * T_S; set = 1; }
    const int c = cw * 64 + lane, t0 = tb * 16;
    const float* G = p->FILT + (size_t)l * FILT_L + (set ? (size_t)2 * 256 * 256 : 0) + c;
    const float* Zp = p->Z + (size_t)row0 * 256 + c;
    float acc[16];
#pragma unroll
    for (int i = 0; i < 16; ++i) acc[i] = 0.f;
    float tap[31], z[16];
    {
        const float* gp = G + (size_t)(t0 - 15 + T) * 256;
#pragma unroll
        for (int i = 0; i < 31; ++i) tap[i] = gp[(size_t)i * 256];
#pragma unroll
        for (int j = 0; j < 16; ++j) z[j] = Zp[(size_t)j * 256];
    }
    for (int s0 = 0; s0 < T; s0 += 16) {
        const int sn = (s0 + 16 < T) ? s0 + 16 : s0;
        float tapn[31], zn[16];
        const float* gp = G + (size_t)(t0 - sn - 15 + T) * 256;
#pragma unroll
        for (int i = 0; i < 31; ++i) tapn[i] = gp[(size_t)i * 256];
#pragma unroll
        for (int j = 0; j < 16; ++j) zn[j] = Zp[(size_t)(sn + j) * 256];
#pragma unroll
        for (int i = 0; i < 16; ++i)
#pragma unroll
            for (int j = 0; j < 16; ++j) acc[i] += tap[i - j + 15] * z[j];
#pragma unroll
        for (int i = 0; i < 31; ++i) tap[i] = tapn[i];
#pragma unroll
        for (int j = 0; j < 16; ++j) z[j] = zn[j];
    }
    const float skip = p->hy_skip[l * 256 + c];
#pragma unroll
    for (int i = 0; i < 16; ++i) {
        const size_t r = (size_t)(row0 + t0 + i);
        const float zz = p->Z[r * 256 + c];
        p->OCAT[r * D + 256 + c] = (bf16)f2bf(p->X0[r * 256 + c] * (acc[i] + zz * skip));
    }
}

__device__ __forceinline__ void ph_mixB(KP p, int l) {
    const int tix = otid();
    const int lane = tix & 63, wv = tix >> 6;
    hgrn_passB(p, l, blockIdx.x * NTHREADS + tix, gridDim.x * NTHREADS);
    const int gw = wv * gridDim.x + blockIdx.x;
    for (int it = gw; it < 576 + 3072; it += gridDim.x * 8) {
        if (it < 64) gdnS_wave(p, l, 128 + (it >> 2), it & 3, lane);
        else if (it < 576) gdnS_wave(p, l, (it - 64) >> 2, it & 3, lane);
        else { const int j = it - 576;
            if (j < 512) attn_wave(p, 1024 + j, lane);
            else if (j < 1024) { __builtin_amdgcn_s_setprio(2); hyena_wave(p, l, 1024 + (j - 512), lane); __builtin_amdgcn_s_setprio(0); }
            else if (j < 2048) { __builtin_amdgcn_s_setprio(1); hyena_wave(p, l, j - 1024, lane); __builtin_amdgcn_s_setprio(0); }
            else attn_wave(p, j - 2048, lane); }
    }
}
__device__ __forceinline__ void ph_athy(KP p, int l) {
    const int tix = otid();
    const int lane = tix & 63, wv = tix >> 6;
    for (int j = wv * gridDim.x + blockIdx.x; j < 3072; j += gridDim.x * 8) {
        if (j < 512) attn_wave(p, 1024 + j, lane);
        else if (j < 1024) hyena_wave(p, l, 1024 + (j - 512), lane);
        else if (j < 2048) hyena_wave(p, l, j - 1024, lane);
        else attn_wave(p, j - 2048, lane);
    }
}

__device__ __forceinline__ void ph_headnorm(KP p, int l) {
    const int tix = otid();
    const int lane = tix & 63, wv = tix >> 6;
    for (int item = wv * gridDim.x + blockIdx.x; item < (M / 4) * 8; item += gridDim.x * 8) {
        const int r0 = (item >> 3) * 4, which = (item >> 2) & 1, h = item & 3;
        const int c = h * 64 + lane;
        const float* O = which ? p->OG : p->OH;
        const float gn = which ? p->gdn_norm[l * 64 + lane] : p->hgrn_norm[l * 256 + c];
        float o[4], gt[4];
#pragma unroll
        for (int i = 0; i < 4; ++i) {
            o[i] = O[(size_t)(r0 + i) * 256 + c] + O[((size_t)M + r0 + i) * 256 + c];
            gt[i] = which ? p->U[(size_t)(r0 + i) * INCP + GD_OFF + 768 + c] : p->U[(size_t)(r0 + i) * INCP + HG_OFF + 512 + c];
        }
#pragma unroll
        for (int i = 0; i < 4; ++i) {
            const float ss = wave_sum(o[i] * o[i], lane);
            const float rstd = 1.0f / sqrtf(ss * (1.0f / 64.f) + RMS_EPS);
            p->OCAT[(size_t)(r0 + i) * D + (which ? 768 : 0) + c] = (bf16)f2bf(o[i] * rstd * gn * siluf_(gt[i]));
        }
    }
}

#define XB_TMO      128
#define XB_XCNT(j)  (256  + 64 * (j))
#define XB_XSUB(j)  (1280 + 64 * (j))
#define XB_XGEN(j)  (2304 + 64 * (j))
#define XB_TOP      3328
#define XB_TOPGEN   3392
#define XCD_BAR_WORDS 3456
#define XB_SPIN_CAP (1u << 18)

__device__ __forceinline__ unsigned xb_ld(unsigned* p)              { return __hip_atomic_load(p, __ATOMIC_RELAXED, __HIP_MEMORY_SCOPE_AGENT); }
__device__ __forceinline__ unsigned xb_add(unsigned* p, unsigned v) { return __hip_atomic_fetch_add(p, v, __ATOMIC_RELAXED, __HIP_MEMORY_SCOPE_AGENT); }
__device__ __forceinline__ unsigned xb_xcc_id() { return (unsigned)__builtin_amdgcn_s_getreg((3 << 11) | 20) & 0xFu; }
#define XB_SPIN(cond, bar) do { unsigned _sp = 0; while (cond) { __builtin_amdgcn_s_sleep(1); \
    if ((++_sp & 255u) == 0u) { if (xb_ld(&(bar)[XB_TMO])) break; if (_sp > XB_SPIN_CAP) { atomicAdd(&(bar)[XB_TMO], 1u); break; } } } } while (0)

struct XcdBarrier {
    unsigned* bar; unsigned x;
    volatile LAS unsigned* st;
};

__device__ __forceinline__ XcdBarrier xcd_barrier_post(unsigned* bar, volatile LAS unsigned* st) {
    XcdBarrier b; b.bar = bar; b.x = xb_xcc_id(); b.st = st;
    if (threadIdx.x == 0) (void)xb_add(&bar[XB_XCNT(b.x)], 1u);
    return b;
}
__device__ __forceinline__ void xcd_barrier_complete(unsigned* bar, unsigned x, unsigned& nloc, unsigned& nx) {
    const unsigned G = gridDim.x * gridDim.y * gridDim.z;
    unsigned sum, cnt, mine, sp = 0u;
    for (;;) {
        sum = 0u; cnt = 0u; mine = 0u;
#pragma unroll
        for (unsigned j = 0; j < 16; ++j) { const unsigned c = xb_ld(&bar[XB_XCNT(j)]); sum += c; cnt += (c > 0u) ? 1u : 0u; mine = (j == x) ? c : mine; }
        if (sum == G) break;
        __builtin_amdgcn_s_sleep(1);
        if ((++sp & 255u) == 0u) { if (xb_ld(&bar[XB_TMO])) break; if (sp > XB_SPIN_CAP) { atomicAdd(&bar[XB_TMO], 1u); break; } }
    }
    nloc = mine > 0u ? mine : 1u; nx = cnt > 0u ? cnt : 1u;
}

__device__ __forceinline__ void xcd_barrier(const XcdBarrier& b) {
    asm volatile("s_waitcnt vmcnt(0)" ::: "memory");
    __syncthreads();
    if (threadIdx.x == 0) {
        unsigned* bar = b.bar;
        __builtin_amdgcn_s_waitcnt(0);
        unsigned nloc = b.st[0], nx = b.st[1];
        if (nloc == 0u) { xcd_barrier_complete(bar, b.x, nloc, nx); b.st[0] = nloc; b.st[1] = nx; }
        const unsigned old = xb_add(&bar[XB_XSUB(b.x)], 1u);
        const unsigned gen = old / nloc;
        if (old + 1u == (gen + 1u) * nloc) {
            __builtin_amdgcn_fence(__ATOMIC_RELEASE, "agent");
            asm volatile("s_waitcnt vmcnt(0)" ::: "memory");
            const unsigned og = xb_add(&bar[XB_TOP], 1u);
            const unsigned tg = og / nx;
            if (og + 1u == (tg + 1u) * nx) xb_add(&bar[XB_TOPGEN], 1u);
            else XB_SPIN(xb_ld(&bar[XB_TOPGEN]) == tg, bar);
            __builtin_amdgcn_fence(__ATOMIC_ACQUIRE, "agent");
            xb_add(&bar[XB_XGEN(b.x)], 1u);
            asm volatile("s_waitcnt vmcnt(0)" ::: "memory");
        } else {
            XB_SPIN(xb_ld(&bar[XB_XGEN(b.x)]) == gen, bar);
            __builtin_amdgcn_fence(__ATOMIC_ACQUIRE, "agent");
            asm volatile("s_waitcnt vmcnt(0)" ::: "memory");
        }
    }
    __syncthreads();
}

#ifndef REP_SETUP
#define REP_SETUP 1
#endif
#ifndef REP_NORM
#define REP_NORM 1
#endif
#ifndef REP_GU
#define REP_GU 1
#endif
#ifndef REP_GIN
#define REP_GIN 1
#endif
#ifndef REP_PREP
#define REP_PREP 1
#endif
#ifndef REP_SCANA
#define REP_SCANA 1
#endif
#ifndef REP_ATHY
#define REP_ATHY 1
#endif
#ifndef REP_SCANC
#define REP_SCANC 1
#endif
#ifndef REP_HN
#define REP_HN 1
#endif
#ifndef REP_MIXB
#define REP_MIXB 1
#endif
#ifndef REP_SYNC
#define REP_SYNC 1
#endif
#define REPEAT(n) for (int rep_ = 0; rep_ < (n); ++rep_)
__global__ void __launch_bounds__(NTHREADS, 2) fwd_megakernel(P p) {
    extern __shared__ __attribute__((aligned(16))) unsigned char lds_raw[];
    LAS unsigned char* lds = (LAS unsigned char*)lds_raw;
    const int G = gridDim.x;
    volatile LAS unsigned* MISC = (volatile LAS unsigned*)(lds + 131072);
    if (threadIdx.x < 64) MISC[threadIdx.x] = 0u;
    __syncthreads();
    (void)xcd_barrier_post(FRESH_P()->BAR, MISC + 8);
#define GRID_SYNC() REPEAT(REP_SYNC) do { XcdBarrier b_; b_.bar = FRESH_P()->BAR; b_.x = xb_xcc_id(); b_.st = (volatile LAS unsigned*)(lds + 131072) + 8; xcd_barrier(b_); } while (0)

    REPEAT(REP_SETUP) {
    ph_init(FRESH_P());
#ifndef NO_ADA
    ph_ada(FRESH_P(), (LAS float*)lds);
#endif
#ifndef NO_SMALL
    ph_small(FRESH_P());
#endif
#ifndef NO_FILT
    ph_filt(FRESH_P(), (LAS double*)lds);
#endif
#ifndef NO_WPREP
    ph_wprep(FRESH_P(), (LAS float*)lds);
#endif
    __syncthreads();
    }
    GRID_SYNC();

#pragma unroll 1
    for (int l = 0; l < DEPTH; ++l) {
#pragma unroll 1
        for (int f = 0; f < 2; ++f) {
            if (f == 1) {
                REPEAT(REP_NORM) ph_norm(FRESH_P(), l, 1);
                GRID_SYNC();
#ifndef NO_GIN
                REPEAT(REP_GIN) { KP q = FRESH_P(); pg8::Gemm g{q->H, q->WIN + (size_t)l * INCP * D, M, INCP, D}; pg8::StaticOrder S; S.init(M, INCP, G, (int)blockIdx.x);
                  EpiF32 E{q->U, INCP};
                  pg8::gemm_phase<EpiF32, pg8::StaticOrder, true, true>(lds, g, S, E); }
#endif
                GRID_SYNC();
                REPEAT(REP_PREP) ph_prep(FRESH_P(), l);
                GRID_SYNC();
                REPEAT(REP_SCANA) ph_scanA(FRESH_P(), lds);
                GRID_SYNC();
                REPEAT(REP_MIXB) ph_mixB(FRESH_P(), l);
                REPEAT(REP_ATHY - 1) ph_athy(FRESH_P(), l);
                GRID_SYNC();
                REPEAT(REP_SCANC) ph_scanC(FRESH_P());
                GRID_SYNC();
                REPEAT(REP_HN) ph_headnorm(FRESH_P(), l);
                GRID_SYNC();
#ifndef NO_GOUT
                { KP q = FRESH_P(); pg8::Gemm g{q->OCAT, q->WOUT + (size_t)l * D * D, M, D, D}; pg8::StaticOrder S; S.init(M, D, G, (int)blockIdx.x);
                  EpiResid E{q->X, q->ADA + (size_t)(l * 3) * NADA * D + 5 * D, 1.0f};
                  pg8::gemm_phase<EpiResid, pg8::StaticOrder, true, true>(lds, g, S, E);
                  wprep_idle(FRESH_P(), (LAS float*)lds, l + 1, 1, (M / 256) * (D / 256));
#ifdef REP_GOUT
                  __syncthreads(); EpiResid E0{q->X, q->ADA + (size_t)(l * 3) * NADA * D + 5 * D, 0.0f};
                  pg8::gemm_phase<EpiResid, pg8::StaticOrder, true, true>(lds, g, S, E0);
#endif
                }
#endif
                GRID_SYNC();
            }
            const int s = f == 0 ? 0 : 2;
            REPEAT(REP_NORM) ph_norm(FRESH_P(), l, s);
            GRID_SYNC();
#ifndef NO_GGU
            REPEAT(REP_GU) { KP q = FRESH_P(); pg8::Gemm g{q->H, q->WGU + (size_t)(l * 2 + f) * 2 * DFF * D, M, 2 * DFF, D}; pg8::StaticOrder S; S.init(M, 2 * DFF, G, (int)blockIdx.x);
              EpiSwiGLU E{q->ACT};
              pg8::gemm_phase<EpiSwiGLU, pg8::StaticOrder, true, true>(lds, g, S, E); }
#endif
            GRID_SYNC();
#ifndef NO_GDN
            { KP q = FRESH_P(); pg8::Gemm g{q->ACT, q->WDN + (size_t)(l * 2 + f) * D * DFF, M, D, DFF}; pg8::StaticOrder S; S.init(M, D, G, (int)blockIdx.x);
              EpiResid E{q->X, q->ADA + (size_t)(l * 3) * NADA * D + (3 * s + 2) * D, 0.5f};
              pg8::gemm_phase<EpiResid, pg8::StaticOrder, true, true>(lds, g, S, E);
              wprep_idle(FRESH_P(), (LAS float*)lds, l + 1, f == 0 ? 0 : 2, (M / 256) * (D / 256));
#ifdef REP_GDN
              __syncthreads(); EpiResid E0{q->X, q->ADA + (size_t)(l * 3) * NADA * D + (3 * s + 2) * D, 0.0f};
              pg8::gemm_phase<EpiResid, pg8::StaticOrder, true, true>(lds, g, S, E0);
#endif
            }
#endif
            GRID_SYNC();
        }
    }
}

}

extern "C" void kernel_launch(void* const* d_in, const int* in_sizes, int n_in, void* d_out, int out_size, void* d_ws, size_t ws_size, hipStream_t stream) {
    P p{};
    const float* const* in = (const float* const*)d_in;
    p.x_prompt = in[0]; p.x_sample = in[1]; p.cache_ckv = in[2]; p.cache_krope = in[3]; p.state_hgrn = in[4]; p.state_gdn = in[5]; p.c = in[6]; p.c_ctx = in[7];
    p.w_ada = in[8]; p.b_ada = in[9]; p.norm_ffn = in[10]; p.w_gu = in[11]; p.w_down = in[12]; p.norm_mix = in[13]; p.w_in = in[14]; p.w_out = in[15];
    p.hgrn_lb = in[16]; p.hgrn_norm = in[17]; p.hy_conv_w = in[18]; p.hy_conv_b = in[19]; p.hy_w1 = in[20]; p.hy_b1 = in[21]; p.hy_freq = in[22];
    p.hy_w2 = in[23]; p.hy_b2 = in[24]; p.hy_w3 = in[25]; p.hy_skip = in[26]; p.q_norm_a = in[27]; p.w_q_up = in[28]; p.kv_norm_a = in[29];
    p.w_kv_up = in[30]; p.qk_norm = in[31]; p.gdn_conv_w = in[32]; p.gdn_a_log = in[33]; p.gdn_dt_bias = in[34]; p.gdn_norm = in[35];
    float* out = (float*)d_out;
    p.X = out;
    p.o_ckv = out + (size_t)M * D;
    p.o_krope = p.o_ckv + (size_t)NB_P * DEPTH * T_P * 128;
    p.o_shg = p.o_krope + (size_t)NB_P * DEPTH * T_P * 32;
    p.o_sgd = p.o_shg + (size_t)NB_P * DEPTH * 2 * 4 * 64 * 64;
    unsigned char* w = (unsigned char*)d_ws;
    auto take = [&](size_t bytes) { unsigned char* r = w; w += (bytes + 255) & ~(size_t)255; return r; };
    p.ADA = (float*)take((size_t)DEPTH * 3 * NADA * D * 4);
    p.LB = (float*)take(DEPTH * 512 * 4);
    p.FILT = (float*)take(DEPTH * FILT_L * 4);
    p.ROPE = (float*)take(2 * 1024 * 16 * 4);
    p.WGU = (bf16*)take((size_t)DEPTH * 2 * 2 * DFF * D * 2);
    p.WDN = (bf16*)take((size_t)DEPTH * 2 * D * DFF * 2);
    p.WIN = (bf16*)take((size_t)DEPTH * INCP * D * 2);
    p.WOUT = (bf16*)take((size_t)DEPTH * D * D * 2);
    p.WQT = (bf16*)take((size_t)DEPTH * 384 * 256 * 2); p.WKVT = (bf16*)take((size_t)DEPTH * 512 * 128 * 2);
    p.H = (bf16*)take((size_t)M * D * 2);
    p.ACT = (bf16*)take((size_t)M * DFF * 2);
    p.OCAT = (bf16*)take((size_t)M * D * 2);
    p.U = (float*)take((size_t)M * INCP * 4);
    p.QB = (bf16*)take((size_t)M * 384 * 2);
    p.KBP = (bf16*)take((size_t)NB_P * 4 * T_P * 96 * 2); p.VTP = (bf16*)take((size_t)NB_P * 4 * 64 * T_P * 2);
    p.KBS = (bf16*)take((size_t)NB_S * 4 * NKS * 96 * 2); p.VTS = (bf16*)take((size_t)NB_S * 4 * 64 * NKS * 2);
    p.GQ = (float*)take((size_t)M * 256 * 4); p.GK = (float*)take((size_t)M * 256 * 4); p.GV = (float*)take((size_t)M * 256 * 4);
    p.GA = (float*)take((size_t)M * 8 * 4); p.GBT = (float*)take((size_t)M * 8 * 4);
    p.HF = (float*)take((size_t)2 * M * 256 * 4); p.HQ = (float*)take((size_t)M * 256 * 4);
    p.Z = (float*)take((size_t)M * 256 * 4); p.X0 = (float*)take((size_t)M * 256 * 4);
    p.OH = (float*)take((size_t)2 * M * 256 * 4); p.OG = (float*)take((size_t)2 * M * 256 * 4);
    p.HS = (float*)take((size_t)1536 * 4096 * 4); p.HD = (float*)take((size_t)1536 * 64 * 4);
    p.GS = (float*)take((size_t)768 * 4096 * 4); p.GP = (float*)take((size_t)768 * 4096 * 4);
    p.HS2 = (float*)take((size_t)1536 * 4096 * 4); p.GS2 = (float*)take((size_t)768 * 4096 * 4);
    p.GKB = (bf16*)take((size_t)M * 256 * 2); p.GQB = (bf16*)take((size_t)M * 256 * 2); p.GLA = (float*)take((size_t)M * 8 * 4);
    p.ATT = (bf16*)take((size_t)768 * 4096 * 2); p.WN = (bf16*)take((size_t)768 * 4096 * 2); p.QG = (bf16*)take((size_t)768 * 4096 * 2); p.KOT = (bf16*)take((size_t)768 * 4096 * 2);
    p.UB = (float*)take((size_t)768 * 4096 * 4); p.EGL = (float*)take((size_t)768 * 4);
    p.BAR = (unsigned*)take(16384);

    static int grid_blocks = 0;
    if (!grid_blocks) {
        int dev = 0, cus = 0, per_cu = 0;
        hipGetDevice(&dev);
        hipDeviceGetAttribute(&cus, hipDeviceAttributeMultiprocessorCount, dev);
        hipFuncSetAttribute((const void*)fwd_megakernel, hipFuncAttributeMaxDynamicSharedMemorySize, LDS_BYTES);
        hipOccupancyMaxActiveBlocksPerMultiprocessor(&per_cu, (const void*)fwd_megakernel, NTHREADS, LDS_BYTES);
        if (per_cu < 1) { fprintf(stderr, "kernel_launch: occupancy query reports %d blocks per CU\n", per_cu); per_cu = 1; }
        if (per_cu > 1) per_cu = 1;
        grid_blocks = cus * per_cu;
    }
    (void)hipMemsetAsync(p.BAR, 0, 16384, stream);
    void* args[] = {&p};
    hipError_t e = hipLaunchCooperativeKernel((const void*)fwd_megakernel, dim3(grid_blocks), dim3(NTHREADS), args, LDS_BYTES, stream);
    if (e != hipSuccess) fprintf(stderr, "cooperative launch failed: %s (grid %d)\n", hipGetErrorString(e), grid_blocks);
}
```
